# Optimizing an MI355X kernel written in HIP

```python
import jax, jax.numpy as jnp
from jax import lax
import numpy as np

D_MODEL = 2048
BATCH = 1
SEQ = 8192
DEPTH = 2
DEC_BATCH = 16
DEC_SEQ = 16
PAST_LEN = 4096

CHUNK = 64
N_META = 16
CONV_DIM = D_MODEL // 2
CONV_W = 3
HEAD_DIM = 128
ATTN_DIM = D_MODEL // 2
N_HEADS = ATTN_DIM // HEAD_DIM
D_FF = 2 * D_MODEL
FFN_CONV_W = 3
Q_BLOCK = 128
EPS = 1e-6
ATTN_SCALE = HEAD_DIM ** -0.5
NEG_INF = -1e30
SPLIT_SIZES = (CONV_DIM, CONV_DIM, CONV_DIM, ATTN_DIM, ATTN_DIM, ATTN_DIM, N_HEADS, D_MODEL, D_MODEL)
PROJ_DIM = 3 * CONV_DIM + 3 * ATTN_DIM + N_HEADS + 2 * D_MODEL
F_OFF = 3 * CONV_DIM + 3 * ATTN_DIM

kernel_name = 'hybrid_gatedconv_fox_convffn_stream_step'


def rmsnorm(x, g):
    xf = x.astype(jnp.float32)
    y = xf * lax.rsqrt(jnp.mean(xf * xf, axis=-1, keepdims=True) + EPS)
    return (y * g.astype(jnp.float32)).astype(x.dtype)


def causal_dwconv(u, hist, w):
    L = u.shape[1]
    width = w.shape[0]
    full = jnp.concatenate([hist.astype(u.dtype), u], axis=1)
    y = full[:, 0:L] * w[0]
    for j in range(1, width):
        y = y + full[:, j:j + L] * w[j]
    return y, full[:, full.shape[1] - (width - 1):]


def split_proj(z):
    points = np.cumsum(np.array(SPLIT_SIZES))[:-1].tolist()
    return jnp.split(z, points, axis=-1)


def fox_prompt(q, k, v, logf):
    B, L, H, Dh = q.shape
    nb = -(-L // Q_BLOCK)
    Lp = nb * Q_BLOCK
    pad = Lp - L
    pad4 = ((0, 0), (0, pad), (0, 0), (0, 0))
    qp = jnp.pad(q, pad4)
    kp = jnp.pad(k, pad4)
    vp = jnp.pad(v, pad4)
    c = jnp.pad(jnp.cumsum(logf, axis=1), ((0, 0), (0, pad), (0, 0)))
    c_k = c.transpose(0, 2, 1)
    q_blocks = qp.reshape(B, nb, Q_BLOCK, H, Dh).swapaxes(0, 1)
    c_blocks = c.reshape(B, nb, Q_BLOCK, H).swapaxes(0, 1)
    k_pos = jnp.arange(Lp)

    def one_block(args):
        blk, qi, ci = args
        s = jnp.einsum('bqhd,bkhd->bhqk', qi, kp, preferred_element_type=jnp.float32) * ATTN_SCALE
        s = s + ci.astype(jnp.float32).transpose(0, 2, 1)[..., None] - c_k[:, :, None, :]
        q_pos = blk * Q_BLOCK + jnp.arange(Q_BLOCK)
        s = jnp.where(k_pos[None, :] <= q_pos[:, None], s, NEG_INF)
        p = jax.nn.softmax(s, axis=-1)
        return jnp.einsum('bhqk,bkhd->bqhd', p.astype(vp.dtype), vp)

    out = lax.map(one_block, (jnp.arange(nb), q_blocks, c_blocks))
    return out.swapaxes(0, 1).reshape(B, Lp, H, Dh)[:, :L]


def fox_sample(q, k, v, logf, cache_k, cache_v, cache_logf):
    T = q.shape[1]
    P = cache_k.shape[1]
    lc = cache_logf.astype(jnp.float32)
    suffix = lax.cumsum(lc, axis=1, reverse=True) - lc
    cn = jnp.cumsum(logf, axis=1)
    keys = jnp.concatenate([cache_k.astype(k.dtype), k], axis=1)
    vals = jnp.concatenate([cache_v.astype(v.dtype), v], axis=1)
    k_bias = jnp.concatenate([suffix, -cn], axis=1)
    s = jnp.einsum('bthd,bshd->bhts', q, keys, preferred_element_type=jnp.float32) * ATTN_SCALE
    s = s + cn.transpose(0, 2, 1)[..., None] + k_bias.transpose(0, 2, 1)[:, :, None, :]
    new_mask = jnp.arange(T)[None, :] <= jnp.arange(T)[:, None]
    mask = jnp.concatenate([jnp.ones((T, P), dtype=bool), new_mask], axis=1)
    s = jnp.where(mask, s, NEG_INF)
    p = jax.nn.softmax(s, axis=-1)
    return jnp.einsum('bhts,bshd->bthd', p.astype(vals.dtype), vals)


def layer_forward(x, conv_hist, ffn_hist, attn, g_mix, w_in, b_in, w_conv, w_pc, w_pa, w_o,
                  g_ffn, w_up, w_fconv, b_fconv, w_down):
    B, L, _ = x.shape
    h = rmsnorm(x, g_mix)
    z = h @ w_in + b_in
    xc, bc, cc, q, k, v, fl, gc, ga = split_proj(z)
    yc, conv_new = causal_dwconv(cc * xc, conv_hist, w_conv)
    yc = bc * yc
    q = q.reshape(B, L, N_HEADS, HEAD_DIM)
    k = k.reshape(B, L, N_HEADS, HEAD_DIM)
    v = v.reshape(B, L, N_HEADS, HEAD_DIM)
    logf = jax.nn.log_sigmoid(fl.astype(jnp.float32))
    ya = attn(q, k, v, logf).reshape(B, L, ATTN_DIM)
    merged = jax.nn.sigmoid(gc) * (yc @ w_pc) + jax.nn.sigmoid(ga) * (ya @ w_pa)
    x = x + merged @ w_o
    u = rmsnorm(x, g_ffn) @ w_up
    u, ffn_new = causal_dwconv(u, ffn_hist, w_fconv)
    a, b = jnp.split(u + b_fconv, 2, axis=-1)
    x = x + (jax.nn.silu(a) * b) @ w_down
    return x, conv_new, ffn_new, k, v, logf


def setup_inputs(seed: int = 0) -> dict:
    key = jax.random.key(seed)
    ks = jax.random.split(key, 24)
    f32 = jnp.float32
    nrm = lambda kk, shape, scale: jax.random.normal(kk, shape, f32) * scale
    b_in = nrm(ks[0], (DEPTH, PROJ_DIM), 0.02)
    b_f = jax.random.uniform(ks[1], (DEPTH, N_HEADS), f32, 1.0, 4.0)
    b_in = b_in.at[:, F_OFF:F_OFF + N_HEADS].set(b_f)
    cache_logf = jax.nn.log_sigmoid(nrm(ks[2], (DEPTH, DEC_BATCH, PAST_LEN, N_HEADS), 1.0) + 2.5)
    return {
        'x_prompt': nrm(ks[3], (BATCH, SEQ, D_MODEL), 1.0),
        'x_sample': nrm(ks[4], (DEC_BATCH, DEC_SEQ, D_MODEL), 1.0),
        'cache_k': nrm(ks[5], (DEPTH, DEC_BATCH, PAST_LEN, N_HEADS, HEAD_DIM), 1.0),
        'cache_v': nrm(ks[6], (DEPTH, DEC_BATCH, PAST_LEN, N_HEADS, HEAD_DIM), 1.0),
        'cache_logf': cache_logf,
        'state_conv': nrm(ks[7], (DEPTH, DEC_BATCH, CONV_W - 1, CONV_DIM), 1.0),
        'state_ffn_conv': nrm(ks[8], (DEPTH, DEC_BATCH, FFN_CONV_W - 1, 2 * D_FF), 1.0),
        'meta_tokens': nrm(ks[9], (N_META, D_MODEL), 1.0),
        'g_mix': 1.0 + nrm(ks[10], (DEPTH, D_MODEL), 0.02),
        'w_in': nrm(ks[11], (DEPTH, D_MODEL, PROJ_DIM), D_MODEL ** -0.5),
        'b_in': b_in,
        'w_conv': nrm(ks[12], (DEPTH, CONV_W, CONV_DIM), 0.5),
        'w_pc': nrm(ks[13], (DEPTH, CONV_DIM, D_MODEL), CONV_DIM ** -0.5),
        'w_pa': nrm(ks[14], (DEPTH, ATTN_DIM, D_MODEL), ATTN_DIM ** -0.5),
        'w_o': nrm(ks[15], (DEPTH, D_MODEL, D_MODEL), D_MODEL ** -0.5),
        'g_ffn': 1.0 + nrm(ks[16], (DEPTH, D_MODEL), 0.02),
        'w_up': nrm(ks[17], (DEPTH, D_MODEL, 2 * D_FF), D_MODEL ** -0.5),
        'w_fconv': nrm(ks[18], (DEPTH, FFN_CONV_W, 2 * D_FF), 0.5),
        'b_fconv': nrm(ks[19], (DEPTH, 2 * D_FF), 0.02),
        'w_down': nrm(ks[20], (DEPTH, D_FF, D_MODEL), D_FF ** -0.5),
        'g_final': 1.0 + nrm(ks[21], (D_MODEL,), 0.02),
    }


def reference(x_prompt, x_sample, cache_k, cache_v, cache_logf, state_conv, state_ffn_conv,
              meta_tokens, g_mix, w_in, b_in, w_conv, w_pc, w_pa, w_o, g_ffn, w_up, w_fconv,
              b_fconv, w_down, g_final):
    B = x_prompt.shape[0]
    meta = jnp.broadcast_to(meta_tokens[None].astype(x_prompt.dtype), (B, N_META, D_MODEL))
    xp = jnp.concatenate([meta, x_prompt], axis=1)
    xs = x_sample
    zeros_conv = jnp.zeros((B, CONV_W - 1, CONV_DIM), x_prompt.dtype)
    zeros_ffn = jnp.zeros((B, FFN_CONV_W - 1, 2 * D_FF), x_prompt.dtype)
    kp_l, vp_l, fp_l, cp_l, ffp_l = [], [], [], [], []
    ks_l, vs_l, fs_l, cs_l, ffs_l = [], [], [], [], []
    for i in range(DEPTH):
        wts = (g_mix[i], w_in[i], b_in[i], w_conv[i], w_pc[i], w_pa[i], w_o[i],
               g_ffn[i], w_up[i], w_fconv[i], b_fconv[i], w_down[i])
        xp, c_new, f_new, k_new, v_new, lf_new = layer_forward(
            xp, zeros_conv, zeros_ffn, fox_prompt, *wts)
        kp_l.append(k_new); vp_l.append(v_new); fp_l.append(lf_new)
        cp_l.append(c_new); ffp_l.append(f_new)
        ck, cv, cl = cache_k[i], cache_v[i], cache_logf[i]
        attn_s = lambda q, k, v, lf, ck=ck, cv=cv, cl=cl: fox_sample(q, k, v, lf, ck, cv, cl)
        xs, c_new, f_new, k_new, v_new, lf_new = layer_forward(
            xs, state_conv[i], state_ffn_conv[i], attn_s, *wts)
        ks_l.append(k_new); vs_l.append(v_new); fs_l.append(lf_new)
        cs_l.append(c_new); ffs_l.append(f_new)
    y_prompt = rmsnorm(xp, g_final)[:, N_META:]
    y_sample = rmsnorm(xs, g_final)
    return (y_prompt, y_sample,
            jnp.stack(kp_l), jnp.stack(vp_l), jnp.stack(fp_l), jnp.stack(cp_l), jnp.stack(ffp_l),
            jnp.stack(ks_l), jnp.stack(vs_l), jnp.stack(fs_l), jnp.stack(cs_l), jnp.stack(ffs_l))
```

```cpp
#include <hip/hip_runtime.h>
#include <cstdio>
#include <cstdint>
typedef float f32x2_cv __attribute__((ext_vector_type(2))); typedef __bf16 bf16x2_cv __attribute__((ext_vector_type(2)));
__device__ __forceinline__ unsigned cvt_pk_bf16_rne(float lo, float hi) { const f32x2_cv v = {lo, hi}; const bf16x2_cv b = __builtin_convertvector(v, bf16x2_cv); return __builtin_bit_cast(unsigned, b); }
namespace xl {
typedef unsigned u32x2_t __attribute__((ext_vector_type(2)));
__device__ __forceinline__ float sum_xor32(float v) { const auto r = __builtin_amdgcn_permlane32_swap(__float_as_uint(v), __float_as_uint(v), false, false); return __uint_as_float(r[0]) + __uint_as_float(r[1]); }
__device__ __forceinline__ float sum_xor16(float v) { const auto r = __builtin_amdgcn_permlane16_swap(__float_as_uint(v), __float_as_uint(v), false, false); return __uint_as_float(r[0]) + __uint_as_float(r[1]); }
__device__ __forceinline__ float max_xor32(float v) { const auto r = __builtin_amdgcn_permlane32_swap(__float_as_uint(v), __float_as_uint(v), false, false); return fmaxf(__uint_as_float(r[0]), __uint_as_float(r[1])); }
__device__ __forceinline__ float max_xor16(float v) { const auto r = __builtin_amdgcn_permlane16_swap(__float_as_uint(v), __float_as_uint(v), false, false); return fmaxf(__uint_as_float(r[0]), __uint_as_float(r[1])); }
__device__ __forceinline__ float xor1(float v) { return __int_as_float(__builtin_amdgcn_update_dpp(0, __float_as_int(v), 0xB1, 0xf, 0xf, true)); }
template <int N> __device__ __forceinline__ float row_shr(float v) { return __int_as_float(__builtin_amdgcn_update_dpp(0, __float_as_int(v), 0x110 + N, 0xf, 0xf, true)); }
__device__ __forceinline__ float wave_incl_scan(float x, int lane) {
    x += row_shr<1>(x); x += row_shr<2>(x); x += row_shr<4>(x); x += row_shr<8>(x);
    const float t0 = __int_as_float(__builtin_amdgcn_readlane(__float_as_int(x), 15)), t1 = __int_as_float(__builtin_amdgcn_readlane(__float_as_int(x), 31)), t2 = __int_as_float(__builtin_amdgcn_readlane(__float_as_int(x), 47));
    const int row = lane >> 4; return x + (row >= 1 ? t0 : 0.f) + (row >= 2 ? t1 : 0.f) + (row >= 3 ? t2 : 0.f);
}
__device__ __forceinline__ float wave_sum(float v) { v += xor1(v); v += __int_as_float(__builtin_amdgcn_update_dpp(0, __float_as_int(v), 0x4E, 0xf, 0xf, true));
    v += row_shr<4>(v); v += row_shr<8>(v);
    return __int_as_float(__builtin_amdgcn_readlane(__float_as_int(v), 15)) + __int_as_float(__builtin_amdgcn_readlane(__float_as_int(v), 31)) + __int_as_float(__builtin_amdgcn_readlane(__float_as_int(v), 47)) + __int_as_float(__builtin_amdgcn_readlane(__float_as_int(v), 63)); }
}
namespace pg8 {
#define PG8_LAS __attribute__((address_space(3)))
typedef unsigned short bf16_t;
typedef short bf16x8 __attribute__((ext_vector_type(8)));
typedef float f32x4 __attribute__((ext_vector_type(4)));
typedef unsigned u32x4 __attribute__((ext_vector_type(4)));
constexpr int BM = 256, BK = 64, HALF = 128, HTB = HALF * BK * 2  , STAGE_BYTES = 8 * HTB, NXCD = 8, WGM = 8;

__host__ __device__ __forceinline__ int lds_byte(int r, int c) { const int st = (r >> 4) * 2 + (c >> 5), rr = r & 15, cc = c & 31, ob = rr * 64 + cc * 2; return st * 1024 + (ob ^ (((ob >> 9) & 1) << 5)); }
__host__ __device__ __forceinline__ void stage_rc(int b, int& R, int& C) { const int st = b / 1024, sb = b % 1024, swz = sb ^ (((sb >> 9) & 1) << 5); R = (st >> 1) * 16 + swz / 64; C = (st & 1) * 32 + (swz % 64) / 2; }
__host__ __device__ __forceinline__ int perm32(int rho) { const int n = rho >> 4, i = rho & 15; return 8 * (i >> 2) + 4 * n + (i & 3); }

struct Unit { int pm, pn; };
struct Gemm { const bf16_t* A; const bf16_t* Bt; int M, N, K; };

struct StaticOrder {
    int nM, nN, nwg, G, c;
    __host__ __device__ void init(int M, int N, int G_, int c_) { nM = M / BM; nN = N / BM; nwg = nM * nN; G = G_; c = c_; }
    __host__ __device__ bool next(int i, Unit& u) const {
        const long L = (long)i * G + c; if (L >= nwg) return false;
        int wgid = (int)L; { const int q = nwg / NXCD, r = nwg % NXCD, xcd = wgid % NXCD, off = wgid / NXCD; wgid = (xcd < r ? xcd * (q + 1) : r * (q + 1) + (xcd - r) * q) + off; }
        const int nig = WGM * nN, gid = wgid / nig, fm = gid * WGM, gsz = (nM - fm) < WGM ? (nM - fm) : WGM;
        u.pm = fm + ((wgid % nig) % gsz); u.pn = (wgid % nig) / gsz; return true;
    }
    __device__ __forceinline__ void a_ready(const Unit&) const {}
    __device__ __forceinline__ void done(const Unit&) const {}
};

__device__ __forceinline__ unsigned cvt_pk_bf16(float lo, float hi) { return cvt_pk_bf16_rne(lo, hi); }
typedef float f32x2 __attribute__((ext_vector_type(2)));
constexpr int MP = 8704, MREAL = 8464, NSAMP = 256, LPR = 8208;
constexpr int DM = 2048, CONVD = 1024, ATTD = 1024, NH = 8, HDIM = 128, DFF = 4096, DFF2 = 8192, NPROJ = 10496, PROJ = 10248;
constexpr float RMS_EPS = 1e-6f;
constexpr long OFF_YP = 0, OFF_YS = 16777216, OFF_KP = 17301504, OFF_VP = 34111488, OFF_LFP = 50921472, OFF_CP = 51052800, OFF_FP = 51056896,
               OFF_KS = 51089664, OFF_VS = 51613952, OFF_LFS = 52138240, OFF_CS = 52142336, OFF_FS = 52207872, OUT_TOTAL = 52732160;
typedef unsigned u32x2 __attribute__((ext_vector_type(2)));
__device__ __forceinline__ u32x2 pk4(const f32x4 v) { u32x2 w; w.x = cvt_pk_bf16(v[0], v[1]); w.y = cvt_pk_bf16(v[2], v[3]); return w; }
__device__ __forceinline__ f32x4 unpk4(const u32x2 w) { f32x4 v; v[0] = __uint_as_float(w.x << 16); v[1] = __uint_as_float(w.x & 0xffff0000u); v[2] = __uint_as_float(w.y << 16); v[3] = __uint_as_float(w.y & 0xffff0000u); return v; }
__device__ __forceinline__ float sigmoidf_(float v) { return __builtin_amdgcn_rcpf(1.0f + __builtin_amdgcn_exp2f(-1.4426950408889634f * v)); }
__device__ __forceinline__ float rowscale(const float* ssq, int row) { const f32x4* p = (const f32x4*)(ssq + (size_t)row * 32); f32x4 a = p[0];
#pragma unroll
    for (int i = 1; i < 8; ++i) a += p[i];
    return 1.0f / sqrtf(((a[0] + a[1]) + (a[2] + a[3])) * (1.0f / 2048.0f) + RMS_EPS); }

struct EpiIn {
    static constexpr bool PERM = false, AFTER_DRAIN = false;
    const float* ssq; const float* bias; bf16_t *P, *BC, *Q, *Kb, *Vb, *SGC, *SGA; float* LOGF; float* out; int layer;
    __device__ __forceinline__ void operator()(const f32x4 (&acc)[2][2][4][2], const Unit& u, int wr, int wc, int fr, int fq) const {
        const int rowb = u.pm * BM + wr * 64 + fr, pn = u.pn;
        f32x4 bv[2][2];
#pragma unroll
        for (int bj = 0; bj < 2; ++bj)
#pragma unroll
            for (int n = 0; n < 2; ++n) bv[bj][n] = *(const f32x4*)(bias + pn * 256 + wc * 32 + 4 * fq + bj * HALF + n * 16);
        if (pn < 16) {
            const int ch = 64 * pn + 16 * wc + 4 * fq;
#pragma unroll
            for (int ai = 0; ai < 2; ++ai)
#pragma unroll
                for (int m = 0; m < 4; ++m) { const int row = rowb + ai * HALF + m * 16; const float rs = rowscale(ssq, row);
                    const f32x4 xc = acc[ai][0][m][0] * rs + bv[0][0], bc = acc[ai][0][m][1] * rs + bv[0][1], cc = acc[ai][1][m][0] * rs + bv[1][0], q = acc[ai][1][m][1] * rs + bv[1][1];
                    const f32x4 p = cc * xc; const size_t o = (size_t)row * 1024 + ch;
                    *(u32x2*)(P + o) = pk4(p); *(u32x2*)(BC + o) = pk4(bc); *(u32x2*)(Q + o) = pk4(q);
                    if (row < NSAMP) { if ((row & 15) >= 14) *(f32x4*)(out + OFF_CS + ((size_t)(layer * 16 + (row >> 4)) * 2 + ((row & 15) - 14)) * 1024 + ch) = p; }
                    else if (row == NSAMP + LPR - 2 || row == NSAMP + LPR - 1) *(f32x4*)(out + OFF_CP + (size_t)(layer * 2 + (row - (NSAMP + LPR - 2))) * 1024 + ch) = p; }
        } else if (pn < 24) {
            const bool isv = pn >= 20; bf16_t* B = isv ? Vb : Kb; const int colb = 256 * (pn - (isv ? 20 : 16)) + wc * 32 + 4 * fq;
#pragma unroll
            for (int ai = 0; ai < 2; ++ai)
#pragma unroll
                for (int m = 0; m < 4; ++m) { const int row = rowb + ai * HALF + m * 16; const float rs = rowscale(ssq, row);
                    long oo = -1; if (row < NSAMP) oo = (isv ? OFF_VS : OFF_KS) + ((long)layer * 256 + row) * 1024; else if (row < MREAL) oo = (isv ? OFF_VP : OFF_KP) + ((long)layer * LPR + (row - NSAMP)) * 1024;
#pragma unroll
                    for (int bj = 0; bj < 2; ++bj)
#pragma unroll
                        for (int n = 0; n < 2; ++n) { const f32x4 v = acc[ai][bj][m][n] * rs + bv[bj][n]; const int col = colb + bj * HALF + n * 16;
                            *(u32x2*)(B + (size_t)row * 1024 + col) = pk4(v); if (oo >= 0) *(f32x4*)(out + oo + col) = v; } }
        } else if (pn < 40) {
            const bool isa = pn >= 32; bf16_t* S = isa ? SGA : SGC; const int colb = 256 * (pn - (isa ? 32 : 24)) + wc * 32 + 4 * fq;
#pragma unroll
            for (int ai = 0; ai < 2; ++ai)
#pragma unroll
                for (int m = 0; m < 4; ++m) { const int row = rowb + ai * HALF + m * 16; const float rs = rowscale(ssq, row);
#pragma unroll
                    for (int bj = 0; bj < 2; ++bj)
#pragma unroll
                        for (int n = 0; n < 2; ++n) { f32x4 v = acc[ai][bj][m][n] * rs + bv[bj][n]; v[0] = sigmoidf_(v[0]); v[1] = sigmoidf_(v[1]); v[2] = sigmoidf_(v[2]); v[3] = sigmoidf_(v[3]);
                            *(u32x2*)(S + (size_t)row * 2048 + colb + bj * HALF + n * 16) = pk4(v); } }
        } else {
            if (wc == 0 && fq < 2) {
#pragma unroll
                for (int ai = 0; ai < 2; ++ai)
#pragma unroll
                    for (int m = 0; m < 4; ++m) { const int row = rowb + ai * HALF + m * 16; const float rs = rowscale(ssq, row);
                        f32x4 v = acc[ai][0][m][0] * rs + bv[0][0];
#pragma unroll
                        for (int e = 0; e < 4; ++e) v[e] = fminf(v[e], 0.f) - log1pf(__expf(-fabsf(v[e])));
                        *(f32x4*)(LOGF + (size_t)row * 8 + 4 * fq) = v;
                        if (row < NSAMP) *(f32x4*)(out + OFF_LFS + ((size_t)layer * 256 + row) * 8 + 4 * fq) = v;
                        else if (row < MREAL) *(f32x4*)(out + OFF_LFP + ((size_t)layer * LPR + (row - NSAMP)) * 8 + 4 * fq) = v; }
            }
        }
    }
};
struct EpiGate1 {
    static constexpr bool PERM = false, AFTER_DRAIN = false;
    const bf16_t* SG; float* T1;
    __device__ __forceinline__ void operator()(const f32x4 (&acc)[2][2][4][2], const Unit& u, int wr, int wc, int fr, int fq) const {
        const int rowb = u.pm * BM + wr * 64 + fr, colb = u.pn * BM + wc * 32 + 4 * fq;
#pragma unroll
        for (int ai = 0; ai < 2; ++ai)
#pragma unroll
            for (int m = 0; m < 4; ++m) { const size_t ro = (size_t)(rowb + ai * HALF + m * 16) * 2048 + colb;
#pragma unroll
                for (int bj = 0; bj < 2; ++bj)
#pragma unroll
                    for (int n = 0; n < 2; ++n) { const size_t o = ro + bj * HALF + n * 16; *(f32x4*)(T1 + o) = unpk4(*(const u32x2*)(SG + o)) * acc[ai][bj][m][n]; } }
    }
};
struct EpiGate2 {
    static constexpr bool PERM = false, AFTER_DRAIN = false;
    const bf16_t* SG; const float* T1; bf16_t* MG;
    __device__ __forceinline__ void operator()(const f32x4 (&acc)[2][2][4][2], const Unit& u, int wr, int wc, int fr, int fq) const {
        const int rowb = u.pm * BM + wr * 64 + fr, colb = u.pn * BM + wc * 32 + 4 * fq;
#pragma unroll
        for (int ai = 0; ai < 2; ++ai)
#pragma unroll
            for (int m = 0; m < 4; ++m) { const size_t ro = (size_t)(rowb + ai * HALF + m * 16) * 2048 + colb;
#pragma unroll
                for (int bj = 0; bj < 2; ++bj)
#pragma unroll
                    for (int n = 0; n < 2; ++n) { const size_t o = ro + bj * HALF + n * 16; *(u32x2*)(MG + o) = pk4(*(const f32x4*)(T1 + o) + unpk4(*(const u32x2*)(SG + o)) * acc[ai][bj][m][n]); } }
    }
};
struct EpiRes {
    static constexpr bool PERM = false, AFTER_DRAIN = false;
    float* X; bf16_t* XB; float* ssq_next;
    __device__ __forceinline__ void operator()(const f32x4 (&acc)[2][2][4][2], const Unit& u, int wr, int wc, int fr, int fq) const {
        const int rowb = u.pm * BM + wr * 64 + fr, colb = u.pn * BM + wc * 32 + 4 * fq;
#pragma unroll
        for (int ai = 0; ai < 2; ++ai)
#pragma unroll
            for (int m = 0; m < 4; ++m) { const int row = rowb + ai * HALF + m * 16; const size_t ro = (size_t)row * 2048 + colb; float s = 0.f;
#pragma unroll
                for (int bj = 0; bj < 2; ++bj)
#pragma unroll
                    for (int n = 0; n < 2; ++n) { const size_t o = ro + bj * HALF + n * 16; const f32x4 x = *(const f32x4*)(X + o) + acc[ai][bj][m][n];
                        *(f32x4*)(X + o) = x; *(u32x2*)(XB + o) = pk4(x); s += (x[0] * x[0] + x[1] * x[1]) + (x[2] * x[2] + x[3] * x[3]); }
                s = xl::sum_xor16(s); s = xl::sum_xor32(s);
                if (fq == 0) ssq_next[(size_t)row * 32 + u.pn * 4 + wc] = s; }
    }
};
struct EpiUp {
    static constexpr bool PERM = false, AFTER_DRAIN = false;
    const float* ssq; bf16_t* U; float* out; int layer;
    __device__ __forceinline__ void operator()(const f32x4 (&acc)[2][2][4][2], const Unit& u, int wr, int wc, int fr, int fq) const {
        const int rowb = u.pm * BM + wr * 64 + fr, colb = u.pn * BM + wc * 32 + 4 * fq, natb = 128 * u.pn + wc * 32 + 4 * fq;
#pragma unroll
        for (int ai = 0; ai < 2; ++ai)
#pragma unroll
            for (int m = 0; m < 4; ++m) { const int row = rowb + ai * HALF + m * 16; const float rs = rowscale(ssq, row);
                long oo = -1; if (row < NSAMP) { if ((row & 15) >= 14) oo = OFF_FS + ((long)(layer * 16 + (row >> 4)) * 2 + ((row & 15) - 14)) * 8192; }
                else if (row == NSAMP + LPR - 2 || row == NSAMP + LPR - 1) oo = OFF_FP + (long)(layer * 2 + (row - (NSAMP + LPR - 2))) * 8192;
#pragma unroll
                for (int bj = 0; bj < 2; ++bj)
#pragma unroll
                    for (int n = 0; n < 2; ++n) { const f32x4 v = acc[ai][bj][m][n] * rs; *(u32x2*)(U + (size_t)row * 8192 + colb + bj * HALF + n * 16) = pk4(v);
                        if (oo >= 0) *(f32x4*)(out + oo + bj * 4096 + natb + n * 16) = v; } }
    }
};
template <class Epi, class Sched, bool ALIGN_EPI = false, bool SP2 = false>
__device__ __forceinline__ void gemm_phase(PG8_LAS unsigned char* lds, const Gemm g, const Sched& S, const Epi& E, const int wv  ) {
    int tid_ = wv * 64 + (int)__builtin_amdgcn_mbcnt_hi(~0u, __builtin_amdgcn_mbcnt_lo(~0u, 0u)); asm volatile("" : "+v"(tid_));
    const int tid = tid_, wid = __builtin_amdgcn_readfirstlane(tid >> 6), lane = tid & 63, wr = wid >> 2, wc = wid & 3, fr = lane & 15, fq = lane >> 4;
    const int K = g.K, nt = K / BK;
    unsigned voffA[2], voffB[2];
#pragma unroll
    for (int i = 0; i < 2; ++i) { int R, C; stage_rc(tid * 16 + i * 8192, R, C); const int Rb = Epi::PERM ? ((R & ~31) + perm32(R & 31)) : R;
        voffA[i] = (unsigned)(R * K + C) * 2u; voffB[i] = (unsigned)(Rb * K + C) * 2u; }
    const size_t kstep = (size_t)(BK * 2);
    const size_t hstep = (size_t)HALF * K * 2;
    const size_t tstep = 2 * hstep;
    const unsigned ldsw = (unsigned)wid * 1024u;
    const int aoff = lds_byte(wr * 64 + fr, fq * 8), boff = lds_byte(wc * 32 + fr, fq * 8);
#define PG8_SA(b, h) (((b) * 2 + (h)) * HTB)
#define PG8_SB(b, h) ((4 + (b) * 2 + (h)) * HTB)
#define PG8_STAGE(bufoff, gbase, voff) do { _Pragma("unroll") for (int _i = 0; _i < 2; ++_i) \
        __builtin_amdgcn_global_load_lds((const unsigned*)((const char*)(gbase) + (voff)[_i]), (PG8_LAS unsigned*)(lds + (bufoff) + ldsw + _i * 8192), 16, 0, 0); } while (0)
#define PG8_LDA(dst, b, h) do { _Pragma("unroll") for (int m = 0; m < 4; ++m) _Pragma("unroll") for (int k = 0; k < 2; ++k) dst[m][k] = *(const PG8_LAS bf16x8*)(lds + PG8_SA(b, h) + aoff + m * 2048 + k * 1024); } while (0)
#define PG8_LDB(dst, b, h) do { _Pragma("unroll") for (int n = 0; n < 2; ++n) _Pragma("unroll") for (int k = 0; k < 2; ++k) dst[n][k] = *(const PG8_LAS bf16x8*)(lds + PG8_SB(b, h) + boff + n * 2048 + k * 1024); } while (0)
#define PG8_MMA(ai, bj, At, Bt) do { __builtin_amdgcn_s_setprio(1); _Pragma("unroll") for (int m = 0; m < 4; ++m) _Pragma("unroll") for (int n = 0; n < 2; ++n) _Pragma("unroll") for (int k = 0; k < 2; ++k) \
        acc[ai][bj][m][n] = __builtin_amdgcn_mfma_f32_16x16x32_bf16(Bt[n][k], At[m][k], acc[ai][bj][m][n], 0, 0, 0); __builtin_amdgcn_s_setprio(0); } while (0)
#define PG8_WAIT_V(n) asm volatile("s_waitcnt vmcnt(" #n ")" ::: "memory")
#define PG8_WAIT_L(n) asm volatile("s_waitcnt lgkmcnt(" #n ")" ::: "memory")
#define PG8_BAR __builtin_amdgcn_s_barrier()
#define PG8_SCHED __builtin_amdgcn_sched_barrier(0)
    Unit cur, nxt; int ui = 0;
    if (!S.next(0, cur)) return;
    f32x4 acc[2][2][4][2];
#pragma unroll
    for (int a = 0; a < 2; ++a)
#pragma unroll
        for (int b = 0; b < 2; ++b)
#pragma unroll
            for (int m = 0; m < 4; ++m)
#pragma unroll
                for (int n = 0; n < 2; ++n) acc[a][b][m][n] = (f32x4){0.f, 0.f, 0.f, 0.f};
    bf16x8 At[4][2], B0[2][2], B1[2][2];
    const char* cA = (const char*)g.A + (size_t)cur.pm * tstep; const char* cB = (const char*)g.Bt + (size_t)cur.pn * tstep;
    S.a_ready(cur);
    if constexpr (SP2) {
        PG8_STAGE(PG8_SB(0, 0), cB, voffB); PG8_STAGE(PG8_SB(0, 1), cB + hstep, voffB); PG8_STAGE(PG8_SA(0, 0), cA, voffA); PG8_STAGE(PG8_SA(0, 1), cA + hstep, voffA);
        if (wr == 1) PG8_BAR;
        PG8_WAIT_V(2); PG8_BAR;
        PG8_STAGE(PG8_SB(1, 0), cB + kstep, voffB); PG8_STAGE(PG8_SA(1, 0), cA + kstep, voffA); PG8_STAGE(PG8_SB(1, 1), cB + hstep + kstep, voffB);
        PG8_WAIT_V(6); PG8_BAR;
    } else {
        PG8_STAGE(PG8_SB(0, 0), cB, voffB); PG8_STAGE(PG8_SA(0, 0), cA, voffA); PG8_STAGE(PG8_SB(0, 1), cB + hstep, voffB); PG8_STAGE(PG8_SA(0, 1), cA + hstep, voffA);
        if (wr == 1) PG8_BAR;
        PG8_WAIT_V(4); PG8_BAR;
        PG8_STAGE(PG8_SB(1, 0), cB + kstep, voffB); PG8_STAGE(PG8_SA(1, 0), cA + kstep, voffA); PG8_STAGE(PG8_SB(1, 1), cB + hstep + kstep, voffB);
        PG8_WAIT_V(6); PG8_BAR;
    }
    for (;;) {
        const bool has_next = S.next(ui + 1, nxt);
        const char* nA = has_next ? (const char*)g.A + (size_t)nxt.pm * tstep : cA; const char* nB = has_next ? (const char*)g.Bt + (size_t)nxt.pn * tstep : cB;
        for (int t = 0; t < nt; t += 2) {
            const bool last = (t == nt - 2);
            const char* a1 = cA + (size_t)(t + 1) * kstep;
            const char* a2 = last ? nA : cA + (size_t)(t + 2) * kstep; const char* b2 = last ? nB : cB + (size_t)(t + 2) * kstep;
            const char* a3 = a2 + kstep; const char* b3 = b2 + kstep;
            if (last && has_next) S.a_ready(nxt);
            if constexpr (SP2) {
            PG8_LDB(B0, 0, 0); PG8_LDB(B1, 0, 1); PG8_SCHED; PG8_LDA(At, 0, 0); PG8_STAGE(PG8_SA(1, 1), a1 + hstep, voffA);
            PG8_WAIT_V(8); PG8_WAIT_L(0); PG8_BAR; PG8_MMA(0, 0, At, B0); PG8_MMA(0, 1, At, B1); PG8_BAR; PG8_SCHED;
            PG8_LDA(At, 0, 1); PG8_STAGE(PG8_SB(0, 0), b2, voffB); PG8_STAGE(PG8_SB(0, 1), b2 + hstep, voffB); PG8_STAGE(PG8_SA(0, 0), a2, voffA);
            PG8_WAIT_V(8); PG8_WAIT_L(0); PG8_BAR; PG8_MMA(1, 0, At, B0); PG8_MMA(1, 1, At, B1); PG8_BAR; PG8_SCHED;
            PG8_LDB(B0, 1, 0); PG8_LDB(B1, 1, 1); PG8_SCHED; PG8_LDA(At, 1, 0); PG8_STAGE(PG8_SA(0, 1), a2 + hstep, voffA);
            PG8_WAIT_V(8); PG8_WAIT_L(0); PG8_BAR; PG8_MMA(0, 0, At, B0); PG8_MMA(0, 1, At, B1); PG8_BAR; PG8_SCHED;
            PG8_LDA(At, 1, 1); PG8_STAGE(PG8_SB(1, 0), b3, voffB); PG8_STAGE(PG8_SB(1, 1), b3 + hstep, voffB); PG8_STAGE(PG8_SA(1, 0), a3, voffA);
            PG8_WAIT_V(8); PG8_WAIT_L(0); PG8_BAR; PG8_MMA(1, 0, At, B0); PG8_MMA(1, 1, At, B1); PG8_BAR; PG8_SCHED;
            } else {
            PG8_LDB(B0, 0, 0); PG8_SCHED; PG8_LDA(At, 0, 0); PG8_STAGE(PG8_SA(1, 1), a1 + hstep, voffA);
            PG8_WAIT_L(8); PG8_BAR; PG8_WAIT_L(0); PG8_MMA(0, 0, At, B0); PG8_BAR; PG8_SCHED;
            PG8_LDB(B1, 0, 1); PG8_STAGE(PG8_SB(0, 0), b2, voffB);
            PG8_BAR; PG8_WAIT_L(0); PG8_MMA(0, 1, At, B1); PG8_BAR;
            PG8_LDA(At, 0, 1); PG8_STAGE(PG8_SA(0, 0), a2, voffA);
            PG8_BAR; PG8_WAIT_L(0); PG8_MMA(1, 0, At, B0); PG8_BAR; PG8_SCHED;
            PG8_STAGE(PG8_SB(0, 1), b2 + hstep, voffB);
            PG8_WAIT_V(6); PG8_BAR; PG8_MMA(1, 1, At, B1); PG8_BAR;
            PG8_LDB(B0, 1, 0); PG8_SCHED; PG8_LDA(At, 1, 0); PG8_STAGE(PG8_SA(0, 1), a2 + hstep, voffA);
            PG8_WAIT_L(8); PG8_BAR; PG8_WAIT_L(0); PG8_MMA(0, 0, At, B0); PG8_BAR; PG8_SCHED;
            PG8_LDB(B1, 1, 1); PG8_STAGE(PG8_SB(1, 0), b3, voffB);
            PG8_BAR; PG8_WAIT_L(0); PG8_MMA(0, 1, At, B1); PG8_BAR;
            PG8_LDA(At, 1, 1); PG8_STAGE(PG8_SA(1, 0), a3, voffA);
            PG8_BAR; PG8_WAIT_L(0); PG8_MMA(1, 0, At, B0); PG8_BAR; PG8_SCHED;
            PG8_STAGE(PG8_SB(1, 1), b3 + hstep, voffB);
            PG8_WAIT_V(6); PG8_BAR; PG8_MMA(1, 1, At, B1); PG8_BAR;
            }
        }
        if constexpr (ALIGN_EPI) { if (wr == 0) PG8_BAR; }
        if constexpr (!Epi::AFTER_DRAIN) { E(acc, cur, wr, wc, fr, fq); S.done(cur); PG8_WAIT_V(0); }
        if (!has_next) break;
#pragma unroll
        for (int a = 0; a < 2; ++a)
#pragma unroll
            for (int b = 0; b < 2; ++b)
#pragma unroll
                for (int m = 0; m < 4; ++m)
#pragma unroll
                    for (int n = 0; n < 2; ++n) acc[a][b][m][n] = (f32x4){0.f, 0.f, 0.f, 0.f};
        cur = nxt; cA = nA; cB = nB; ++ui;
        if constexpr (ALIGN_EPI) { if (wr == 1) PG8_BAR; }
    }
    PG8_WAIT_V(0);
    if constexpr (!ALIGN_EPI) { if (wr == 0) PG8_BAR; }
    PG8_BAR;
    if constexpr (Epi::AFTER_DRAIN) { E.fused(acc, cur, wr, wc, fr, fq, lds, wid, lane); S.done(cur); }
#undef PG8_SA
#undef PG8_SB
#undef PG8_STAGE
#undef PG8_LDA
#undef PG8_LDB
#undef PG8_MMA
#undef PG8_WAIT_V
#undef PG8_WAIT_L
#undef PG8_BAR
#undef PG8_SCHED
}
}
namespace pa {
typedef unsigned short bf16_t;
typedef short bf16x8 __attribute__((ext_vector_type(8)));
typedef short s16x4 __attribute__((ext_vector_type(4)));
typedef float f32x16 __attribute__((ext_vector_type(16)));
typedef float f32x4 __attribute__((ext_vector_type(4)));
typedef unsigned u32x4 __attribute__((ext_vector_type(4)));
constexpr int D = 128, LD = 1024;
constexpr float SCALE = 0.08838834764831845f, C2 = 1.4426950408889634f * SCALE, THR = 8.f;
constexpr int NW = 8, QBLK = 32, KVBLK = 64, QB = NW * QBLK;
constexpr int SHM_V = KVBLK * D * 2, SHM_K = KVBLK * D * 2;
constexpr int LDS_ATT = 2 * SHM_V + 2 * SHM_K + NW * 64 * 4;
#define KSWZ(row, colB) ((row) * 256 + ((colB) ^ (((row) & 7) << 4)))
#define SBAR() __builtin_amdgcn_sched_barrier(0)
__device__ __forceinline__ int v_st(int k, int c) { const int kk = (k & ~0xC) | ((k & 4) << 1) | ((k & 8) >> 1); return ((kk >> 3) * 4 + (c >> 5)) * 512 + ((kk & 7) * 32 + (c & 31)) * 2; }
__device__ __forceinline__ int v_rd_base(int lane) { return ((lane & 3) << 3) | (((lane >> 2) & 3) << 6) | (((lane >> 4) & 1) << 5) | (((lane >> 5) & 1) << 8); }
constexpr int v_rd_off(int d0, int ks, int half) { return d0 * 512 + ks * 4096 + half * 2048; }
__device__ __forceinline__ int crow(int r, int hi) { return (r & 3) + 8 * (r >> 2) + 4 * hi; }
__device__ __forceinline__ unsigned cvtpk(float lo, float hi) { return cvt_pk_bf16_rne(lo, hi); }
__device__ __forceinline__ bf16x8 load8(const bf16_t* p) { return *reinterpret_cast<const bf16x8*>(p); }
__device__ __forceinline__ void mask_tile(f32x16& p0, f32x16& p1, int dq) {
    const float NEG = -__builtin_inff();
#pragma unroll
    for (int r = 0; r < 16; ++r) { const int c = (r & 3) + 8 * (r >> 2); if (dq - c < 0) p0[r] = NEG; if (dq - c - 32 < 0) p1[r] = NEG; }
}
__device__ __forceinline__ void partialSM(f32x16& p0, f32x16& p1, float& m_reg, float& mn, float& alpha) {
    float pmax = p0[0];
#pragma unroll
    for (int r = 1; r < 16; ++r) pmax = fmaxf(pmax, p0[r]);
#pragma unroll
    for (int r = 0; r < 16; ++r) pmax = fmaxf(pmax, p1[r]);
    { auto rr = __builtin_amdgcn_permlane32_swap(__float_as_uint(pmax), __float_as_uint(pmax), false, false);
      pmax = fmaxf(__uint_as_float(rr[0]), __uint_as_float(rr[1])); }
    if (__builtin_expect(__all((pmax - m_reg) * SCALE <= THR), 1)) { mn = m_reg; alpha = 1.f; }
    else { mn = fmaxf(m_reg, pmax); alpha = __builtin_amdgcn_exp2f((m_reg - mn) * C2); m_reg = mn; }
    const float mnL = -mn * C2;
#pragma unroll
    for (int r = 0; r < 16; ++r) p0[r] = fmaf(p0[r], C2, mnL);
#pragma unroll
    for (int r = 0; r < 16; ++r) p1[r] = fmaf(p1[r], C2, mnL);
#pragma unroll
    for (int r = 0; r < 16; ++r) p0[r] = __builtin_amdgcn_exp2f(p0[r]);
}
__device__ __forceinline__ void finishSM(f32x16& p0, f32x16& p1, float alpha, float& l_reg, bf16x8& pa0, bf16x8& pa1, bf16x8& pa2, bf16x8& pa3) {
#pragma unroll
    for (int r = 0; r < 16; ++r) p1[r] = __builtin_amdgcn_exp2f(p1[r]);
    float ps = 0;
#pragma unroll
    for (int r = 0; r < 16; ++r) ps += p0[r];
#pragma unroll
    for (int r = 0; r < 16; ++r) ps += p1[r];
    { auto rr = __builtin_amdgcn_permlane32_swap(__float_as_uint(ps), __float_as_uint(ps), false, false);
      ps = __uint_as_float(rr[0]) + __uint_as_float(rr[1]); }
    l_reg = l_reg * alpha + ps;
#define PK4(P, B_, OUT) do { unsigned a0 = cvtpk(P[B_+0], P[B_+1]), a1 = cvtpk(P[B_+2], P[B_+3]);                          \
        unsigned b0 = cvtpk(P[B_+4], P[B_+5]), b1 = cvtpk(P[B_+6], P[B_+7]);                                             \
        auto r0 = __builtin_amdgcn_permlane32_swap(a0, b0, false, false); auto r1 = __builtin_amdgcn_permlane32_swap(a1, b1, false, false); \
        u32x4 w = {r0[0], r1[0], r0[1], r1[1]}; OUT = *reinterpret_cast<bf16x8*>(&w); } while (0)
    PK4(p0, 0, pa0); PK4(p0, 8, pa1); PK4(p1, 0, pa2); PK4(p1, 8, pa3);
#undef PK4
}
template <int KB>
__device__ __forceinline__ void qkt(f32x16& p0, f32x16& p1, const char* K_lds, int r32, int hi, const bf16x8* qr, const float* bk) {
#pragma unroll
    for (int j = 0; j < 4; ++j) { const f32x4 b0 = *(const f32x4*)(bk + 8 * j), b1 = *(const f32x4*)(bk + 32 + 8 * j);
#pragma unroll
        for (int e = 0; e < 4; ++e) { p0[4 * j + e] = b0[e]; p1[4 * j + e] = b1[e]; } }
    const char* kb[4];
#pragma unroll
    for (int dd = 0; dd < 4; ++dd) kb[dd] = K_lds + KB * SHM_K + KSWZ(r32, (dd * 16 + hi * 8) * 2);
#pragma unroll
    for (int d0 = 0; d0 < 8; ++d0) { const char* a = kb[d0 & 3] + (d0 >> 2) * 128;
        bf16x8 b0 = *reinterpret_cast<const bf16x8*>(a);
        bf16x8 b1 = *reinterpret_cast<const bf16x8*>(a + 32 * 256);
        p0 = __builtin_amdgcn_mfma_f32_32x32x16_bf16(b0, qr[d0], p0, 0, 0, 0);
        p1 = __builtin_amdgcn_mfma_f32_32x32x16_bf16(b1, qr[d0], p1, 0, 0, 0); }
}
template <int VB>
__device__ __forceinline__ void pv_tile(f32x16* o, int vb0, bf16x8 pa0, bf16x8 pa1, bf16x8 pa2, bf16x8 pa3) {
#define TRRD(dst, off) asm volatile("ds_read_b64_tr_b16 %0, %1 offset:%2" : "=&v"(dst) : "v"(vb0), "i"(off) : "memory")
#define PV_D0(d0) do { s16x4 l0, l1, l2, l3, h0, h1, h2, h3; constexpr int b_ = VB * SHM_V + v_rd_off(d0, 0, 0); \
        TRRD(l0, b_); TRRD(h0, b_ + 2048); TRRD(l1, b_ + 4096); TRRD(h1, b_ + 6144); TRRD(l2, b_ + 8192); TRRD(h2, b_ + 10240); TRRD(l3, b_ + 12288); TRRD(h3, b_ + 14336); \
        asm volatile("s_waitcnt lgkmcnt(0)" ::: "memory"); SBAR();   \
        o[d0] = __builtin_amdgcn_mfma_f32_32x32x16_bf16(pa0, (bf16x8){l0[0], l0[1], l0[2], l0[3], h0[0], h0[1], h0[2], h0[3]}, o[d0], 0, 0, 0);   \
        o[d0] = __builtin_amdgcn_mfma_f32_32x32x16_bf16(pa1, (bf16x8){l1[0], l1[1], l1[2], l1[3], h1[0], h1[1], h1[2], h1[3]}, o[d0], 0, 0, 0);   \
        o[d0] = __builtin_amdgcn_mfma_f32_32x32x16_bf16(pa2, (bf16x8){l2[0], l2[1], l2[2], l2[3], h2[0], h2[1], h2[2], h2[3]}, o[d0], 0, 0, 0);   \
        o[d0] = __builtin_amdgcn_mfma_f32_32x32x16_bf16(pa3, (bf16x8){l3[0], l3[1], l3[2], l3[3], h3[0], h3[1], h3[2], h3[3]}, o[d0], 0, 0, 0); } while (0)
    PV_D0(0); PV_D0(1); PV_D0(2); PV_D0(3);
#undef PV_D0
#undef TRRD
}
struct BlockRef { const bf16_t* Q; const bf16_t* K; const bf16_t* V; bf16_t* O; int P0; };
struct Seam { bf16x8 qr[8]; bf16x8 st_v0, st_v1, st_k0, st_k1; };
#define ROW(p, k0, rr) ((p) + (size_t)((k0) + (rr)) * LD + sc)
#define VMW() asm volatile("s_waitcnt vmcnt(0)" ::: "memory")
#define VMWN(n) asm volatile("s_waitcnt vmcnt(%0)" :: "i"(n) : "memory")
#define SLOAD_H(Kp, Vp, k0) do { S.st_v0 = load8(ROW(Vp, k0, sr)); S.st_v1 = load8(ROW(Vp, k0, 32 + sr));              \
                         S.st_k0 = load8(ROW(Kp, k0, sr)); S.st_k1 = load8(ROW(Kp, k0, 32 + sr)); } while (0)
#define SWRITE_HK(bf) do { *(bf16x8*)(K_lds + (bf) * SHM_K + kws) = S.st_k0; *(bf16x8*)(K_lds + (bf) * SHM_K + kws + 32 * 256) = S.st_k1; } while (0)
#define SWRITE_HV(bf) do { *(bf16x8*)(V_lds + (bf) * SHM_V + vst0) = S.st_v0; *(bf16x8*)(V_lds + (bf) * SHM_V + vst1) = S.st_v1; } while (0)
#define SWRITE_H(bf) do { SWRITE_HV(bf); SWRITE_HK(bf); } while (0)
__device__ __forceinline__ void prime(const BlockRef& cur, char* lds, Seam& S, const int wv) {
    int tid_ = wv * 64 + (int)__builtin_amdgcn_mbcnt_hi(~0u, __builtin_amdgcn_mbcnt_lo(~0u, 0u)); asm volatile("" : "+v"(tid_)); const int tid = tid_, wid = __builtin_amdgcn_readfirstlane(tid >> 6), lane = tid & 63, r32 = lane & 31, hi = lane >> 5;
    const int sr = tid >> 4, sc = (tid & 15) * 8, kws = KSWZ(sr, sc * 2); char* K_lds = lds + 2 * SHM_V;
#pragma unroll
    for (int d0 = 0; d0 < 8; ++d0) S.qr[d0] = load8(cur.Q + (size_t)(wid * QBLK + r32) * LD + d0 * 16 + hi * 8);
    SLOAD_H(cur.K, cur.V, 0); VMW(); SWRITE_HK(0);
    __syncthreads();
}
__device__ __forceinline__ void block(const BlockRef& cur, const BlockRef& nxt, int ntiles_max, char* lds, const float* bias, Seam& S, const int wv) {
    int tid_ = wv * 64 + (int)__builtin_amdgcn_mbcnt_hi(~0u, __builtin_amdgcn_mbcnt_lo(~0u, 0u)); asm volatile("" : "+v"(tid_)); const int tid = tid_, wid = __builtin_amdgcn_readfirstlane(tid >> 6), lane = tid & 63, r32 = lane & 31, hi = lane >> 5;
    int j_hi = (cur.P0 + QB - 1) / KVBLK + 1; if (j_hi > ntiles_max) j_hi = ntiles_max;
    const int NT = j_hi;
    const int qlo = cur.P0 + wid * QBLK, qm = qlo + r32 - 4 * hi;
    char* V_lds = lds; char* K_lds = lds + 2 * SHM_V;
    float* ws = (float*)(lds + 2 * SHM_V + 2 * SHM_K) + wid * 64; float* li_l = ws, * al_l = ws + 32;
    const float* bk = bias + 4 * hi;
    float m_reg = -1e30f, l_reg = 0; f32x16 o[4] = {};
    const int sr = tid >> 4, sc = (tid & 15) * 8, vst0 = v_st(sr, sc), vst1 = v_st(32 + sr, sc), kws = KSWZ(sr, sc * 2);
    const int vb0 = (int)(uintptr_t)V_lds + v_rd_base(lane);
    const bf16_t* Kh = cur.K; const bf16_t* Vh = cur.V;
#define RESC(a) do { if (__any((a) < 1.f)) { if (hi == 0) al_l[r32] = (a); asm volatile("s_waitcnt lgkmcnt(0)" ::: "memory");              \
                     for (int d_ = 0; d_ < 4; ++d_) for (int r = 0; r < 16; ++r) o[d_][r] *= al_l[crow(r, hi)]; } } while (0)
#define KBASE(t) ((t) * KVBLK)
#define MASKT(P0_, P1_, t) do { const int kb_ = KBASE(t); if (kb_ + KVBLK - 1 > qlo) mask_tile(P0_, P1_, qm - kb_); } while (0)
    constexpr int NQL = 8;
#define SEAM_K0() do { VMWN(NQL); SWRITE_HK(0); SBAR(); } while (0)
    f32x16 pA0, pA1, pB0, pB1; float mnA, mnB, alA, alB; bf16x8 pa0, pa1, pa2, pa3;
    SWRITE_HV(0); SBAR();
    if (NT > 1) { SLOAD_H(Kh, Vh, KBASE(1)); }
    SBAR(); qkt<0>(pA0, pA1, K_lds, r32, hi, S.qr, bk + KBASE(0));
    MASKT(pA0, pA1, 0); partialSM(pA0, pA1, m_reg, mnA, alA);
    if (NT > 1) { VMW(); SWRITE_H(1); }
    __syncthreads();
#define HALF_STEP(PX0, PX1, mnX, alX, PY0, PY1, alY, t, KB, VB, SB) do {                                                      \
        SBAR(); qkt<KB>(PX0, PX1, K_lds, r32, hi, S.qr, bk + KBASE(t));                                             \
        finishSM(PY0, PY1, alY, l_reg, pa0, pa1, pa2, pa3); SBAR();                                                           \
        if ((t) + 1 < NT) { SLOAD_H(Kh, Vh, KBASE((t) + 1)); SBAR(); }                                               \
        pv_tile<VB>(o, vb0, pa0, pa1, pa2, pa3); MASKT(PX0, PX1, (t)); partialSM(PX0, PX1, m_reg, mnX, alX);                                        \
        __syncthreads();                                                                                                      \
        if ((t) + 1 < NT) { VMW(); SWRITE_H(SB); }                                                                          \
        RESC(alX); __syncthreads(); } while (0)
    for (int t = 1; t + 1 < NT; t += 2) {
        HALF_STEP(pB0, pB1, mnB, alB, pA0, pA1, alA, t, 1, 0, 0);
        HALF_STEP(pA0, pA1, mnA, alA, pB0, pB1, alB, t + 1, 0, 1, 1);
    }
    const bool even = (NT & 1) == 0;
    if (even) { SBAR(); qkt<1>(pB0, pB1, K_lds, r32, hi, S.qr, bk + KBASE(NT - 1)); SBAR(); }
    SLOAD_H(nxt.K, nxt.V, 0); SBAR();
#pragma unroll
    for (int d0 = 0; d0 < 8; ++d0) S.qr[d0] = load8(nxt.Q + (size_t)(wid * QBLK + r32) * LD + d0 * 16 + hi * 8);
    SBAR();
    finishSM(pA0, pA1, alA, l_reg, pa0, pa1, pa2, pa3); SBAR();
    pv_tile<0>(o, vb0, pa0, pa1, pa2, pa3);
    if (even) { MASKT(pB0, pB1, NT - 1); partialSM(pB0, pB1, m_reg, mnB, alB); __syncthreads(); RESC(alB);
        finishSM(pB0, pB1, alB, l_reg, pa0, pa1, pa2, pa3); SBAR(); pv_tile<1>(o, vb0, pa0, pa1, pa2, pa3); }
    SBAR(); SEAM_K0();
    if (hi == 0) li_l[r32] = l_reg; asm volatile("s_waitcnt lgkmcnt(0)" ::: "memory");
    float rli[16];
#pragma unroll
    for (int r = 0; r < 16; ++r) rli[r] = __builtin_amdgcn_rcpf(li_l[crow(r, hi)]);
    bf16_t* Ow = cur.O + (size_t)(wid * QBLK) * LD;
#pragma unroll
    for (int r = 0; r < 16; ++r) { const int orow = crow(r, hi);
#pragma unroll
        for (int d0 = 0; d0 < 4; ++d0) { const float v = o[d0][r] * rli[r];
            const float vn = xl::xor1(v);
            if ((r32 & 1) == 0) *(unsigned*)(Ow + (size_t)orow * LD + d0 * 32 + r32) = cvtpk(v, vn); } }
    __syncthreads();
#undef RESC
#undef KBASE
#undef MASKT
#undef SEAM_K0
#undef HALF_STEP
}
#undef ROW
#undef VMW
#undef VMWN
#undef SLOAD_H
#undef SWRITE_HK
#undef SWRITE_HV
#undef SWRITE_H
#undef KSWZ
#undef SBAR
}

namespace sa {
typedef unsigned short bf16_t;
typedef short bf16x8 __attribute__((ext_vector_type(8)));
typedef float f32x4 __attribute__((ext_vector_type(4)));
typedef unsigned u32x4 __attribute__((ext_vector_type(4)));
typedef unsigned u32x2 __attribute__((ext_vector_type(2)));
constexpr int LD = 1024;
constexpr float C2 = 0.08838834764831845f * 1.4426950408889634f;
constexpr int PART_OFF = 36864, PART_STRIDE = 8320;
struct Item { const float* Kc; const float* Vc; int nk; const float* Kn; const float* Vn; const bf16_t* Q; bf16_t* O; };
__device__ __forceinline__ unsigned cvtpk(float lo, float hi) { return cvt_pk_bf16_rne(lo, hi); }
__device__ __forceinline__ bf16x8 pack8(f32x4 a, f32x4 b) { u32x4 w = {cvtpk(a[0], a[1]), cvtpk(a[2], a[3]), cvtpk(b[0], b[1]), cvtpk(b[2], b[3])}; return *reinterpret_cast<bf16x8*>(&w); }
struct TileRegs { f32x4 ka[4][2]; f32x4 va[4][2]; };
__device__ __forceinline__ void tile_load(TileRegs& T, const float* K, const float* V, int lane) {
    const int q = lane & 15, g = lane >> 4;
    const float* kp = K + (size_t)q * LD + 8 * g;
#pragma unroll
    for (int s = 0; s < 4; ++s) { T.ka[s][0] = *(const f32x4*)(kp + 32 * s); T.ka[s][1] = *(const f32x4*)(kp + 32 * s + 4); }
#pragma unroll
    for (int v = 0; v < 4; ++v) { const float* vp = V + (size_t)(4 * g + v) * LD + 8 * q; T.va[v][0] = *(const f32x4*)vp; T.va[v][1] = *(const f32x4*)(vp + 4); }
}
template <bool ISNEW>
__device__ __forceinline__ void tile_compute(const TileRegs& T, const bf16x8 (&qf)[4], const float* bias_t, f32x4 (&o)[8], float& m, float& l, int lane) {
    const int q = lane & 15, g = lane >> 4;
    f32x4 s4 = {0.f, 0.f, 0.f, 0.f};
#pragma unroll
    for (int s = 0; s < 4; ++s) s4 = __builtin_amdgcn_mfma_f32_16x16x32_bf16(pack8(T.ka[s][0], T.ka[s][1]), qf[s], s4, 0, 0, 0);
    const f32x4 b = *(const f32x4*)(bias_t + 4 * g);
    float t[4];
#pragma unroll
    for (int v = 0; v < 4; ++v) { t[v] = fmaf(s4[v], C2, b[v]); if (ISNEW && (4 * g + v) > q) t[v] = -__builtin_inff(); }
    float pmax = fmaxf(fmaxf(t[0], t[1]), fmaxf(t[2], t[3]));
    pmax = xl::max_xor16(pmax); pmax = xl::max_xor32(pmax);
    const float mn = fmaxf(m, pmax), alpha = __builtin_amdgcn_exp2f(m - mn); m = mn;
    float p[4];
#pragma unroll
    for (int v = 0; v < 4; ++v) p[v] = __builtin_amdgcn_exp2f(t[v] - mn);
    l = l * alpha + ((p[0] + p[1]) + (p[2] + p[3]));
    if (__any(alpha != 1.f)) {
#pragma unroll
        for (int j = 0; j < 8; ++j) o[j] = o[j] * alpha; }
#pragma unroll
    for (int v = 0; v < 4; ++v)
#pragma unroll
        for (int j = 0; j < 8; ++j) o[j] = __builtin_amdgcn_mfma_f32_16x16x4f32(T.va[v][j >> 2][j & 3], p[v], o[j], 0, 0, 0);
}
__device__ __forceinline__ void run_item(const Item& it, char* lds, const int wv) {
    int tid_ = wv * 64 + (int)__builtin_amdgcn_mbcnt_hi(~0u, __builtin_amdgcn_mbcnt_lo(~0u, 0u)); asm volatile("" : "+v"(tid_)); const int tid = tid_, wid = __builtin_amdgcn_readfirstlane(tid >> 6), lane = tid & 63, q = lane & 15, g = lane >> 4;
    const float* bias = (const float*)lds;
    bf16x8 qf[4];
#pragma unroll
    for (int s = 0; s < 4; ++s) qf[s] = *(const bf16x8*)(it.Q + (size_t)q * LD + 32 * s + 8 * g);
    f32x4 o[8];
#pragma unroll
    for (int j = 0; j < 8; ++j) o[j] = (f32x4){0.f, 0.f, 0.f, 0.f};
    float m = -1e30f, l = 0.f;
    const int nt = it.nk >> 4, t0 = (wid * nt) >> 3, t1 = ((wid + 1) * nt) >> 3;
    TileRegs A, B;
    tile_load(A, it.Kc + (size_t)t0 * 16 * LD, it.Vc + (size_t)t0 * 16 * LD, lane);
    for (int t = t0; t < t1; t += 2) {
        if (t + 1 < t1) tile_load(B, it.Kc + (size_t)(t + 1) * 16 * LD, it.Vc + (size_t)(t + 1) * 16 * LD, lane);
        tile_compute<false>(A, qf, bias + t * 16, o, m, l, lane);
        if (t + 1 < t1) {
            if (t + 2 < t1) tile_load(A, it.Kc + (size_t)(t + 2) * 16 * LD, it.Vc + (size_t)(t + 2) * 16 * LD, lane);
            tile_compute<false>(B, qf, bias + (t + 1) * 16, o, m, l, lane);
        }
    }
    if (wid == 7) { tile_load(A, it.Kn, it.Vn, lane); tile_compute<true>(A, qf, bias + it.nk, o, m, l, lane); }
    l = xl::sum_xor16(l); l = xl::sum_xor32(l);
    float* part = (float*)(lds + PART_OFF + wid * PART_STRIDE);
    if (g == 0) { part[q] = m; part[16 + q] = l; }
#pragma unroll
    for (int j = 0; j < 8; ++j)
#pragma unroll
        for (int v = 0; v < 4; ++v) part[32 + q * 128 + 32 * g + 8 * v + j] = o[j][v];
    __syncthreads();
    {   const int qq = tid >> 5, d4 = (tid & 31) * 4;
        float mw[8], M = -1e30f;
#pragma unroll
        for (int w = 0; w < 8; ++w) { mw[w] = ((const float*)(lds + PART_OFF + w * PART_STRIDE))[qq]; M = fmaxf(M, mw[w]); }
        float den = 0.f; f32x4 num = {0.f, 0.f, 0.f, 0.f};
#pragma unroll
        for (int w = 0; w < 8; ++w) { const float* pw = (const float*)(lds + PART_OFF + w * PART_STRIDE); const float e = __builtin_amdgcn_exp2f(mw[w] - M);
            den += e * pw[16 + qq]; num += *(const f32x4*)(pw + 32 + qq * 128 + d4) * e; }
        const float inv = 1.0f / den; u32x2 w2; w2.x = cvtpk(num[0] * inv, num[1] * inv); w2.y = cvtpk(num[2] * inv, num[3] * inv);
        *(u32x2*)(it.O + (size_t)qq * LD + d4) = w2; }
    __syncthreads();
}
}
#define GAS __attribute__((address_space(1)))
#define LAS __attribute__((address_space(3)))
typedef unsigned short bf16;
typedef unsigned v4u __attribute__((ext_vector_type(4)));
typedef float f32x4 __attribute__((ext_vector_type(4)));
typedef short bf16x8 __attribute__((ext_vector_type(8)));
typedef GAS unsigned gu32;
typedef GAS unsigned long long gu64;
#define RLX_AGENT __ATOMIC_RELAXED, __HIP_MEMORY_SCOPE_AGENT
#define LDS_WAIT() asm volatile("s_waitcnt lgkmcnt(0)" ::: "memory")
#define VM_WAIT() asm volatile("s_waitcnt vmcnt(0)" ::: "memory")
__device__ __forceinline__ unsigned long long rt() { return __builtin_amdgcn_s_memrealtime(); }
__device__ __forceinline__ unsigned f2bf(float f) { unsigned u = __builtin_bit_cast(unsigned, f); return (u + 0x7fffu + ((u >> 16) & 1u)) >> 16; }
__device__ __forceinline__ unsigned pk2(float lo, float hi) { return f2bf(lo) | (f2bf(hi) << 16); }

#define XB_TMO      128
#define XB_XCNT(j)  (256  + 64 * (j))
#define XB_XSUB(j)  (1280 + 64 * (j))
#define XB_XGEN(j)  (2304 + 64 * (j))
#define XB_TOP      3328
#define XB_TOPGEN   3392
#define XCD_BAR_WORDS 3456
#define XB_SPIN_CAP (1u << 18)

__device__ __forceinline__ unsigned xb_ld(unsigned* p)              { return __hip_atomic_load(p, __ATOMIC_RELAXED, __HIP_MEMORY_SCOPE_AGENT); }
__device__ __forceinline__ unsigned xb_add(unsigned* p, unsigned v) { return __hip_atomic_fetch_add(p, v, __ATOMIC_RELAXED, __HIP_MEMORY_SCOPE_AGENT); }
__device__ __forceinline__ unsigned xb_xcc_id() { return (unsigned)__builtin_amdgcn_s_getreg((3 << 11) | 20) & 0xFu; }
#define XB_SPIN(cond, bar) do { unsigned _sp = 0; while (cond) { __builtin_amdgcn_s_sleep(1); \
    if ((++_sp & 255u) == 0u) { if (xb_ld(&(bar)[XB_TMO])) break; if (_sp > XB_SPIN_CAP) { atomicAdd(&(bar)[XB_TMO], 1u); break; } } } } while (0)

struct XcdBarrier {
    unsigned* bar; unsigned x;
    volatile LAS unsigned* st;
};

__device__ __forceinline__ XcdBarrier xcd_barrier_post(unsigned* bar, volatile LAS unsigned* st) {
    XcdBarrier b; b.bar = bar; b.x = xb_xcc_id(); b.st = st;
    if (threadIdx.x == 0) (void)xb_add(&bar[XB_XCNT(b.x)], 1u);
    return b;
}
__device__ __forceinline__ void xcd_barrier_complete(unsigned* bar, unsigned x, unsigned& nloc, unsigned& nx) {
    const unsigned G = gridDim.x * gridDim.y * gridDim.z;
    unsigned sum, cnt, mine, sp = 0u;
    for (;;) {
        sum = 0u; cnt = 0u; mine = 0u;
#pragma unroll
        for (unsigned j = 0; j < 16; ++j) { const unsigned c = xb_ld(&bar[XB_XCNT(j)]); sum += c; cnt += (c > 0u) ? 1u : 0u; mine = (j == x) ? c : mine; }
        if (sum == G) break;
        __builtin_amdgcn_s_sleep(1);
        if ((++sp & 255u) == 0u) { if (xb_ld(&bar[XB_TMO])) break; if (sp > XB_SPIN_CAP) { atomicAdd(&bar[XB_TMO], 1u); break; } }
    }
    nloc = mine > 0u ? mine : 1u; nx = cnt > 0u ? cnt : 1u;
}

__device__ __forceinline__ void xcd_barrier(const XcdBarrier& b) {
    asm volatile("s_waitcnt vmcnt(0)" ::: "memory");
    __syncthreads();
    if (threadIdx.x == 0) {
        unsigned* bar = b.bar;
        __builtin_amdgcn_s_waitcnt(0);
        unsigned nloc = b.st[0], nx = b.st[1];
        if (nloc == 0u) { xcd_barrier_complete(bar, b.x, nloc, nx); b.st[0] = nloc; b.st[1] = nx; }
        const unsigned old = xb_add(&bar[XB_XSUB(b.x)], 1u);
        const unsigned gen = old / nloc;
        if (old + 1u == (gen + 1u) * nloc) {
            __builtin_amdgcn_fence(__ATOMIC_RELEASE, "agent");
            asm volatile("s_waitcnt vmcnt(0)" ::: "memory");
            const unsigned og = xb_add(&bar[XB_TOP], 1u);
            const unsigned tg = og / nx;
            if (og + 1u == (tg + 1u) * nx) xb_add(&bar[XB_TOPGEN], 1u);
            else XB_SPIN(xb_ld(&bar[XB_TOPGEN]) == tg, bar);
            __builtin_amdgcn_fence(__ATOMIC_ACQUIRE, "agent");
            xb_add(&bar[XB_XGEN(b.x)], 1u);
            asm volatile("s_waitcnt vmcnt(0)" ::: "memory");
        } else {
            XB_SPIN(xb_ld(&bar[XB_XGEN(b.x)]) == gen, bar);
            __builtin_amdgcn_fence(__ATOMIC_ACQUIRE, "agent");
            asm volatile("s_waitcnt vmcnt(0)" ::: "memory");
        }
    }
    __syncthreads();
}
using pg8::MP; using pg8::MREAL; using pg8::NSAMP; using pg8::LPR;
constexpr int NWAVES = 8;
constexpr size_t MiB = 1u << 20;
constexpr size_t WS_CTL = 0, CTL_ZERO_BYTES = 1 * MiB;
constexpr int CW_BAR = 4096;
constexpr size_t SSQ_OFF = 808 * MiB;
constexpr size_t WS_BIAS1 = 1 * MiB;
constexpr size_t WS_W1T = 2 * MiB, WS_WPCT = 84 * MiB, WS_WPAT = 92 * MiB, WS_WOT = 100 * MiB, WS_WUPT = 116 * MiB, WS_WDNT = 180 * MiB;
constexpr size_t WS_X = 212 * MiB, WS_XB = 280 * MiB, WS_Q = 314 * MiB, WS_K = 331 * MiB, WS_V = 348 * MiB, WS_P = 365 * MiB, WS_BC = 382 * MiB, WS_YC = 399 * MiB, WS_YA = 416 * MiB;
constexpr size_t WS_SGC = 433 * MiB, WS_SGA = 467 * MiB, WS_T1 = 501 * MiB, WS_MG = 569 * MiB, WS_U = 603 * MiB, WS_G = 739 * MiB, WS_LOGF = 807 * MiB, WS_END = 814 * MiB;
static_assert(WS_W1T + 2ull * 10496 * 2048 * 2 <= WS_WPCT && WS_WUPT + 2ull * 8192 * 2048 * 2 <= WS_WDNT && WS_WDNT + 2ull * 2048 * 4096 * 2 <= WS_X, "weight map");
static_assert(WS_X + (size_t)MP * 2048 * 4 <= WS_XB && WS_XB + (size_t)MP * 2048 * 2 <= WS_Q && WS_Q + (size_t)MP * 1024 * 2 <= WS_K && WS_T1 + (size_t)MP * 2048 * 4 <= WS_MG, "activation map");
static_assert(WS_U + (size_t)MP * 8192 * 2 <= WS_G && WS_G + (size_t)MP * 4096 * 2 <= WS_LOGF && WS_LOGF + (size_t)MP * 8 * 4 <= SSQ_OFF && SSQ_OFF + 5ull * MP * 32 * 4 <= WS_END, "map");
constexpr int RING_OFF = 0, RING_BYTES = 131072;
constexpr int LDS_BYTES = 147456, LDSCTL_OFF = 146944;
constexpr int ATT_BIAS_OFF = 69632;
constexpr int SCAN_SCR_OFF = 103424;
constexpr int TR_PITCH = 65, TR_BYTES = 64 * TR_PITCH * 4;
static_assert(NWAVES * TR_BYTES <= LDSCTL_OFF && pa::LDS_ATT <= ATT_BIAS_OFF && ATT_BIAS_OFF + 8448 * 4 <= SCAN_SCR_OFF && sa::PART_OFF + 8 * sa::PART_STRIDE <= SCAN_SCR_OFF, "LDS map");
constexpr float LOG2E = 1.4426950408889634f;

struct Frame {
    LAS unsigned char* lds; volatile LAS unsigned* MISC; gu32* ctl;
    int wv, G, bx;
};
__device__ __forceinline__ int opaque_s(int v) { asm volatile("" : "+s"(v)); return v; }
__device__ __forceinline__ int lane_id() { return (int)__builtin_amdgcn_mbcnt_hi(~0u, __builtin_amdgcn_mbcnt_lo(~0u, 0u)); }
__device__ __forceinline__ int phase_tid(const Frame& F) { int t = F.wv * 64 + lane_id(); asm volatile("" : "+v"(t)); return t; }
struct MapIdent { __device__ __forceinline__ int operator()(int n) const { return n; } };
struct MapIn { __device__ __forceinline__ int operator()(int n) const {
    const int T = n >> 8, c = n & 255;
    if (T < 16) { const int bj = c >> 7, wc = (c >> 5) & 3, nn = (c >> 4) & 1, fq = (c >> 2) & 3, e = c & 3; return (bj * 2 + nn) * 1024 + 64 * T + 16 * wc + 4 * fq + e; }
    if (T < 24) return 4096 + ((T - 16) << 8) + c;
    if (T < 40) return 6152 + ((T - 24) << 8) + c;
    return c < 8 ? 6144 + c : -1; } };
struct MapUp { __device__ __forceinline__ int operator()(int n) const { const int T = n >> 8, c = n & 255; return (c >> 7) * 4096 + 128 * T + (c & 127); } };
template <class Map>
__device__ __forceinline__ void transpose_item(const float* __restrict__ W, int K, int Nsrc, const float* __restrict__ gsc, bf16* __restrict__ WT, int k0, int n0, LAS float* scr, int lane, Map map) {
    const int nloc = (lane & 15) * 4, src = map(n0 + nloc), kr = lane >> 4;
    f32x4 v[16];
#pragma unroll
    for (int i = 0; i < 16; ++i) { const int kk = kr + 4 * i; v[i] = src >= 0 ? *(const GAS f32x4*)(W + (size_t)(k0 + kk) * Nsrc + src) : (f32x4){0.f, 0.f, 0.f, 0.f}; }
#pragma unroll
    for (int i = 0; i < 16; ++i) { const int kk = kr + 4 * i; const float g = gsc ? gsc[k0 + kk] : 1.0f; LAS float* s = scr + kk * TR_PITCH + nloc;
        s[0] = v[i][0] * g; s[1] = v[i][1] * g; s[2] = v[i][2] * g; s[3] = v[i][3] * g; }
    const int c = lane & 7;
#pragma unroll
    for (int j = 0; j < 8; ++j) { const int n = (lane >> 3) + 8 * j; const LAS float* s = scr + (8 * c) * TR_PITCH + n;
        v4u o; o.x = pk2(s[0 * TR_PITCH], s[1 * TR_PITCH]); o.y = pk2(s[2 * TR_PITCH], s[3 * TR_PITCH]); o.z = pk2(s[4 * TR_PITCH], s[5 * TR_PITCH]); o.w = pk2(s[6 * TR_PITCH], s[7 * TR_PITCH]);
        *(GAS v4u*)(WT + (size_t)(n0 + n) * K + k0 + 8 * c) = o; }
}
template <class Map>
__device__ __forceinline__ void transpose_matrix(Frame& F, const float* W, int K, int Nsrc, int Ndst, const float* gsc, bf16* WT, Map map) {
    LAS float* scr = (LAS float*)(F.lds + F.wv * TR_BYTES); const int lane = phase_tid(F) & 63;
    const int gw = F.bx * NWAVES + F.wv, NGW = F.G * NWAVES, nkb = K / 64, nnb = Ndst / 64;
    for (int it = gw; it < nkb * nnb; it += NGW) { const int kb = it / nnb, nb = it % nnb; transpose_item(W, K, Nsrc, gsc, WT, kb * 64, nb * 64, scr, lane, map); }
}
typedef __attribute__((address_space(4))) const unsigned char* kptr_t;
__device__ __forceinline__ kptr_t kargs() { kptr_t p = (kptr_t)__builtin_amdgcn_kernarg_segment_ptr(); asm volatile("" : "+s"(p)); return p; }
#define ARG_IN(i) (*(const __attribute__((address_space(4))) float* const __attribute__((address_space(4)))*)(kargs() + 8 * (i)))
struct Args { const float* in[21]; float* out; unsigned char* ws; int pad0, pad1; };

__device__ __forceinline__ void phase_conv_yc(Frame& F, const bf16* P, const bf16* BC, bf16* YC, const float* wconv  , const float* state  ) {
    const int NT = F.G * NWAVES * 64, t0 = F.bx * NWAVES * 64 + phase_tid(F);
    for (int idx = t0; idx < MREAL * 128; idx += NT) {
        const int row = idx >> 7, c8 = (idx & 127) * 8;
        const v4u bcv = *(const GAS v4u*)(BC + (size_t)row * 1024 + c8), p0v = *(const GAS v4u*)(P + (size_t)row * 1024 + c8);
        float pm1[8], pm2[8];
        int t; const float* st = nullptr;
        if (row < NSAMP) { t = row & 15; st = state + (size_t)(row >> 4) * 2048 + c8; } else { t = row - NSAMP; }
        if (t >= 1) { const v4u w = *(const GAS v4u*)(P + (size_t)(row - 1) * 1024 + c8);
#pragma unroll
            for (int e = 0; e < 4; ++e) { pm1[2 * e] = __uint_as_float(w[e] << 16); pm1[2 * e + 1] = __uint_as_float(w[e] & 0xffff0000u); } }
        else {
#pragma unroll
            for (int e = 0; e < 8; ++e) pm1[e] = st ? st[1024 + e] : 0.f; }
        if (t >= 2) { const v4u w = *(const GAS v4u*)(P + (size_t)(row - 2) * 1024 + c8);
#pragma unroll
            for (int e = 0; e < 4; ++e) { pm2[2 * e] = __uint_as_float(w[e] << 16); pm2[2 * e + 1] = __uint_as_float(w[e] & 0xffff0000u); } }
        else {
#pragma unroll
            for (int e = 0; e < 8; ++e) pm2[e] = st ? st[(t == 1 ? 1024 : 0) + e] : 0.f; }
        float y[8];
#pragma unroll
        for (int e = 0; e < 8; ++e) { const unsigned pw = p0v[e >> 1], bw = bcv[e >> 1];
            const float p0 = (e & 1) ? __uint_as_float(pw & 0xffff0000u) : __uint_as_float(pw << 16), bcf = (e & 1) ? __uint_as_float(bw & 0xffff0000u) : __uint_as_float(bw << 16);
            y[e] = bcf * (wconv[c8 + e] * pm2[e] + wconv[1024 + c8 + e] * pm1[e] + wconv[2048 + c8 + e] * p0); }
        v4u o; o.x = pk2(y[0], y[1]); o.y = pk2(y[2], y[3]); o.z = pk2(y[4], y[5]); o.w = pk2(y[6], y[7]);
        *(GAS v4u*)(YC + (size_t)row * 1024 + c8) = o;
    }
}
__device__ __forceinline__ void load_u8(float (&d)[8], const bf16* p) { const v4u w = *(const GAS v4u*)p;
#pragma unroll
    for (int e = 0; e < 4; ++e) { d[2 * e] = __uint_as_float(w[e] << 16); d[2 * e + 1] = __uint_as_float(w[e] & 0xffff0000u); } }
__device__ __forceinline__ void phase_ffn_gate(Frame& F, const bf16* U, bf16* Gb, const float* wf  , const float* bfc  , const float* state  ) {
    const int NT = F.G * NWAVES * 64, t0 = F.bx * NWAVES * 64 + phase_tid(F);
    for (int idx = t0; idx < MREAL * 512; idx += NT) {
        const int row = idx >> 9, ch = (idx & 511) * 8, ua = 256 * (ch >> 7) + (ch & 127);
        float a0[8], a1[8], a2[8], b0[8], b1[8], b2[8];
        load_u8(a0, U + (size_t)row * 8192 + ua); load_u8(b0, U + (size_t)row * 8192 + ua + 128);
        int t; const float* st = nullptr;
        if (row < NSAMP) { t = row & 15; st = state + (size_t)(row >> 4) * 2 * 8192; } else { t = row - NSAMP; }
        if (t >= 1) { load_u8(a1, U + (size_t)(row - 1) * 8192 + ua); load_u8(b1, U + (size_t)(row - 1) * 8192 + ua + 128); }
        else {
#pragma unroll
            for (int e = 0; e < 8; ++e) { a1[e] = st ? st[8192 + ch + e] : 0.f; b1[e] = st ? st[8192 + 4096 + ch + e] : 0.f; } }
        if (t >= 2) { load_u8(a2, U + (size_t)(row - 2) * 8192 + ua); load_u8(b2, U + (size_t)(row - 2) * 8192 + ua + 128); }
        else { const int so = (t == 1) ? 8192 : 0;
#pragma unroll
            for (int e = 0; e < 8; ++e) { a2[e] = st ? st[so + ch + e] : 0.f; b2[e] = st ? st[so + 4096 + ch + e] : 0.f; } }
        float y[8];
#pragma unroll
        for (int e = 0; e < 8; ++e) { const int ca = ch + e, cb = 4096 + ch + e;
            const float A = wf[ca] * a2[e] + wf[8192 + ca] * a1[e] + wf[16384 + ca] * a0[e] + bfc[ca];
            const float B = wf[cb] * b2[e] + wf[8192 + cb] * b1[e] + wf[16384 + cb] * b0[e] + bfc[cb];
            y[e] = A * pg8::sigmoidf_(A) * B; }
        v4u o; o.x = pk2(y[0], y[1]); o.y = pk2(y[2], y[3]); o.z = pk2(y[4], y[5]); o.w = pk2(y[6], y[7]);
        *(GAS v4u*)(Gb + (size_t)row * 4096 + ch) = o;
    }
}
template <int CH>
__device__ __forceinline__ void block_cumsum(const float* src, int stride, int n, float* dst, float* wtot, float scale, bool subT, int tid) {
    asm volatile("" : "+v"(tid));
    const int lane = tid & 63, wid = tid >> 6, i0 = tid * CH;
    float v[CH]; float run = 0.f;
#pragma unroll
    for (int j = 0; j < CH; ++j) { const int i = i0 + j; const float x = i < n ? src[(size_t)i * stride] : 0.f; run += x; v[j] = run; }
    const float inc = xl::wave_incl_scan(run, lane);
    if (lane == 63) wtot[wid] = inc;
    __syncthreads();
    float off = inc - run, tot = 0.f;
#pragma unroll
    for (int w = 0; w < 8; ++w) { const float x = wtot[w]; if (w < wid) off += x; tot += x; }
    const float sub = subT ? tot : 0.f;
#pragma unroll
    for (int j = 0; j < CH; ++j) if (i0 + j < n) dst[i0 + j] = scale * (off + v[j] - sub);
    __syncthreads();
}

#define GRID_BAR() do { XcdBarrier b_ = bar; asm volatile("" : "+s"(b_.bar), "+s"(b_.x)); xcd_barrier(b_); } while (0)
#ifndef STOP_AFTER
#define STOP_AFTER 0
#endif
__device__ __forceinline__ void diag_dump(int k, int t0, int NT, float* out, unsigned char* ws) {
    const bf16* a = nullptr; const bf16* b = nullptr; const float* x = nullptr; int lda = 1024;
    if (k == 1) { a = (const bf16*)(ws + WS_Q); b = (const bf16*)(ws + WS_P); }
    else if (k == 2) { a = (const bf16*)(ws + WS_YA); b = (const bf16*)(ws + WS_YC); }
#if defined(DIAG_SEL) && DIAG_SEL == 1
    else if (k == 3) { const bf16* w = (const bf16*)(ws + WS_WPCT); const bf16* s = (const bf16*)(ws + WS_SGC);
        for (int i = t0; i < 4 * 1024 * 1024; i += NT) out[i] = __uint_as_float((unsigned)w[i] << 16);
        for (int i = t0; i < 6000 * 2048; i += NT) out[4 * 1024 * 1024 + i] = __uint_as_float((unsigned)s[i] << 16);
        return; }
#elif defined(DIAG_SEL) && DIAG_SEL == 2
    else if (k == 3) { const bf16* w = (const bf16*)(ws + WS_WPCT);
        for (int i = t0; i < 16 * 1024 * 1024; i += NT) out[i] = __uint_as_float((unsigned)w[i] << 16);
        return; }
#else
    else if (k == 3) { x = (const float*)(ws + WS_T1); }
#endif
    else if (k == 4) { a = (const bf16*)(ws + WS_MG); lda = 2048; }
    else if (k == 5 || k == 8) { x = (const float*)(ws + WS_X); }
    else if (k == 6) { a = (const bf16*)(ws + WS_U); lda = 8192; }
    else if (k == 7) { a = (const bf16*)(ws + WS_G); lda = 4096; }
    if (x) { for (int i = t0; i < 8192 * 2048; i += NT) out[i] = x[i]; return; }
    if (b) { for (int i = t0; i < 8192 * 1024; i += NT) { out[i] = __uint_as_float((unsigned)a[i] << 16); out[8192 * 1024 + i] = __uint_as_float((unsigned)b[i] << 16); } return; }
    for (int i = t0; i < 8192 * 2048; i += NT) { const int r = i / 2048, c = i % 2048; out[i] = __uint_as_float((unsigned)a[(size_t)r * lda + c] << 16); }
}
#define STOP_AT(k) do { if (STOP_AFTER != 0 && STOP_AFTER == 10 * l + (k)) { diag_dump(k, F.bx * NWAVES * 64 + phase_tid(F), F.G * NWAVES * 64, KOUT(), KWS()); return; } } while (0)
#define KARG_U64(off) (*(const __attribute__((address_space(4))) unsigned long long*)(kargs() + (off)))
#define KIN(i)  ((const float*)(const GAS float*)KARG_U64(8 * (i)))
#define KOUT()  ((float*)(GAS float*)KARG_U64(168))
#define KWS()   ((unsigned char*)(GAS unsigned char*)KARG_U64(176))
#define WSP(T, off) ((T*)(KWS() + (off)))
__global__ void __launch_bounds__(NWAVES * 64, 2) fwd_kernel(Args args) {
    extern __shared__ __attribute__((aligned(16))) unsigned char lds[];
    Frame F;
    F.lds = (LAS unsigned char*)lds; F.MISC = (volatile LAS unsigned*)(F.lds + LDSCTL_OFF);
    F.wv = __builtin_amdgcn_readfirstlane((int)threadIdx.x >> 6); F.G = gridDim.x; F.bx = blockIdx.x;
    F.ctl = (gu32*)(KWS() + WS_CTL);
    for (int u = threadIdx.x; u < (LDS_BYTES - LDSCTL_OFF) / 4; u += NWAVES * 64) ((LAS unsigned*)(F.lds + LDSCTL_OFF))[u] = 0u;
    __syncthreads();
    XcdBarrier bar = xcd_barrier_post((unsigned*)(F.ctl + CW_BAR), F.MISC + 8);

#ifndef SKIP_P0
#pragma unroll 1
    for (int l = 0; l < 2; ++l) {
        transpose_matrix(F, KIN(9) + (size_t)l * 2048 * 10248, 2048, 10248, 10496, KIN(8) + l * 2048, WSP(bf16, WS_W1T) + (size_t)l * 10496 * 2048, MapIn());
        transpose_matrix(F, KIN(12) + (size_t)l * 1024 * 2048, 1024, 2048, 2048, nullptr, WSP(bf16, WS_WPCT) + (size_t)l * 2048 * 1024, MapIdent());
        transpose_matrix(F, KIN(13) + (size_t)l * 1024 * 2048, 1024, 2048, 2048, nullptr, WSP(bf16, WS_WPAT) + (size_t)l * 2048 * 1024, MapIdent());
        transpose_matrix(F, KIN(14) + (size_t)l * 2048 * 2048, 2048, 2048, 2048, nullptr, WSP(bf16, WS_WOT) + (size_t)l * 2048 * 2048, MapIdent());
        transpose_matrix(F, KIN(16) + (size_t)l * 2048 * 8192, 2048, 8192, 8192, KIN(15) + l * 2048, WSP(bf16, WS_WUPT) + (size_t)l * 8192 * 2048, MapUp());
        transpose_matrix(F, KIN(19) + (size_t)l * 4096 * 2048, 4096, 2048, 2048, nullptr, WSP(bf16, WS_WDNT) + (size_t)l * 2048 * 4096, MapIdent());
    }
    { const int NT = F.G * NWAVES * 64; MapIn mp; const float* b_in = KIN(10); float* BIAS1 = WSP(float, WS_BIAS1);
      for (int i = F.bx * NWAVES * 64 + phase_tid(F); i < 2 * 10496; i += NT) { const int l = i / 10496, n = i % 10496, s = mp(n); BIAS1[i] = s >= 0 ? b_in[l * 10248 + s] : 0.f; } }
    {   const int gw = F.bx * NWAVES + F.wv, NGW = F.G * NWAVES, lane = phase_tid(F) & 63;
        const float* xs = KIN(1); const float* xm = KIN(7); const float* xp = KIN(0); float* X = WSP(float, WS_X); bf16* XB = WSP(bf16, WS_XB); float* SSQ = WSP(float, SSQ_OFF);
        for (int m = gw; m < MP; m += NGW) {
            const float* src = nullptr;
            if (m < NSAMP) src = xs + (size_t)m * 2048; else if (m < NSAMP + 16) src = xm + (size_t)(m - NSAMP) * 2048; else if (m < MREAL) src = xp + (size_t)(m - NSAMP - 16) * 2048;
            float s = 0.f;
#pragma unroll
            for (int j = 0; j < 8; ++j) { const f32x4 v = src ? *(const GAS f32x4*)(src + 256 * j + 4 * lane) : (f32x4){0.f, 0.f, 0.f, 0.f};
                *(GAS f32x4*)(X + (size_t)m * 2048 + 256 * j + 4 * lane) = v; *(GAS unsigned long long*)(XB + (size_t)m * 2048 + 256 * j + 4 * lane) = (unsigned long long)pk2(v[0], v[1]) | ((unsigned long long)pk2(v[2], v[3]) << 32);
                s += (v[0] * v[0] + v[1] * v[1]) + (v[2] * v[2] + v[3] * v[3]); }
            s = xl::wave_sum(s); if (lane < 32) SSQ[(size_t)m * 32 + lane] = lane == 0 ? s : 0.f;
        }
    }
#endif
    GRID_BAR();

#pragma unroll 1
    for (int l = 0; l < 2; ++l) {
#ifndef SKIP_G1
        {   pg8::Gemm g{WSP(bf16, WS_XB), WSP(bf16, WS_W1T) + (size_t)l * 10496 * 2048, MP, 10496, 2048}; pg8::StaticOrder S; S.init(MP, 10496, opaque_s(F.G), opaque_s(F.bx));
            pg8::EpiIn E{WSP(float, SSQ_OFF) + (size_t)(2 * l) * MP * 32, WSP(float, WS_BIAS1) + l * 10496, WSP(bf16, WS_P), WSP(bf16, WS_BC), WSP(bf16, WS_Q), WSP(bf16, WS_K), WSP(bf16, WS_V), WSP(bf16, WS_SGC), WSP(bf16, WS_SGA), WSP(float, WS_LOGF), KOUT(), l};
            pg8::gemm_phase<pg8::EpiIn, pg8::StaticOrder, true, true>(F.lds + RING_OFF, g, S, E, F.wv); }
#endif
        GRID_BAR();
        STOP_AT(1);
#ifndef SKIP_CONV
        phase_conv_yc(F, WSP(bf16, WS_P), WSP(bf16, WS_BC), WSP(bf16, WS_YC), KIN(11) + l * 3072, KIN(5) + (size_t)l * 16 * 2048);
#endif
#ifndef SKIP_PA
        {
            float* bias = (float*)(lds + ATT_BIAS_OFF); float* wtot = (float*)(lds + SCAN_SCR_OFF);
            const bf16* Qb = WSP(bf16, WS_Q); bf16* YA = WSP(bf16, WS_YA); const float* LOGF = WSP(float, WS_LOGF);
            const bf16* Kp = WSP(bf16, WS_K) + (size_t)NSAMP * 1024; const bf16* Vp = WSP(bf16, WS_V) + (size_t)NSAMP * 1024;
            int L = F.bx; const int L2 = (F.bx >= 248) ? 256 + (F.bx - 248) : -1;
            if (L < 264) {
                pa::Seam S; int h = L & 7; const int qb = 32 - (L >> 3);
                pa::BlockRef cur{Qb + (size_t)(NSAMP + 256 * qb) * 1024 + h * 128, Kp + h * 128, Vp + h * 128, YA + (size_t)(NSAMP + 256 * qb) * 1024 + h * 128, 256 * qb};
                pa::prime(cur, (char*)lds, S, F.wv);
                for (;;) {
                    int n = cur.P0 + 256; if (n > 8448) n = 8448;
                    block_cumsum<17>(LOGF + (size_t)NSAMP * 8 + h, 8, n, bias, wtot, -1.0f / pa::SCALE, false, phase_tid(F));
                    pa::BlockRef nxt = cur; const bool more = (L < 256 && L2 >= 0);
                    if (more) { const int h2 = L2 & 7, qb2 = 32 - (L2 >> 3); nxt = pa::BlockRef{Qb + (size_t)(NSAMP + 256 * qb2) * 1024 + h2 * 128, Kp + h2 * 128, Vp + h2 * 128, YA + (size_t)(NSAMP + 256 * qb2) * 1024 + h2 * 128, 256 * qb2}; }
                    pa::block(cur, nxt, 129, (char*)lds, bias, S, F.wv);
                    if (!more) break;
                    cur = nxt; L = L2; h = L2 & 7;
                }
            }
            asm volatile("s_waitcnt vmcnt(0)" ::: "memory"); __syncthreads();
        }
#endif
#ifndef SKIP_SA
        {
            float* bias = (float*)lds; float* wtot = (float*)(lds + SCAN_SCR_OFF);
            for (int itx = F.G - 1 - F.bx; itx < 128; itx += F.G) {
                const int b = itx >> 3, h = itx & 7; const float* LOGF = WSP(float, WS_LOGF); float* out = KOUT();
                block_cumsum<8>(KIN(4) + ((size_t)(l * 16 + b) * 4096) * 8 + h, 8, 4096, bias, wtot, -LOG2E, true, phase_tid(F));
                if (phase_tid(F) == 0) { float c = 0.f; for (int j = 0; j < 16; ++j) { c += LOGF[(size_t)(b * 16 + j) * 8 + h]; bias[4096 + j] = -LOG2E * c; } }
                __syncthreads();
                sa::Item it; const size_t cb = ((size_t)(l * 16 + b) * 4096) * 1024 + h * 128;
                it.Kc = KIN(2) + cb; it.Vc = KIN(3) + cb; it.nk = 4096;
                it.Kn = out + pg8::OFF_KS + ((size_t)l * 256 + b * 16) * 1024 + h * 128; it.Vn = out + pg8::OFF_VS + ((size_t)l * 256 + b * 16) * 1024 + h * 128;
                it.Q = WSP(bf16, WS_Q) + (size_t)(b * 16) * 1024 + h * 128; it.O = WSP(bf16, WS_YA) + (size_t)(b * 16) * 1024 + h * 128;
                sa::run_item(it, (char*)lds, F.wv);
            }
        }
#endif
        GRID_BAR();
        STOP_AT(2);
#ifndef SKIP_G2
        {   pg8::Gemm g{WSP(bf16, WS_YC), WSP(bf16, WS_WPCT) + (size_t)l * 2048 * 1024, MP, 2048, 1024}; pg8::StaticOrder S; S.init(MP, 2048, opaque_s(F.G), opaque_s(F.bx));
            pg8::EpiGate1 E{WSP(bf16, WS_SGC), WSP(float, WS_T1)}; pg8::gemm_phase<pg8::EpiGate1, pg8::StaticOrder, true, true>(F.lds + RING_OFF, g, S, E, F.wv); }
        GRID_BAR();
        STOP_AT(3);
        {   pg8::Gemm g{WSP(bf16, WS_YA), WSP(bf16, WS_WPAT) + (size_t)l * 2048 * 1024, MP, 2048, 1024}; pg8::StaticOrder S; S.init(MP, 2048, opaque_s(F.G), opaque_s(F.bx));
            pg8::EpiGate2 E{WSP(bf16, WS_SGA), WSP(float, WS_T1), WSP(bf16, WS_MG)}; pg8::gemm_phase<pg8::EpiGate2, pg8::StaticOrder, true, true>(F.lds + RING_OFF, g, S, E, F.wv); }
        GRID_BAR();
        STOP_AT(4);
#endif
#ifndef SKIP_G3
        {   pg8::Gemm g{WSP(bf16, WS_MG), WSP(bf16, WS_WOT) + (size_t)l * 2048 * 2048, MP, 2048, 2048}; pg8::StaticOrder S; S.init(MP, 2048, opaque_s(F.G), opaque_s(F.bx));
            pg8::EpiRes E{WSP(float, WS_X), WSP(bf16, WS_XB), WSP(float, SSQ_OFF) + (size_t)(2 * l + 1) * MP * 32}; pg8::gemm_phase<pg8::EpiRes, pg8::StaticOrder, true, true>(F.lds + RING_OFF, g, S, E, F.wv); }
        GRID_BAR();
        STOP_AT(5);
#endif
#ifndef SKIP_G4
        {   pg8::Gemm g{WSP(bf16, WS_XB), WSP(bf16, WS_WUPT) + (size_t)l * 8192 * 2048, MP, 8192, 2048}; pg8::StaticOrder S; S.init(MP, 8192, opaque_s(F.G), opaque_s(F.bx));
            pg8::EpiUp E{WSP(float, SSQ_OFF) + (size_t)(2 * l + 1) * MP * 32, WSP(bf16, WS_U), KOUT(), l}; pg8::gemm_phase<pg8::EpiUp, pg8::StaticOrder, true, true>(F.lds + RING_OFF, g, S, E, F.wv); }
        GRID_BAR();
        STOP_AT(6);
#endif
#ifndef SKIP_E4
        phase_ffn_gate(F, WSP(bf16, WS_U), WSP(bf16, WS_G), KIN(17) + (size_t)l * 3 * 8192, KIN(18) + l * 8192, KIN(6) + (size_t)l * 16 * 2 * 8192);
        GRID_BAR();
        STOP_AT(7);
#endif
#ifndef SKIP_G5
        {   pg8::Gemm g{WSP(bf16, WS_G), WSP(bf16, WS_WDNT) + (size_t)l * 2048 * 4096, MP, 2048, 4096}; pg8::StaticOrder S; S.init(MP, 2048, opaque_s(F.G), opaque_s(F.bx));
            pg8::EpiRes E{WSP(float, WS_X), WSP(bf16, WS_XB), WSP(float, SSQ_OFF) + (size_t)(2 * l + 2) * MP * 32}; pg8::gemm_phase<pg8::EpiRes, pg8::StaticOrder, true, true>(F.lds + RING_OFF, g, S, E, F.wv); }
        GRID_BAR();
        STOP_AT(8);
#endif
    }
    {   const int gw = F.bx * NWAVES + F.wv, NGW = F.G * NWAVES, lane = phase_tid(F) & 63; float* out = KOUT(); const float* X = WSP(float, WS_X); const float* SSQ = WSP(float, SSQ_OFF); const float* gf = KIN(20);
        for (int m = gw; m < MREAL; m += NGW) {
            float* o; if (m < NSAMP) o = out + pg8::OFF_YS + (size_t)m * 2048; else if (m >= NSAMP + 16) o = out + pg8::OFF_YP + (size_t)(m - NSAMP - 16) * 2048; else continue;
            const float rs = pg8::rowscale(SSQ + (size_t)4 * MP * 32, m);
#pragma unroll
            for (int j = 0; j < 8; ++j) { const f32x4 v = *(const GAS f32x4*)(X + (size_t)m * 2048 + 256 * j + 4 * lane), gg = *(const GAS f32x4*)(gf + 256 * j + 4 * lane);
                *(GAS f32x4*)(o + 256 * j + 4 * lane) = v * rs * gg; }
        }
    }
}

extern "C" void kernel_launch(void* const* d_in, const int* in_sizes, int n_in, void* d_out, int out_size, void* d_ws, size_t ws_size, hipStream_t stream) {
    static int grid = 0;
    if (grid == 0) {
        if (n_in != 21 || out_size != (int)pg8::OUT_TOTAL || ws_size < WS_END) { fprintf(stderr, "kernel_launch: unexpected shapes: n_in %d out %d ws %zu\n", n_in, out_size, ws_size); grid = -1; return; }
        int dev = 0, cus = 0, per_cu = 0;
        if (hipGetDevice(&dev) != hipSuccess || hipDeviceGetAttribute(&cus, hipDeviceAttributeMultiprocessorCount, dev) != hipSuccess) { grid = -1; return; }
        if (hipFuncSetAttribute((const void*)fwd_kernel, hipFuncAttributeMaxDynamicSharedMemorySize, LDS_BYTES) != hipSuccess) { fprintf(stderr, "kernel_launch: hipFuncSetAttribute failed\n"); grid = -1; return; }
        if (hipOccupancyMaxActiveBlocksPerMultiprocessor(&per_cu, (const void*)fwd_kernel, NWAVES * 64, LDS_BYTES) != hipSuccess || per_cu < 1) fprintf(stderr, "kernel_launch: occupancy query reports %d\n", per_cu);
        (void)hipGetLastError();
        grid = cus;
    }
    if (grid < 0) return;
    (void)hipMemsetAsync((char*)d_ws + WS_CTL, 0, CTL_ZERO_BYTES, stream);
    Args a{};
    for (int i = 0; i < 21; ++i) a.in[i] = (const float*)d_in[i];
    a.out = (float*)d_out; a.ws = (unsigned char*)d_ws;
    hipLaunchKernelGGL(fwd_kernel, dim3(grid), dim3(NWAVES * 64), LDS_BYTES, stream, a);
    const hipError_t le = hipPeekAtLastError();
    if (le != hipSuccess) fprintf(stderr, "kernel_launch: launch failed: %s\n", hipGetErrorName(le));
}
```

```cpp
#include <hip/hip_runtime.h>
#include <cstdio>
#include <cstdint>
typedef float f32x2_cv __attribute__((ext_vector_type(2))); typedef __bf16 bf16x2_cv __attribute__((ext_vector_type(2)));
__device__ __forceinline__ unsigned cvt_pk_bf16_rne(float lo, float hi) { const f32x2_cv v = {lo, hi}; const bf16x2_cv b = __builtin_convertvector(v, bf16x2_cv); return __builtin_bit_cast(unsigned, b); }
namespace xl {
typedef unsigned u32x2_t __attribute__((ext_vector_type(2)));
__device__ __forceinline__ float sum_xor32(float v) { const auto r = __builtin_amdgcn_permlane32_swap(__float_as_uint(v), __float_as_uint(v), false, false); return __uint_as_float(r[0]) + __uint_as_float(r[1]); }
__device__ __forceinline__ float sum_xor16(float v) { const auto r = __builtin_amdgcn_permlane16_swap(__float_as_uint(v), __float_as_uint(v), false, false); return __uint_as_float(r[0]) + __uint_as_float(r[1]); }
__device__ __forceinline__ float max_xor32(float v) { const auto r = __builtin_amdgcn_permlane32_swap(__float_as_uint(v), __float_as_uint(v), false, false); return fmaxf(__uint_as_float(r[0]), __uint_as_float(r[1])); }
__device__ __forceinline__ float max_xor16(float v) { const auto r = __builtin_amdgcn_permlane16_swap(__float_as_uint(v), __float_as_uint(v), false, false); return fmaxf(__uint_as_float(r[0]), __uint_as_float(r[1])); }
__device__ __forceinline__ float xor1(float v) { return __int_as_float(__builtin_amdgcn_update_dpp(0, __float_as_int(v), 0xB1, 0xf, 0xf, true)); }
template <int N> __device__ __forceinline__ float row_shr(float v) { return __int_as_float(__builtin_amdgcn_update_dpp(0, __float_as_int(v), 0x110 + N, 0xf, 0xf, true)); }
template <int N> __device__ __forceinline__ float row_ror(float v) { return __int_as_float(__builtin_amdgcn_update_dpp(0, __float_as_int(v), 0x120 + N, 0xf, 0xf, true)); }
__device__ __forceinline__ float wave_incl_scan(float x, int lane) {
    x += row_shr<1>(x); x += row_shr<2>(x); x += row_shr<4>(x); x += row_shr<8>(x);
    const float t0 = __int_as_float(__builtin_amdgcn_readlane(__float_as_int(x), 15)), t1 = __int_as_float(__builtin_amdgcn_readlane(__float_as_int(x), 31)), t2 = __int_as_float(__builtin_amdgcn_readlane(__float_as_int(x), 47));
    const int row = lane >> 4; return x + (row >= 1 ? t0 : 0.f) + (row >= 2 ? t1 : 0.f) + (row >= 3 ? t2 : 0.f);
}
__device__ __forceinline__ float wave_max(float v) { v = fmaxf(v, xor1(v)); v = fmaxf(v, __int_as_float(__builtin_amdgcn_update_dpp(0, __float_as_int(v), 0x4E, 0xf, 0xf, true)));
    v = fmaxf(v, row_ror<4>(v)); v = fmaxf(v, row_ror<8>(v)); v = max_xor16(v); return max_xor32(v); }
__device__ __forceinline__ float wave_sum(float v) { v += xor1(v); v += __int_as_float(__builtin_amdgcn_update_dpp(0, __float_as_int(v), 0x4E, 0xf, 0xf, true));
    v += row_shr<4>(v); v += row_shr<8>(v);
    return __int_as_float(__builtin_amdgcn_readlane(__float_as_int(v), 15)) + __int_as_float(__builtin_amdgcn_readlane(__float_as_int(v), 31)) + __int_as_float(__builtin_amdgcn_readlane(__float_as_int(v), 47)) + __int_as_float(__builtin_amdgcn_readlane(__float_as_int(v), 63)); }
}
namespace pg8 {
#define PG8_LAS __attribute__((address_space(3)))
typedef unsigned short bf16_t;
typedef short bf16x8 __attribute__((ext_vector_type(8)));
typedef float f32x4 __attribute__((ext_vector_type(4)));
typedef unsigned u32x4 __attribute__((ext_vector_type(4)));
constexpr int BM = 256, BK = 64, HALF = 128, HTB = HALF * BK * 2  , STAGE_BYTES = 8 * HTB, NXCD = 8, WGM = 8;

__host__ __device__ __forceinline__ int lds_byte(int r, int c) { const int st = (r >> 4) * 2 + (c >> 5), rr = r & 15, cc = c & 31, ob = rr * 64 + cc * 2; return st * 1024 + (ob ^ (((ob >> 9) & 1) << 5)); }
__host__ __device__ __forceinline__ void stage_rc(int b, int& R, int& C) { const int st = b / 1024, sb = b % 1024, swz = sb ^ (((sb >> 9) & 1) << 5); R = (st >> 1) * 16 + swz / 64; C = (st & 1) * 32 + (swz % 64) / 2; }
__host__ __device__ __forceinline__ int perm32(int rho) { const int n = rho >> 4, i = rho & 15; return 8 * (i >> 2) + 4 * n + (i & 3); }

struct Unit { int pm, pn; };
struct Gemm { const bf16_t* A; const bf16_t* Bt; int M, N, K; };

struct StaticOrder {
    int nM, nN, nwg, G, c;
    __host__ __device__ void init(int M, int N, int G_, int c_) { nM = M / BM; nN = N / BM; nwg = nM * nN; G = G_; c = c_; }
    __host__ __device__ bool next(int i, Unit& u) const {
        const long L = (long)i * G + c; if (L >= nwg) return false;
        int wgid = (int)L; { const int q = nwg / NXCD, r = nwg % NXCD, xcd = wgid % NXCD, off = wgid / NXCD; wgid = (xcd < r ? xcd * (q + 1) : r * (q + 1) + (xcd - r) * q) + off; }
        const int nig = WGM * nN, gid = wgid / nig, fm = gid * WGM, gsz = (nM - fm) < WGM ? (nM - fm) : WGM;
        u.pm = fm + ((wgid % nig) % gsz); u.pn = (wgid % nig) / gsz; return true;
    }
    __device__ __forceinline__ void a_ready(const Unit&) const {}
    __device__ __forceinline__ void done(const Unit&) const {}
};

__device__ __forceinline__ unsigned cvt_pk_bf16(float lo, float hi) { return cvt_pk_bf16_rne(lo, hi); }
typedef float f32x2 __attribute__((ext_vector_type(2)));
constexpr int MP = 8704, MREAL = 8464, NSAMP = 256, LPR = 8208, SROW0 = 8208;
constexpr int DM = 2048, CONVD = 1024, ATTD = 1024, NH = 8, HDIM = 128, DFF = 4096, DFF2 = 8192, NPROJ = 10496, PROJ = 10248;
constexpr float RMS_EPS = 1e-6f;
constexpr long OFF_YP = 0, OFF_YS = 16777216, OFF_KP = 17301504, OFF_VP = 34111488, OFF_LFP = 50921472, OFF_CP = 51052800, OFF_FP = 51056896,
               OFF_KS = 51089664, OFF_VS = 51613952, OFF_LFS = 52138240, OFF_CS = 52142336, OFF_FS = 52207872, OUT_TOTAL = 52732160;
typedef unsigned u32x2 __attribute__((ext_vector_type(2)));
__device__ __forceinline__ u32x2 pk4(const f32x4 v) { u32x2 w; w.x = cvt_pk_bf16(v[0], v[1]); w.y = cvt_pk_bf16(v[2], v[3]); return w; }
__device__ __forceinline__ f32x4 unpk4(const u32x2 w) { f32x4 v; v[0] = __uint_as_float(w.x << 16); v[1] = __uint_as_float(w.x & 0xffff0000u); v[2] = __uint_as_float(w.y << 16); v[3] = __uint_as_float(w.y & 0xffff0000u); return v; }
__device__ __forceinline__ float sigmoidf_(float v) { return __builtin_amdgcn_rcpf(1.0f + __builtin_amdgcn_exp2f(-1.4426950408889634f * v)); }
__device__ __forceinline__ float rowscale(const float* ssq, int row) { const f32x4* p = (const f32x4*)(ssq + (size_t)row * 32); f32x4 a = p[0];
#pragma unroll
    for (int i = 1; i < 8; ++i) a += p[i];
    return 1.0f / sqrtf(((a[0] + a[1]) + (a[2] + a[3])) * (1.0f / 2048.0f) + RMS_EPS); }

constexpr int HALO_SLOTS = 512 + 68;
__device__ __forceinline__ int halo_slot(int row) { return row < 8192 ? (row >> 6) * 4 + ((row + 2) & 3) : 512 + ((row - 8192) >> 4) * 4 + ((row + 2) & 3); }
typedef __attribute__((address_space(1))) f32x4 GAS_F4;
__device__ __forceinline__ float rowscale_asm(const float* ssq_row, const float* extra, f32x4& ex) {
    f32x4 p0, p1, p2, p3, p4, p5, p6, p7; const GAS_F4* q = (const GAS_F4*)ssq_row;
    asm volatile("global_load_dwordx4 %0, %1, off" : "=v"(ex) : "v"((const GAS_F4*)extra));
    asm volatile("global_load_dwordx4 %0, %1, off" : "=v"(p0) : "v"(q + 0)); asm volatile("global_load_dwordx4 %0, %1, off" : "=v"(p1) : "v"(q + 1));
    asm volatile("global_load_dwordx4 %0, %1, off" : "=v"(p2) : "v"(q + 2)); asm volatile("global_load_dwordx4 %0, %1, off" : "=v"(p3) : "v"(q + 3));
    asm volatile("global_load_dwordx4 %0, %1, off" : "=v"(p4) : "v"(q + 4)); asm volatile("global_load_dwordx4 %0, %1, off" : "=v"(p5) : "v"(q + 5));
    asm volatile("global_load_dwordx4 %0, %1, off" : "=v"(p6) : "v"(q + 6)); asm volatile("global_load_dwordx4 %0, %1, off" : "=v"(p7) : "v"(q + 7));
    asm volatile("s_waitcnt vmcnt(0)" : "+v"(p0), "+v"(p1), "+v"(p2), "+v"(p3), "+v"(p4), "+v"(p5), "+v"(p6), "+v"(p7), "+v"(ex));
    const f32x4 a = ((p0 + p1) + (p2 + p3)) + ((p4 + p5) + (p6 + p7));
    return 1.0f / sqrtf(((a[0] + a[1]) + (a[2] + a[3])) * (1.0f / 2048.0f) + RMS_EPS);
}
struct EpiIn {
    static constexpr bool PERM = false, AFTER_DRAIN = false;
    const float* ssq; const float* bias; bf16_t *YC; float* PH; const float* wconv; bf16_t *Q, *Kb, *Vb, *RG; unsigned char* SGA; float* LOGF; float* out; int layer; PG8_LAS float* rst;
    __device__ __forceinline__ void pre_epi(const Unit& u, int wc, int lane) const { const int trow = wc * 64 + lane, pn = u.pn, j = trow - 64;
        const float* ex = bias + pn * 256 + 4 * (trow & 63);
        if (trow >= 64 && trow < 112 && pn < 16) ex = wconv + (j >> 4) * 1024 + 64 * pn + (j & 15) * 4;
        f32x4 e; rst[trow] = rowscale_asm(ssq + (size_t)(u.pm * BM + trow) * 32, ex, e);
        if (trow < 64) *(PG8_LAS f32x4*)(rst + 256 + 4 * trow) = e; else if (trow < 112) *(PG8_LAS f32x4*)(rst + 512 + 4 * j) = e; }
    __device__ __forceinline__ void operator()(const f32x4 (&acc)[2][2][4][2], const Unit& u, int wr, int wc, int fr, int fq) const {
        const int rowb = u.pm * BM + wr * 64 + fr, pn = u.pn;
        const PG8_LAS float* rsl = rst + wr * 64 + fr;
#define EPI_IN_BIAS() f32x4 bv[2][2]; _Pragma("unroll") for (int bj = 0; bj < 2; ++bj) _Pragma("unroll") for (int n = 0; n < 2; ++n) bv[bj][n] = *(const PG8_LAS f32x4*)(rst + 256 + wc * 32 + 4 * fq + bj * HALF + n * 16)
        if (pn < 16) { EPI_IN_BIAS();
            const int ch = 64 * pn + 16 * wc + 4 * fq; const bool samp = u.pm >= 32;
            const f32x4 w0 = *(const PG8_LAS f32x4*)(rst + 512 + 16 * wc + 4 * fq), w1 = *(const PG8_LAS f32x4*)(rst + 576 + 16 * wc + 4 * fq), w2 = *(const PG8_LAS f32x4*)(rst + 640 + 16 * wc + 4 * fq);
#pragma unroll
            for (int ai = 0; ai < 2; ++ai) { f32x4 plast = {0.f, 0.f, 0.f, 0.f};
#pragma unroll
                for (int m = 0; m < 4; ++m) { const int row = rowb + ai * HALF + m * 16; const float rs = rsl[ai * HALF + m * 16];
                    const f32x4 xc = acc[ai][0][m][0] * rs + bv[0][0], bc = acc[ai][0][m][1] * rs + bv[0][1], cc = acc[ai][1][m][0] * rs + bv[1][0], q = acc[ai][1][m][1] * rs + bv[1][1];
                    const f32x4 p = cc * xc; const size_t o = (size_t)row * 1024 + ch;
                    f32x4 y;
#pragma unroll
                    for (int e = 0; e < 4; ++e) { const float s1 = xl::row_ror<1>(fr == 15 ? plast[e] : p[e]), s2 = xl::row_ror<2>(fr >= 14 ? plast[e] : p[e]);
                        y[e] = bc[e] * (w0[e] * s2 + w1[e] * s1 + w2[e] * p[e]); }
                    plast = p;
                    if (!(fr < 2 && (m == 0 || samp))) *(u32x2*)(YC + (size_t)row * 2048 + ch) = pk4(y);
                    *(u32x2*)(Q + o) = pk4(q);
                    const bool halo = samp ? (fr < 2 || fr >= 14) : ((m == 0 && fr < 2) || (m == 3 && fr >= 14));
                    if (halo && row < MREAL) { float* hp = PH + (size_t)halo_slot(row) * 2048 + ch; *(f32x4*)hp = p; *(f32x4*)(hp + 1024) = bc; }
                    if (samp) {
                        if (row >= SROW0) { const int sr = row - SROW0; if (row < MREAL && (sr & 15) >= 14) *(f32x4*)(out + OFF_CS + ((size_t)(layer * 16 + (sr >> 4)) * 2 + ((sr & 15) - 14)) * 1024 + ch) = p; }
                        else if (row >= LPR - 2) *(f32x4*)(out + OFF_CP + (size_t)(layer * 2 + (row - (LPR - 2))) * 1024 + ch) = p; } } }
        } else if (pn < 24) { EPI_IN_BIAS();
            const bool isv = pn >= 20; bf16_t* B = isv ? Vb : Kb; const int colb = 256 * (pn - (isv ? 20 : 16)) + wc * 32 + 4 * fq;
#pragma unroll
            for (int ai = 0; ai < 2; ++ai)
#pragma unroll
                for (int m = 0; m < 4; ++m) { const int row = rowb + ai * HALF + m * 16; const float rs = rsl[ai * HALF + m * 16];
                    long oo = -1; if (row < LPR) oo = (isv ? OFF_VP : OFF_KP) + ((long)layer * LPR + row) * 1024; else if (row < MREAL) oo = (isv ? OFF_VS : OFF_KS) + ((long)layer * 256 + (row - SROW0)) * 1024;
#pragma unroll
                    for (int bj = 0; bj < 2; ++bj)
#pragma unroll
                        for (int n = 0; n < 2; ++n) { const f32x4 v = acc[ai][bj][m][n] * rs + bv[bj][n]; const int col = colb + bj * HALF + n * 16;
                            *(u32x2*)(B + (size_t)row * 1024 + col) = pk4(v); if (oo >= 0) *(f32x4*)(out + oo + col) = v; } }
        } else if (pn < 40) { EPI_IN_BIAS();
            const int colb = 128 * (pn - 24) + wc * 32 + 4 * fq;
#pragma unroll
            for (int ai = 0; ai < 2; ++ai)
#pragma unroll
                for (int m = 0; m < 4; ++m) { const int row = rowb + ai * HALF + m * 16; const float rs = rsl[ai * HALF + m * 16];
#pragma unroll
                    for (int n = 0; n < 2; ++n) { const f32x4 zc = acc[ai][0][m][n] * rs + bv[0][n], za = acc[ai][1][m][n] * rs + bv[1][n]; f32x4 rg, ga;
#pragma unroll
                        for (int e = 0; e < 4; ++e) { const float ea = 1.0f + __builtin_amdgcn_exp2f(fminf(-1.4426950408889634f * za[e], 80.f));
                            ga[e] = fmaxf(__builtin_rintf(255.0f * __builtin_amdgcn_rcpf(ea)), 1.0f);
                            rg[e] = 255.0f * __builtin_amdgcn_rcpf((1.0f + __builtin_amdgcn_exp2f(-1.4426950408889634f * zc[e])) * ga[e]); }
                        const unsigned gq = (unsigned)ga[0] | ((unsigned)ga[1] << 8) | ((unsigned)ga[2] << 16) | ((unsigned)ga[3] << 24);
                        *(u32x2*)(RG + (size_t)row * 2048 + colb + n * 16) = pk4(rg); *(unsigned*)(SGA + (size_t)row * 2048 + colb + n * 16) = gq; } }
        } else {
            if (wc == 0 && fq < 2) { int fq_ = fq; asm volatile("" : "+v"(fq_)); const f32x4 bv00 = *(const PG8_LAS f32x4*)(rst + 256 + 4 * fq_);
#pragma unroll
                for (int ai = 0; ai < 2; ++ai)
#pragma unroll
                    for (int m = 0; m < 4; ++m) { const int row = rowb + ai * HALF + m * 16; const float rs = rsl[ai * HALF + m * 16];
                        f32x4 v = acc[ai][0][m][0] * rs + bv00;
#pragma unroll
                        for (int e = 0; e < 4; ++e) v[e] = fminf(v[e], 0.f) - log1pf(__expf(-fabsf(v[e])));
#pragma unroll
                        for (int e = 0; e < 4; ++e) LOGF[(size_t)(4 * fq + e) * MP + row] = v[e];
                        if (row < LPR) *(f32x4*)(out + OFF_LFP + ((size_t)layer * LPR + row) * 8 + 4 * fq) = v;
                        else if (row < MREAL) *(f32x4*)(out + OFF_LFS + ((size_t)layer * 256 + (row - SROW0)) * 8 + 4 * fq) = v; }
            }
        }
#undef EPI_IN_BIAS
    }
};
typedef unsigned u32x4e __attribute__((ext_vector_type(4)));
__device__ __forceinline__ void unpk8(const u32x4e w, f32x4& lo, f32x4& hi) { lo = unpk4((u32x2){w.x, w.y}); hi = unpk4((u32x2){w.z, w.w}); }
__device__ __forceinline__ u32x4e pk8(const f32x4 lo, const f32x4 hi) { const u32x2 a = pk4(lo), b = pk4(hi); return (u32x4e){a.x, a.y, b.x, b.y}; }
struct EpiGateK {
    static constexpr bool PERM = true, AFTER_DRAIN = false;
    const bf16_t* RG; const unsigned char* SGA; bf16_t* MG;
    __device__ __forceinline__ void pre_epi(const Unit&, int, int) const {}
    __device__ __forceinline__ void mid(f32x4 (&acc)[2][2][4][2], const Unit& u, int wr, int wc, int fr, int fq) const {
        asm volatile("" : "+v"(fr), "+v"(fq));
        const int rowb = u.pm * BM + wr * 64 + fr, colb = u.pn * BM + wc * 32 + 8 * fq;
#pragma unroll
        for (int ai = 0; ai < 2; ++ai)
#pragma unroll
            for (int m = 0; m < 4; ++m) { const size_t ro = (size_t)(rowb + ai * HALF + m * 16) * 2048 + colb;
#pragma unroll
                for (int bj = 0; bj < 2; ++bj) { f32x4 lo, hi; unpk8(*(const u32x4e*)(RG + ro + bj * HALF), lo, hi); acc[ai][bj][m][0] *= lo; acc[ai][bj][m][1] *= hi; } }
    }
    __device__ __forceinline__ void operator()(const f32x4 (&acc)[2][2][4][2], const Unit& u, int wr, int wc, int fr, int fq) const {
        const int rowb = u.pm * BM + wr * 64 + fr, colb = u.pn * BM + wc * 32 + 8 * fq;
#pragma unroll
        for (int ai = 0; ai < 2; ++ai)
#pragma unroll
            for (int m = 0; m < 4; ++m) { const size_t ro = (size_t)(rowb + ai * HALF + m * 16) * 2048 + colb;
#pragma unroll
                for (int bj = 0; bj < 2; ++bj) { const size_t o = ro + bj * HALF; const u32x2 gq = *(const u32x2*)(SGA + o);
                    const f32x4 g0 = {(float)(gq.x & 255u), (float)((gq.x >> 8) & 255u), (float)((gq.x >> 16) & 255u), (float)(gq.x >> 24)};
                    const f32x4 g1 = {(float)(gq.y & 255u), (float)((gq.y >> 8) & 255u), (float)((gq.y >> 16) & 255u), (float)(gq.y >> 24)};
                    *(u32x4e*)(MG + o) = pk8(g0 * (1.0f / 255.0f) * acc[ai][bj][m][0], g1 * (1.0f / 255.0f) * acc[ai][bj][m][1]); } }
    }
};
struct EpiRes {
    static constexpr bool PERM = true, AFTER_DRAIN = false;
    bf16_t* XB; float* ssq_next;
    __device__ __forceinline__ void pre_epi(const Unit&, int, int) const {}
    __device__ __forceinline__ void operator()(const f32x4 (&acc)[2][2][4][2], const Unit& u, int wr, int wc, int fr, int fq) const {
        const int rowb = u.pm * BM + wr * 64 + fr, colb = u.pn * BM + wc * 32 + 8 * fq;
#pragma unroll
        for (int ai = 0; ai < 2; ++ai)
#pragma unroll
            for (int m = 0; m < 4; ++m) { const int row = rowb + ai * HALF + m * 16; const size_t ro = (size_t)row * 2048 + colb; float s = 0.f;
#pragma unroll
                for (int bj = 0; bj < 2; ++bj) { const size_t o = ro + bj * HALF; f32x4 lo, hi; unpk8(*(const u32x4e*)(XB + o), lo, hi);
                    const f32x4 x0 = lo + acc[ai][bj][m][0], x1 = hi + acc[ai][bj][m][1];
                    *(u32x4e*)(XB + o) = pk8(x0, x1);
                    s += ((x0[0] * x0[0] + x0[1] * x0[1]) + (x0[2] * x0[2] + x0[3] * x0[3])) + ((x1[0] * x1[0] + x1[1] * x1[1]) + (x1[2] * x1[2] + x1[3] * x1[3])); }
                s = xl::sum_xor16(s); s = xl::sum_xor32(s);
                if (fq == 0) ssq_next[(size_t)row * 32 + u.pn * 4 + wc] = s; }
    }
};
struct EpiUp {
    static constexpr bool PERM = false, AFTER_DRAIN = false;
    const float* ssq; bf16_t* U; float* out; int layer;
    __device__ __forceinline__ void operator()(const f32x4 (&acc)[2][2][4][2], const Unit& u, int wr, int wc, int fr, int fq) const {
        const int rowb = u.pm * BM + wr * 64 + fr, colb = u.pn * BM + wc * 32 + 4 * fq, natb = 128 * u.pn + wc * 32 + 4 * fq;
#pragma unroll
        for (int ai = 0; ai < 2; ++ai)
#pragma unroll
            for (int m = 0; m < 4; ++m) { const int row = rowb + ai * HALF + m * 16; const float rs = rowscale(ssq, row);
                long oo = -1; if (row >= SROW0) { const int sr = row - SROW0; if (row < MREAL && (sr & 15) >= 14) oo = OFF_FS + ((long)(layer * 16 + (sr >> 4)) * 2 + ((sr & 15) - 14)) * 8192; }
                else if (row >= LPR - 2) oo = OFF_FP + (long)(layer * 2 + (row - (LPR - 2))) * 8192;
#pragma unroll
                for (int bj = 0; bj < 2; ++bj)
#pragma unroll
                    for (int n = 0; n < 2; ++n) { const f32x4 v = acc[ai][bj][m][n] * rs; *(u32x2*)(U + (size_t)row * 8192 + colb + bj * HALF + n * 16) = pk4(v);
                        if (oo >= 0) *(f32x4*)(out + oo + bj * 4096 + natb + n * 16) = v; } }
    }
};

struct EpiUpConv {
    static constexpr bool PERM = false, AFTER_DRAIN = false;
    const float* ssq; bf16_t* G; float* HALO; const float* wf; const float* bfc; float* out; int layer; PG8_LAS float* rst;
    __device__ __forceinline__ void pre_epi(const Unit& u, int wc, int lane) const { const int trow = wc * 64 + lane, vi = trow >> 5, c4 = (trow & 31) * 4;
        const float* ex = ((vi & 3) == 3 ? bfc : wf + (vi & 3) * 8192) + (vi >> 2) * 4096 + 128 * u.pn + c4;
        f32x4 e; rst[trow] = rowscale_asm(ssq + (size_t)(u.pm * BM + trow) * 32, ex, e);
        *(PG8_LAS f32x4*)(rst + 256 + vi * 128 + c4) = e; }
    __device__ __forceinline__ void operator()(const f32x4 (&acc)[2][2][4][2], const Unit& u, int wr, int wc, int fr, int fq) const {
        const int rowb = u.pm * BM + wr * 64 + fr, chb = 128 * u.pn + wc * 32 + 4 * fq; const bool samp = u.pm >= 32;
        float rs[2][4];
#pragma unroll
        for (int ai = 0; ai < 2; ++ai)
#pragma unroll
            for (int m = 0; m < 4; ++m) rs[ai][m] = rst[ai * HALF + wr * 64 + m * 16 + fr];
#pragma unroll
        for (int n = 0; n < 2; ++n) { const int ch = chb + 16 * n;
            const PG8_LAS float* wt = rst + 256 + wc * 32 + 4 * fq + 16 * n;
            const f32x4 w0a = *(const PG8_LAS f32x4*)(wt), w1a = *(const PG8_LAS f32x4*)(wt + 128), w2a = *(const PG8_LAS f32x4*)(wt + 256), ba = *(const PG8_LAS f32x4*)(wt + 384);
            const f32x4 w0b = *(const PG8_LAS f32x4*)(wt + 512), w1b = *(const PG8_LAS f32x4*)(wt + 640), w2b = *(const PG8_LAS f32x4*)(wt + 768), bb = *(const PG8_LAS f32x4*)(wt + 896);
#pragma unroll
            for (int ai = 0; ai < 2; ++ai)
#pragma unroll
                for (int m = 0; m < 4; ++m) { const int row = rowb + ai * HALF + m * 16;
                    const f32x4 ua = acc[ai][0][m][n] * rs[ai][m], ub = acc[ai][1][m][n] * rs[ai][m];
                    f32x4 pa = ua, pb = ub; if (m > 0) { pa = acc[ai][0][m - 1][n] * rs[ai][m - 1]; pb = acc[ai][1][m - 1][n] * rs[ai][m - 1]; }
                    f32x4 A, B;
#pragma unroll
                    for (int e = 0; e < 4; ++e) {
                        const float a1 = xl::row_ror<1>(fr == 15 ? pa[e] : ua[e]), a2 = xl::row_ror<2>(fr >= 14 ? pa[e] : ua[e]);
                        const float b1 = xl::row_ror<1>(fr == 15 ? pb[e] : ub[e]), b2 = xl::row_ror<2>(fr >= 14 ? pb[e] : ub[e]);
                        A[e] = w0a[e] * a2 + w1a[e] * a1 + w2a[e] * ua[e] + ba[e]; B[e] = w0b[e] * b2 + w1b[e] * b1 + w2b[e] * ub[e] + bb[e]; }
                    f32x4 gv;
#pragma unroll
                    for (int e = 0; e < 4; ++e) gv[e] = A[e] * sigmoidf_(A[e]) * B[e];
                    const bool skip = fr < 2 && (m == 0 || samp);
                    if (!skip) *(u32x2*)(G + (size_t)row * 4096 + ch) = pk4(gv);
                    const bool halo = samp ? (fr < 2 || fr >= 14) : ((m == 0 && fr < 2) || (m == 3 && fr >= 14));
                    if (halo && row < MREAL) { float* hp = HALO + (size_t)halo_slot(row) * 8192 + ch; *(f32x4*)hp = ua; *(f32x4*)(hp + 4096) = ub; }
                    if (samp) {
                        long oo = -1; if (row >= SROW0) { const int sr = row - SROW0; if (row < MREAL && (sr & 15) >= 14) oo = OFF_FS + ((long)(layer * 16 + (sr >> 4)) * 2 + ((sr & 15) - 14)) * 8192; }
                        else if (row >= LPR - 2) oo = OFF_FP + (long)(layer * 2 + (row - (LPR - 2))) * 8192;
                        if (oo >= 0) { *(f32x4*)(out + oo + ch) = ua; *(f32x4*)(out + oo + 4096 + ch) = ub; } } }
            asm volatile("" ::: "memory");
        }
    }
};
template <class Epi, class Sched, bool ALIGN_EPI = false, bool SP2 = false, bool MID = false>
__device__ __forceinline__ void gemm_phase(PG8_LAS unsigned char* lds, const Gemm g, const Sched& S, const Epi& E, const int wv  ) {
    int tid_ = wv * 64 + (int)__builtin_amdgcn_mbcnt_hi(~0u, __builtin_amdgcn_mbcnt_lo(~0u, 0u)); asm volatile("" : "+v"(tid_));
    const int tid = tid_, wid = __builtin_amdgcn_readfirstlane(tid >> 6), lane = tid & 63, wr = wid >> 2, wc = wid & 3, fr = lane & 15, fq = lane >> 4;
    const int K = g.K, nt = K / BK;
    unsigned voffA[2], voffB[2];
#pragma unroll
    for (int i = 0; i < 2; ++i) { int R, C; stage_rc(tid * 16 + i * 8192, R, C); const int Rb = Epi::PERM ? ((R & ~31) + perm32(R & 31)) : R;
        voffA[i] = (unsigned)(R * K + C) * 2u; voffB[i] = (unsigned)(Rb * K + C) * 2u; }
    const size_t kstep = (size_t)(BK * 2);
    const size_t hstep = (size_t)HALF * K * 2;
    const size_t tstep = 2 * hstep;
    const unsigned ldsw = (unsigned)wid * 1024u;
    const int aoff = lds_byte(wr * 64 + fr, fq * 8), boff = lds_byte(wc * 32 + fr, fq * 8);
    const unsigned ldsA = (unsigned)(uintptr_t)lds + (unsigned)aoff, ldsB = (unsigned)(uintptr_t)lds + (unsigned)boff;
#define PG8_SA(b, h) (((b) * 2 + (h)) * HTB)
#define PG8_SB(b, h) ((4 + (b) * 2 + (h)) * HTB)
#define PG8_STAGE(bufoff, gbase, voff) do { _Pragma("unroll") for (int _i = 0; _i < 2; ++_i) \
        __builtin_amdgcn_global_load_lds((const unsigned*)((const char*)(gbase) + (voff)[_i]), (PG8_LAS unsigned*)(lds + (bufoff) + ldsw + _i * 8192), 16, 0, 0); } while (0)
#define PG8_DSRD(dst, addr, off) asm volatile("ds_read_b128 %0, %1 offset:%2" : "=v"(dst) : "v"(addr), "i"(off))
#define PG8_LDA(dst, b, h) do { const unsigned a_ = ldsA + PG8_SA(b, h); _Pragma("unroll") for (int m = 0; m < 4; ++m) _Pragma("unroll") for (int k = 0; k < 2; ++k) PG8_DSRD(dst[m][k], a_, m * 2048 + k * 1024); } while (0)
#define PG8_LDB(dst, b, h) do { const unsigned b_ = ldsB + PG8_SB(b, h); _Pragma("unroll") for (int n = 0; n < 2; ++n) _Pragma("unroll") for (int k = 0; k < 2; ++k) PG8_DSRD(dst[n][k], b_, n * 2048 + k * 1024); } while (0)
#define PG8_MMA(ai, bj, At, Bt) do { __builtin_amdgcn_s_setprio(1); _Pragma("unroll") for (int m = 0; m < 4; ++m) _Pragma("unroll") for (int n = 0; n < 2; ++n) _Pragma("unroll") for (int k = 0; k < 2; ++k) \
        acc[ai][bj][m][n] = __builtin_amdgcn_mfma_f32_16x16x32_bf16(Bt[n][k], At[m][k], acc[ai][bj][m][n], 0, 0, 0); __builtin_amdgcn_s_setprio(0); } while (0)
#define PG8_WAIT_V(n) asm volatile("s_waitcnt vmcnt(" #n ")" ::: "memory")
#define PG8_WAIT_L(n) asm volatile("s_waitcnt lgkmcnt(" #n ")" ::: "memory")
#define PG8_BAR __builtin_amdgcn_s_barrier()
#define PG8_SCHED __builtin_amdgcn_sched_barrier(0)
    Unit cur, nxt; int ui = 0;
    if (!S.next(0, cur)) return;
    f32x4 acc[2][2][4][2];
#pragma unroll
    for (int a = 0; a < 2; ++a)
#pragma unroll
        for (int b = 0; b < 2; ++b)
#pragma unroll
            for (int m = 0; m < 4; ++m)
#pragma unroll
                for (int n = 0; n < 2; ++n) acc[a][b][m][n] = (f32x4){0.f, 0.f, 0.f, 0.f};
    bf16x8 At[4][2], B0[2][2], B1[2][2];
    const char* cA = (const char*)g.A + (size_t)cur.pm * tstep; const char* cB = (const char*)g.Bt + (size_t)cur.pn * tstep;
    S.a_ready(cur);
    if constexpr (SP2) {
        PG8_STAGE(PG8_SB(0, 0), cB, voffB); PG8_STAGE(PG8_SB(0, 1), cB + hstep, voffB); PG8_STAGE(PG8_SA(0, 0), cA, voffA); PG8_STAGE(PG8_SA(0, 1), cA + hstep, voffA);
        if (wr == 1) PG8_BAR;
        PG8_WAIT_V(2); PG8_BAR;
        PG8_STAGE(PG8_SB(1, 0), cB + kstep, voffB); PG8_STAGE(PG8_SA(1, 0), cA + kstep, voffA); PG8_STAGE(PG8_SB(1, 1), cB + hstep + kstep, voffB);
        PG8_WAIT_V(6); PG8_BAR;
    } else {
        PG8_STAGE(PG8_SB(0, 0), cB, voffB); PG8_STAGE(PG8_SA(0, 0), cA, voffA); PG8_STAGE(PG8_SB(0, 1), cB + hstep, voffB); PG8_STAGE(PG8_SA(0, 1), cA + hstep, voffA);
        if (wr == 1) PG8_BAR;
        PG8_WAIT_V(4); PG8_BAR;
        PG8_STAGE(PG8_SB(1, 0), cB + kstep, voffB); PG8_STAGE(PG8_SA(1, 0), cA + kstep, voffA); PG8_STAGE(PG8_SB(1, 1), cB + hstep + kstep, voffB);
        PG8_WAIT_V(6); PG8_BAR;
    }
    for (;;) {
        const bool has_next = S.next(ui + 1, nxt);
        const char* nA = has_next ? (const char*)g.A + (size_t)nxt.pm * tstep : cA; const char* nB = has_next ? (const char*)g.Bt + (size_t)nxt.pn * tstep : cB;
        for (int t = 0; t < nt; t += 2) {
            if constexpr (MID) { if (t == (nt >> 1)) {
                if constexpr (ALIGN_EPI) { if (wr == 0) PG8_BAR; }
                E.mid(acc, cur, wr, wc, fr, fq);
                if constexpr (ALIGN_EPI) { if (wr == 1) PG8_BAR; }
                PG8_SCHED; } }
            const bool last = (t == nt - 2);
            const char* a1 = cA + (size_t)(t + 1) * kstep;
            const char* a2 = last ? nA : cA + (size_t)(t + 2) * kstep; const char* b2 = last ? nB : cB + (size_t)(t + 2) * kstep;
            const char* a3 = a2 + kstep; const char* b3 = b2 + kstep;
            if (last && has_next) S.a_ready(nxt);
            if constexpr (SP2) {
            PG8_LDB(B0, 0, 0); PG8_LDB(B1, 0, 1); PG8_SCHED; PG8_LDA(At, 0, 0); PG8_STAGE(PG8_SA(1, 1), a1 + hstep, voffA);
            PG8_WAIT_V(8); PG8_WAIT_L(0); PG8_BAR; PG8_SCHED; PG8_MMA(0, 0, At, B0); PG8_MMA(0, 1, At, B1); PG8_BAR; PG8_SCHED;
            PG8_LDA(At, 0, 1); PG8_STAGE(PG8_SB(0, 0), b2, voffB); PG8_STAGE(PG8_SB(0, 1), b2 + hstep, voffB); PG8_STAGE(PG8_SA(0, 0), a2, voffA);
            PG8_WAIT_V(8); PG8_WAIT_L(0); PG8_BAR; PG8_SCHED; PG8_MMA(1, 0, At, B0); PG8_MMA(1, 1, At, B1); PG8_BAR; PG8_SCHED;
            PG8_LDB(B0, 1, 0); PG8_LDB(B1, 1, 1); PG8_SCHED; PG8_LDA(At, 1, 0); PG8_STAGE(PG8_SA(0, 1), a2 + hstep, voffA);
            PG8_WAIT_V(8); PG8_WAIT_L(0); PG8_BAR; PG8_SCHED; PG8_MMA(0, 0, At, B0); PG8_MMA(0, 1, At, B1); PG8_BAR; PG8_SCHED;
            PG8_LDA(At, 1, 1); PG8_STAGE(PG8_SB(1, 0), b3, voffB); PG8_STAGE(PG8_SB(1, 1), b3 + hstep, voffB); PG8_STAGE(PG8_SA(1, 0), a3, voffA);
            PG8_WAIT_V(8); PG8_WAIT_L(0); PG8_BAR; PG8_SCHED; PG8_MMA(1, 0, At, B0); PG8_MMA(1, 1, At, B1); PG8_BAR; PG8_SCHED;
            } else {
            PG8_LDB(B0, 0, 0); PG8_SCHED; PG8_LDA(At, 0, 0); PG8_STAGE(PG8_SA(1, 1), a1 + hstep, voffA);
            PG8_WAIT_L(8); PG8_BAR; PG8_WAIT_L(0); PG8_SCHED; PG8_MMA(0, 0, At, B0); PG8_BAR; PG8_SCHED;
            PG8_LDB(B1, 0, 1); PG8_STAGE(PG8_SB(0, 0), b2, voffB);
            PG8_BAR; PG8_WAIT_L(0); PG8_SCHED; PG8_MMA(0, 1, At, B1); PG8_BAR;
            PG8_LDA(At, 0, 1); PG8_STAGE(PG8_SA(0, 0), a2, voffA);
            PG8_BAR; PG8_WAIT_L(0); PG8_SCHED; PG8_MMA(1, 0, At, B0); PG8_BAR; PG8_SCHED;
            PG8_STAGE(PG8_SB(0, 1), b2 + hstep, voffB);
            PG8_WAIT_V(6); PG8_BAR; PG8_MMA(1, 1, At, B1); PG8_BAR;
            PG8_LDB(B0, 1, 0); PG8_SCHED; PG8_LDA(At, 1, 0); PG8_STAGE(PG8_SA(0, 1), a2 + hstep, voffA);
            PG8_WAIT_L(8); PG8_BAR; PG8_WAIT_L(0); PG8_SCHED; PG8_MMA(0, 0, At, B0); PG8_BAR; PG8_SCHED;
            PG8_LDB(B1, 1, 1); PG8_STAGE(PG8_SB(1, 0), b3, voffB);
            PG8_BAR; PG8_WAIT_L(0); PG8_SCHED; PG8_MMA(0, 1, At, B1); PG8_BAR;
            PG8_LDA(At, 1, 1); PG8_STAGE(PG8_SA(1, 0), a3, voffA);
            PG8_BAR; PG8_WAIT_L(0); PG8_SCHED; PG8_MMA(1, 0, At, B0); PG8_BAR; PG8_SCHED;
            PG8_STAGE(PG8_SB(1, 1), b3 + hstep, voffB);
            PG8_WAIT_V(6); PG8_BAR; PG8_MMA(1, 1, At, B1); PG8_BAR;
            }
        }
        if constexpr (ALIGN_EPI) { if (wr == 0) { E.pre_epi(cur, wc, lane); PG8_WAIT_L(0); PG8_BAR; } }
        if constexpr (!Epi::AFTER_DRAIN) { E(acc, cur, wr, wc, fr, fq); S.done(cur); }
        if (!has_next) break;
#pragma unroll
        for (int a = 0; a < 2; ++a)
#pragma unroll
            for (int b = 0; b < 2; ++b)
#pragma unroll
                for (int m = 0; m < 4; ++m)
#pragma unroll
                    for (int n = 0; n < 2; ++n) acc[a][b][m][n] = (f32x4){0.f, 0.f, 0.f, 0.f};
        cur = nxt; cA = nA; cB = nB; ++ui;
        if constexpr (ALIGN_EPI) { if (wr == 1) PG8_BAR; }
    }
    PG8_WAIT_V(0);
    if constexpr (!ALIGN_EPI) { if (wr == 0) PG8_BAR; }
    PG8_BAR;
    if constexpr (Epi::AFTER_DRAIN) { E.fused(acc, cur, wr, wc, fr, fq, lds, wid, lane); S.done(cur); }
#undef PG8_SA
#undef PG8_SB
#undef PG8_STAGE
#undef PG8_DSRD
#undef PG8_LDA
#undef PG8_LDB
#undef PG8_MMA
#undef PG8_WAIT_V
#undef PG8_WAIT_L
#undef PG8_BAR
#undef PG8_SCHED
}
}
namespace pa {
typedef unsigned short bf16_t;
typedef short bf16x8 __attribute__((ext_vector_type(8)));
typedef short s16x4 __attribute__((ext_vector_type(4)));
typedef float f32x16 __attribute__((ext_vector_type(16)));
typedef float f32x4 __attribute__((ext_vector_type(4)));
typedef unsigned u32x4 __attribute__((ext_vector_type(4)));
constexpr int D = 128, LD = 1024, LDO = 2048;
constexpr float SCALE = 0.08838834764831845f, C2 = 1.4426950408889634f * SCALE, THR = 8.f;
constexpr int NW = 8, QBLK = 32, KVBLK = 64, QB = NW * QBLK;
constexpr int SHM_V = KVBLK * D * 2, SHM_K = KVBLK * D * 2;
constexpr int LDS_ATT = 2 * SHM_V + 2 * SHM_K + NW * 64 * 4;
#define KSWZ(row, colB) ((row) * 256 + ((colB) ^ (((row) & 7) << 4)))
#define SBAR() __builtin_amdgcn_sched_barrier(0)
__device__ __forceinline__ int v_st(int k, int c) { const int kk = (k & ~0xC) | ((k & 4) << 1) | ((k & 8) >> 1); return ((kk >> 3) * 4 + (c >> 5)) * 512 + ((kk & 7) * 32 + (c & 31)) * 2; }
__device__ __forceinline__ int v_rd_base(int lane) { return ((lane & 3) << 3) | (((lane >> 2) & 3) << 6) | (((lane >> 4) & 1) << 5) | (((lane >> 5) & 1) << 8); }
constexpr int v_rd_off(int d0, int ks, int half) { return d0 * 512 + ks * 4096 + half * 2048; }
__device__ __forceinline__ int crow(int r, int hi) { return (r & 3) + 8 * (r >> 2) + 4 * hi; }
__device__ __forceinline__ unsigned cvtpk(float lo, float hi) { return cvt_pk_bf16_rne(lo, hi); }
__device__ __forceinline__ bf16x8 load8(const bf16_t* p) { return *reinterpret_cast<const bf16x8*>(p); }
__device__ __forceinline__ void mask_tile(f32x16& p0, f32x16& p1, int dq) {
    const float NEG = -__builtin_inff();
#pragma unroll
    for (int r = 0; r < 16; ++r) { const int c = (r & 3) + 8 * (r >> 2); if (dq - c < 0) p0[r] = NEG; if (dq - c - 32 < 0) p1[r] = NEG; }
}
__device__ __forceinline__ void partialSM(f32x16& p0, f32x16& p1, float& m_reg, float& mn, float& alpha) {
    float pmax = p0[0];
#pragma unroll
    for (int r = 1; r < 16; ++r) pmax = fmaxf(pmax, p0[r]);
#pragma unroll
    for (int r = 0; r < 16; ++r) pmax = fmaxf(pmax, p1[r]);
    { auto rr = __builtin_amdgcn_permlane32_swap(__float_as_uint(pmax), __float_as_uint(pmax), false, false);
      pmax = fmaxf(__uint_as_float(rr[0]), __uint_as_float(rr[1])); }
    if (__builtin_expect(__all((pmax - m_reg) * SCALE <= THR), 1)) { mn = m_reg; alpha = 1.f; }
    else { mn = fmaxf(m_reg, pmax); alpha = __builtin_amdgcn_exp2f((m_reg - mn) * C2); m_reg = mn; }
    const float mnL = -mn * C2;
#pragma unroll
    for (int r = 0; r < 16; ++r) p0[r] = fmaf(p0[r], C2, mnL);
#pragma unroll
    for (int r = 0; r < 16; ++r) p1[r] = fmaf(p1[r], C2, mnL);
#pragma unroll
    for (int r = 0; r < 16; ++r) p0[r] = __builtin_amdgcn_exp2f(p0[r]);
}
__device__ __forceinline__ void finishSM(f32x16& p0, f32x16& p1, float alpha, float& l_reg, bf16x8& pa0, bf16x8& pa1, bf16x8& pa2, bf16x8& pa3) {
#pragma unroll
    for (int r = 0; r < 16; ++r) p1[r] = __builtin_amdgcn_exp2f(p1[r]);
    float ps = 0;
#pragma unroll
    for (int r = 0; r < 16; ++r) ps += p0[r];
#pragma unroll
    for (int r = 0; r < 16; ++r) ps += p1[r];
    { auto rr = __builtin_amdgcn_permlane32_swap(__float_as_uint(ps), __float_as_uint(ps), false, false);
      ps = __uint_as_float(rr[0]) + __uint_as_float(rr[1]); }
    l_reg = l_reg * alpha + ps;
#define PK4(P, B_, OUT) do { unsigned a0 = cvtpk(P[B_+0], P[B_+1]), a1 = cvtpk(P[B_+2], P[B_+3]);                          \
        unsigned b0 = cvtpk(P[B_+4], P[B_+5]), b1 = cvtpk(P[B_+6], P[B_+7]);                                             \
        auto r0 = __builtin_amdgcn_permlane32_swap(a0, b0, false, false); auto r1 = __builtin_amdgcn_permlane32_swap(a1, b1, false, false); \
        u32x4 w = {r0[0], r1[0], r0[1], r1[1]}; OUT = *reinterpret_cast<bf16x8*>(&w); } while (0)
    PK4(p0, 0, pa0); PK4(p0, 8, pa1); PK4(p1, 0, pa2); PK4(p1, 8, pa3);
#undef PK4
}
template <int KB>
__device__ __forceinline__ void qkt(f32x16& p0, f32x16& p1, const char* K_lds, int r32, int hi, const bf16x8* qr, const float* bk) {
#pragma unroll
    for (int j = 0; j < 4; ++j) { const f32x4 b0 = *(const f32x4*)(bk + 8 * j), b1 = *(const f32x4*)(bk + 32 + 8 * j);
#pragma unroll
        for (int e = 0; e < 4; ++e) { p0[4 * j + e] = b0[e]; p1[4 * j + e] = b1[e]; } }
    const char* kb[4];
#pragma unroll
    for (int dd = 0; dd < 4; ++dd) kb[dd] = K_lds + KB * SHM_K + KSWZ(r32, (dd * 16 + hi * 8) * 2);
#pragma unroll
    for (int d0 = 0; d0 < 8; ++d0) { const char* a = kb[d0 & 3] + (d0 >> 2) * 128;
        bf16x8 b0 = *reinterpret_cast<const bf16x8*>(a);
        bf16x8 b1 = *reinterpret_cast<const bf16x8*>(a + 32 * 256);
        p0 = __builtin_amdgcn_mfma_f32_32x32x16_bf16(b0, qr[d0], p0, 0, 0, 0);
        p1 = __builtin_amdgcn_mfma_f32_32x32x16_bf16(b1, qr[d0], p1, 0, 0, 0); }
}
template <int VB>
__device__ __forceinline__ void pv_tile(f32x16* o, int vb0, bf16x8 pa0, bf16x8 pa1, bf16x8 pa2, bf16x8 pa3) {
#define TRRD(dst, off) asm volatile("ds_read_b64_tr_b16 %0, %1 offset:%2" : "=&v"(dst) : "v"(vb0), "i"(off) : "memory")
#define PV_D0(d0) do { s16x4 l0, l1, l2, l3, h0, h1, h2, h3; constexpr int b_ = VB * SHM_V + v_rd_off(d0, 0, 0); \
        TRRD(l0, b_); TRRD(h0, b_ + 2048); TRRD(l1, b_ + 4096); TRRD(h1, b_ + 6144); TRRD(l2, b_ + 8192); TRRD(h2, b_ + 10240); TRRD(l3, b_ + 12288); TRRD(h3, b_ + 14336); \
        asm volatile("s_waitcnt lgkmcnt(0)" ::: "memory"); SBAR();   \
        o[d0] = __builtin_amdgcn_mfma_f32_32x32x16_bf16(pa0, (bf16x8){l0[0], l0[1], l0[2], l0[3], h0[0], h0[1], h0[2], h0[3]}, o[d0], 0, 0, 0);   \
        o[d0] = __builtin_amdgcn_mfma_f32_32x32x16_bf16(pa1, (bf16x8){l1[0], l1[1], l1[2], l1[3], h1[0], h1[1], h1[2], h1[3]}, o[d0], 0, 0, 0);   \
        o[d0] = __builtin_amdgcn_mfma_f32_32x32x16_bf16(pa2, (bf16x8){l2[0], l2[1], l2[2], l2[3], h2[0], h2[1], h2[2], h2[3]}, o[d0], 0, 0, 0);   \
        o[d0] = __builtin_amdgcn_mfma_f32_32x32x16_bf16(pa3, (bf16x8){l3[0], l3[1], l3[2], l3[3], h3[0], h3[1], h3[2], h3[3]}, o[d0], 0, 0, 0); } while (0)
    PV_D0(0); PV_D0(1); PV_D0(2); PV_D0(3);
#undef PV_D0
#undef TRRD
}
struct BlockRef { const bf16_t* Q; const bf16_t* K; const bf16_t* V; bf16_t* O; int P0, j_lo, j_hi, mode; float* part; unsigned* flag; };
struct Seam { bf16x8 qr[8]; bf16x8 st_v0, st_v1, st_k0, st_k1; };
#define ROW(p, k0, rr) ((p) + (size_t)((k0) + (rr)) * LD + sc)
#define VMW() asm volatile("s_waitcnt vmcnt(0)" ::: "memory")
#define VMWN(n) asm volatile("s_waitcnt vmcnt(%0)" :: "i"(n) : "memory")
#define SLOAD_H(Kp, Vp, k0) do { S.st_v0 = load8(ROW(Vp, k0, sr)); S.st_v1 = load8(ROW(Vp, k0, 32 + sr));              \
                         S.st_k0 = load8(ROW(Kp, k0, sr)); S.st_k1 = load8(ROW(Kp, k0, 32 + sr)); } while (0)
#define SWRITE_HK(bf) do { *(bf16x8*)(K_lds + (bf) * SHM_K + kws) = S.st_k0; *(bf16x8*)(K_lds + (bf) * SHM_K + kws + 32 * 256) = S.st_k1; } while (0)
#define SWRITE_HV(bf) do { *(bf16x8*)(V_lds + (bf) * SHM_V + vst0) = S.st_v0; *(bf16x8*)(V_lds + (bf) * SHM_V + vst1) = S.st_v1; } while (0)
#define SWRITE_H(bf) do { SWRITE_HV(bf); SWRITE_HK(bf); } while (0)
constexpr int PART_FLOATS = 256 * 128 + 512;
__device__ __forceinline__ void prime(const BlockRef& cur, char* lds, Seam& S, const int wv) {
    int tid_ = wv * 64 + (int)__builtin_amdgcn_mbcnt_hi(~0u, __builtin_amdgcn_mbcnt_lo(~0u, 0u)); asm volatile("" : "+v"(tid_)); const int tid = tid_, wid = __builtin_amdgcn_readfirstlane(tid >> 6), lane = tid & 63, r32 = lane & 31, hi = lane >> 5;
    const int sr = tid >> 4, sc = (tid & 15) * 8, kws = KSWZ(sr, sc * 2); char* K_lds = lds + 2 * SHM_V;
#pragma unroll
    for (int d0 = 0; d0 < 8; ++d0) S.qr[d0] = load8(cur.Q + (size_t)(wid * QBLK + r32) * LD + d0 * 16 + hi * 8);
    SLOAD_H(cur.K, cur.V, cur.j_lo * KVBLK); VMW(); SWRITE_HK(0);
    __syncthreads();
}
__device__ __forceinline__ void block(const BlockRef& cur, const BlockRef& nxt, char* lds, const float* bias, Seam& S, const int wv) {
    int tid_ = wv * 64 + (int)__builtin_amdgcn_mbcnt_hi(~0u, __builtin_amdgcn_mbcnt_lo(~0u, 0u)); asm volatile("" : "+v"(tid_)); const int tid = tid_, wid = __builtin_amdgcn_readfirstlane(tid >> 6), lane = tid & 63, r32 = lane & 31, hi = lane >> 5;
    const int j_lo = cur.j_lo, NT = cur.j_hi - cur.j_lo;
    const int qlo = cur.P0 + wid * QBLK, qm = qlo + r32 - 4 * hi;
    char* V_lds = lds; char* K_lds = lds + 2 * SHM_V;
    float* ws = (float*)(lds + 2 * SHM_V + 2 * SHM_K) + wid * 64; float* li_l = ws, * al_l = ws + 32;
    const float* bk = bias + 4 * hi;
    float m_reg = -1e30f, l_reg = 0; f32x16 o[4] = {};
    const int sr = tid >> 4, sc = (tid & 15) * 8, vst0 = v_st(sr, sc), vst1 = v_st(32 + sr, sc), kws = KSWZ(sr, sc * 2);
    const int vb0 = (int)(uintptr_t)V_lds + v_rd_base(lane);
    const bf16_t* Kh = cur.K; const bf16_t* Vh = cur.V;
#define RESC(a) do { if (__any((a) < 1.f)) { if (hi == 0) al_l[r32] = (a); asm volatile("s_waitcnt lgkmcnt(0)" ::: "memory");              \
                     for (int d_ = 0; d_ < 4; ++d_) for (int r = 0; r < 16; ++r) o[d_][r] *= al_l[crow(r, hi)]; } } while (0)
#define KBASE(t) ((j_lo + (t)) * KVBLK)
#define MASKT(P0_, P1_, t) do { const int kb_ = KBASE(t); if (kb_ + KVBLK - 1 > qlo) mask_tile(P0_, P1_, qm - kb_); } while (0)
    constexpr int NQL = 8;
#define SEAM_K0() do { VMWN(NQL); SWRITE_HK(0); SBAR(); } while (0)
    f32x16 pA0, pA1, pB0, pB1; float mnA, mnB, alA, alB; bf16x8 pa0, pa1, pa2, pa3;
    SWRITE_HV(0); SBAR();
    if (NT > 1) { SLOAD_H(Kh, Vh, KBASE(1)); }
    SBAR(); qkt<0>(pA0, pA1, K_lds, r32, hi, S.qr, bk + KBASE(0));
    MASKT(pA0, pA1, 0); partialSM(pA0, pA1, m_reg, mnA, alA);
    if (NT > 1) { VMW(); SWRITE_H(1); }
    __syncthreads();
#define HALF_STEP(PX0, PX1, mnX, alX, PY0, PY1, alY, t, KB, VB, SB) do {                                                      \
        SBAR(); qkt<KB>(PX0, PX1, K_lds, r32, hi, S.qr, bk + KBASE(t));                                             \
        finishSM(PY0, PY1, alY, l_reg, pa0, pa1, pa2, pa3); SBAR();                                                           \
        if ((t) + 1 < NT) { SLOAD_H(Kh, Vh, KBASE((t) + 1)); SBAR(); }                                               \
        pv_tile<VB>(o, vb0, pa0, pa1, pa2, pa3); MASKT(PX0, PX1, (t)); partialSM(PX0, PX1, m_reg, mnX, alX);                                        \
        __syncthreads();                                                                                                      \
        if ((t) + 1 < NT) { VMW(); SWRITE_H(SB); }                                                                          \
        RESC(alX); __syncthreads(); } while (0)
    for (int t = 1; t + 1 < NT; t += 2) {
        HALF_STEP(pB0, pB1, mnB, alB, pA0, pA1, alA, t, 1, 0, 0);
        HALF_STEP(pA0, pA1, mnA, alA, pB0, pB1, alB, t + 1, 0, 1, 1);
    }
    const bool even = (NT & 1) == 0;
    if (even) { SBAR(); qkt<1>(pB0, pB1, K_lds, r32, hi, S.qr, bk + KBASE(NT - 1)); SBAR(); }
    SLOAD_H(nxt.K, nxt.V, nxt.j_lo * KVBLK); SBAR();
#pragma unroll
    for (int d0 = 0; d0 < 8; ++d0) S.qr[d0] = load8(nxt.Q + (size_t)(wid * QBLK + r32) * LD + d0 * 16 + hi * 8);
    SBAR();
    finishSM(pA0, pA1, alA, l_reg, pa0, pa1, pa2, pa3); SBAR();
    pv_tile<0>(o, vb0, pa0, pa1, pa2, pa3);
    if (even) { MASKT(pB0, pB1, NT - 1); partialSM(pB0, pB1, m_reg, mnB, alB); __syncthreads(); RESC(alB);
        finishSM(pB0, pB1, alB, l_reg, pa0, pa1, pa2, pa3); SBAR(); pv_tile<1>(o, vb0, pa0, pa1, pa2, pa3); }
    SBAR(); SEAM_K0();
    const int mode = cur.mode;
    if (mode == 1) {
        float* P = cur.part;
#pragma unroll
        for (int r = 0; r < 16; ++r) { const int prow = wid * QBLK + crow(r, hi);
#pragma unroll
            for (int d0 = 0; d0 < 4; ++d0) __hip_atomic_store(P + (size_t)prow * 128 + d0 * 32 + r32, o[d0][r], __ATOMIC_RELAXED, __HIP_MEMORY_SCOPE_AGENT); }
        if (hi == 0) { __hip_atomic_store(P + 32768 + wid * QBLK + r32, m_reg, __ATOMIC_RELAXED, __HIP_MEMORY_SCOPE_AGENT); __hip_atomic_store(P + 32768 + 256 + wid * QBLK + r32, l_reg, __ATOMIC_RELAXED, __HIP_MEMORY_SCOPE_AGENT); }
        VMW();
        __syncthreads();
        if (tid == 0) __hip_atomic_store(cur.flag, 1u, __ATOMIC_RELAXED, __HIP_MEMORY_SCOPE_AGENT);
    } else {
        float w_own;
        if (mode == 2) {
            if (tid == 0) { unsigned sp = 0; while (__hip_atomic_load(cur.flag, __ATOMIC_RELAXED, __HIP_MEMORY_SCOPE_AGENT) == 0u) { __builtin_amdgcn_s_sleep(8); if (++sp > (1u << 22)) break; } }
            __syncthreads();
            const float* P = cur.part;
            const float m0 = __hip_atomic_load(P + 32768 + wid * QBLK + r32, __ATOMIC_RELAXED, __HIP_MEMORY_SCOPE_AGENT), l0 = __hip_atomic_load(P + 32768 + 256 + wid * QBLK + r32, __ATOMIC_RELAXED, __HIP_MEMORY_SCOPE_AGENT);
            const float M = fmaxf(m0, m_reg), e0 = __builtin_amdgcn_exp2f((m0 - M) * C2), e1 = __builtin_amdgcn_exp2f((m_reg - M) * C2), inv = 1.0f / (e0 * l0 + e1 * l_reg);
            w_own = e1 * inv; if (hi == 0) al_l[r32] = e0 * inv;
        } else { w_own = 1.0f / l_reg; }
        if (hi == 0) li_l[r32] = w_own;
        asm volatile("s_waitcnt lgkmcnt(0)" ::: "memory");
        bf16_t* Ow = cur.O + (size_t)(wid * QBLK) * LDO;
#pragma unroll
        for (int r = 0; r < 16; ++r) { const int orow = crow(r, hi); const float wr_ = li_l[orow];
            float w0_ = 0.f; if (mode == 2) w0_ = al_l[orow];
#pragma unroll
            for (int d0 = 0; d0 < 4; ++d0) { float v = o[d0][r] * wr_;
                if (mode == 2) v += w0_ * __hip_atomic_load(cur.part + (size_t)(wid * QBLK + orow) * 128 + d0 * 32 + r32, __ATOMIC_RELAXED, __HIP_MEMORY_SCOPE_AGENT);
                const float vn = xl::xor1(v);
                if ((r32 & 1) == 0) *(unsigned*)(Ow + (size_t)orow * LDO + d0 * 32 + r32) = cvtpk(v, vn); } }
        __syncthreads();
    }
#undef RESC
#undef KBASE
#undef MASKT
#undef SEAM_K0
#undef HALF_STEP
}
#undef ROW
#undef VMW
#undef VMWN
#undef SLOAD_H
#undef SWRITE_HK
#undef SWRITE_HV
#undef SWRITE_H
#undef KSWZ
#undef SBAR
}

namespace sa {
typedef unsigned short bf16_t;
typedef short bf16x8 __attribute__((ext_vector_type(8)));
typedef float f32x4 __attribute__((ext_vector_type(4)));
typedef unsigned u32x4 __attribute__((ext_vector_type(4)));
typedef unsigned u32x2 __attribute__((ext_vector_type(2)));
constexpr int LD = 1024;
constexpr float C2 = 0.08838834764831845f * 1.4426950408889634f;
constexpr int PART_OFF = 36864, PART_STRIDE = 8320;
struct Item { const float* Kc; const float* Vc; int nk; const float* Kn; const float* Vn; const bf16_t* Q; bf16_t* O; };
__device__ __forceinline__ unsigned cvtpk(float lo, float hi) { return cvt_pk_bf16_rne(lo, hi); }
__device__ __forceinline__ bf16x8 pack8(f32x4 a, f32x4 b) { u32x4 w = {cvtpk(a[0], a[1]), cvtpk(a[2], a[3]), cvtpk(b[0], b[1]), cvtpk(b[2], b[3])}; return *reinterpret_cast<bf16x8*>(&w); }
struct TileRegs { f32x4 ka[4][2]; f32x4 va[4][2]; };
__device__ __forceinline__ void tile_load(TileRegs& T, const float* K, const float* V, int lane) {
    const int q = lane & 15, g = lane >> 4;
    const float* kp = K + (size_t)q * LD + 8 * g;
#pragma unroll
    for (int s = 0; s < 4; ++s) { T.ka[s][0] = __builtin_nontemporal_load((const f32x4*)(kp + 32 * s)); T.ka[s][1] = __builtin_nontemporal_load((const f32x4*)(kp + 32 * s + 4)); }
#pragma unroll
    for (int v = 0; v < 4; ++v) { const float* vp = V + (size_t)(4 * g + v) * LD + 8 * q; T.va[v][0] = __builtin_nontemporal_load((const f32x4*)vp); T.va[v][1] = __builtin_nontemporal_load((const f32x4*)(vp + 4)); }
}
template <bool ISNEW>
__device__ __forceinline__ void tile_compute(const TileRegs& T, const bf16x8 (&qf)[4], const float* bias_t, f32x4 (&o)[8], float& m, float& l, int lane) {
    const int q = lane & 15, g = lane >> 4;
    f32x4 s4 = {0.f, 0.f, 0.f, 0.f};
#pragma unroll
    for (int s = 0; s < 4; ++s) s4 = __builtin_amdgcn_mfma_f32_16x16x32_bf16(pack8(T.ka[s][0], T.ka[s][1]), qf[s], s4, 0, 0, 0);
    const f32x4 b = *(const f32x4*)(bias_t + 4 * g);
    float t[4];
#pragma unroll
    for (int v = 0; v < 4; ++v) { t[v] = fmaf(s4[v], C2, b[v]); if (ISNEW && (4 * g + v) > q) t[v] = -__builtin_inff(); }
    float pmax = fmaxf(fmaxf(t[0], t[1]), fmaxf(t[2], t[3]));
    pmax = xl::max_xor16(pmax); pmax = xl::max_xor32(pmax);
    const float mn = fmaxf(m, pmax), alpha = __builtin_amdgcn_exp2f(m - mn); m = mn;
    float p[4];
#pragma unroll
    for (int v = 0; v < 4; ++v) p[v] = __builtin_amdgcn_exp2f(t[v] - mn);
    l = l * alpha + ((p[0] + p[1]) + (p[2] + p[3]));
    if (__any(alpha != 1.f)) {
#pragma unroll
        for (int j = 0; j < 8; ++j) o[j] = o[j] * alpha; }
#pragma unroll
    for (int v = 0; v < 4; ++v)
#pragma unroll
        for (int j = 0; j < 8; ++j) o[j] = __builtin_amdgcn_mfma_f32_16x16x4f32(T.va[v][j >> 2][j & 3], p[v], o[j], 0, 0, 0);
}
constexpr int PART_SLOT = 32 + 16 * 128;
__device__ __forceinline__ void run_part(const Item& it, int tb, int te, bool with_new, float* slot, char* lds, const int wv) {
    int tid_ = wv * 64 + (int)__builtin_amdgcn_mbcnt_hi(~0u, __builtin_amdgcn_mbcnt_lo(~0u, 0u)); asm volatile("" : "+v"(tid_)); const int tid = tid_, wid = __builtin_amdgcn_readfirstlane(tid >> 6), lane = tid & 63, q = lane & 15, g = lane >> 4;
    const float* bias = (const float*)lds;
    bf16x8 qf[4];
#pragma unroll
    for (int s = 0; s < 4; ++s) qf[s] = *(const bf16x8*)(it.Q + (size_t)q * LD + 32 * s + 8 * g);
    f32x4 o[8];
#pragma unroll
    for (int j = 0; j < 8; ++j) o[j] = (f32x4){0.f, 0.f, 0.f, 0.f};
    float m = -1e30f, l = 0.f;
    const int per = (te - tb) >> 3, t0 = tb + wid * per, t1 = t0 + per;
    TileRegs A, B;
    tile_load(A, it.Kc + (size_t)t0 * 16 * LD, it.Vc + (size_t)t0 * 16 * LD, lane);
    tile_load(B, it.Kc + (size_t)(t0 + 1) * 16 * LD, it.Vc + (size_t)(t0 + 1) * 16 * LD, lane);
    for (int t = t0; t < t1; t += 2) {
        tile_compute<false>(A, qf, bias + t * 16, o, m, l, lane);
        { const int tn = (t + 2 < t1) ? t + 2 : t1 - 1; tile_load(A, it.Kc + (size_t)tn * 16 * LD, it.Vc + (size_t)tn * 16 * LD, lane); }
        tile_compute<false>(B, qf, bias + (t + 1) * 16, o, m, l, lane);
        { const int tn = (t + 3 < t1) ? t + 3 : t1 - 1; tile_load(B, it.Kc + (size_t)tn * 16 * LD, it.Vc + (size_t)tn * 16 * LD, lane); }
    }
    if (with_new && wid == 7) { tile_load(A, it.Kn, it.Vn, lane); tile_compute<true>(A, qf, bias + it.nk, o, m, l, lane); }
    l = xl::sum_xor16(l); l = xl::sum_xor32(l);
    float* part = (float*)(lds + PART_OFF + wid * PART_STRIDE);
    if (g == 0) { part[q] = m; part[16 + q] = l; }
#pragma unroll
    for (int j = 0; j < 8; ++j)
#pragma unroll
        for (int v = 0; v < 4; ++v) part[32 + q * 128 + 32 * g + 8 * v + j] = o[j][v];
    __syncthreads();
    {   const int qq = tid >> 5, d4 = (tid & 31) * 4;
        float mw[8], M = -1e30f;
#pragma unroll
        for (int w = 0; w < 8; ++w) { mw[w] = ((const float*)(lds + PART_OFF + w * PART_STRIDE))[qq]; M = fmaxf(M, mw[w]); }
        float den = 0.f; f32x4 num = {0.f, 0.f, 0.f, 0.f};
#pragma unroll
        for (int w = 0; w < 8; ++w) { const float* pw = (const float*)(lds + PART_OFF + w * PART_STRIDE); const float e = __builtin_amdgcn_exp2f(mw[w] - M);
            den += e * pw[16 + qq]; num += *(const f32x4*)(pw + 32 + qq * 128 + d4) * e; }
        if ((tid & 31) == 0) { __hip_atomic_store(slot + qq, M, __ATOMIC_RELAXED, __HIP_MEMORY_SCOPE_AGENT); __hip_atomic_store(slot + 16 + qq, den, __ATOMIC_RELAXED, __HIP_MEMORY_SCOPE_AGENT); }
#pragma unroll
        for (int e = 0; e < 4; ++e) __hip_atomic_store(slot + 32 + qq * 128 + d4 + e, num[e], __ATOMIC_RELAXED, __HIP_MEMORY_SCOPE_AGENT); }
    __syncthreads();
}
template <int NP>
__device__ __forceinline__ void combine_row(const float* slot0, int q, bf16_t* orow, int lane) {
    const float* sl = slot0 + (size_t)(lane < NP ? lane : 0) * PART_SLOT;
    float mp = __hip_atomic_load(sl + q, __ATOMIC_RELAXED, __HIP_MEMORY_SCOPE_AGENT), lp = __hip_atomic_load(sl + 16 + q, __ATOMIC_RELAXED, __HIP_MEMORY_SCOPE_AGENT);
    if (lane >= NP) { mp = -1e30f; lp = 0.f; }
    unsigned long long v[NP];
#pragma unroll
    for (int p = 0; p < NP; ++p) v[p] = __hip_atomic_load((const unsigned long long*)(slot0 + (size_t)p * PART_SLOT + 32 + q * 128 + 2 * lane), __ATOMIC_RELAXED, __HIP_MEMORY_SCOPE_AGENT);
    const float M = xl::wave_max(mp);
    float e = __builtin_amdgcn_exp2f(mp - M); if (lane >= NP) e = 0.f;
    const float den = xl::wave_sum(e * lp);
    float n0 = 0.f, n1 = 0.f;
#pragma unroll
    for (int p = 0; p < NP; ++p) { const float ep = __int_as_float(__builtin_amdgcn_readlane(__float_as_int(e), p)); n0 += ep * __uint_as_float((unsigned)v[p]); n1 += ep * __uint_as_float((unsigned)(v[p] >> 32)); }
    const float inv = 1.0f / den;
    *(unsigned*)(orow + 2 * lane) = cvtpk(n0 * inv, n1 * inv);
}
}
namespace sk {
typedef unsigned short bf16_t;
typedef short bf16x8 __attribute__((ext_vector_type(8)));
typedef float f32x4 __attribute__((ext_vector_type(4)));
constexpr int ROW0 = 8192, NRG = 5;
struct Frags { bf16x8 a[4]; bf16x8 w[4]; };
__device__ __forceinline__ void load_frags(Frags& F, const bf16_t* ap, const bf16_t* wp, int K  ) {
#pragma unroll
    for (int i = 0; i < 4; ++i) { F.a[i] = *(const bf16x8*)(ap + (size_t)i * 16 * K); F.w[i] = *(const bf16x8*)(wp + (size_t)i * 16 * K); }
}
__device__ __forceinline__ void mma_frags(const Frags& F, f32x4 (&acc)[4][4]) {
#pragma unroll
    for (int i = 0; i < 4; ++i)
#pragma unroll
        for (int cb = 0; cb < 4; ++cb) acc[i][cb] = __builtin_amdgcn_mfma_f32_16x16x32_bf16(F.w[cb], F.a[i], acc[i][cb], 0, 0, 0);
}
__device__ __forceinline__ void job(const bf16_t* A, const bf16_t* Bt, int K, int ld  , int rg, int n0, char* lds, const int wv, f32x4& out0, f32x4& out1) {
    int tid_ = wv * 64 + (int)__builtin_amdgcn_mbcnt_hi(~0u, __builtin_amdgcn_mbcnt_lo(~0u, 0u)); asm volatile("" : "+v"(tid_)); const int tid = tid_, wid = __builtin_amdgcn_readfirstlane(tid >> 6), lane = tid & 63, r = lane & 15, g = lane >> 4;
    const int kw = K >> 3, nks = kw >> 5;
    const bf16_t* ap = A + (size_t)(ROW0 + 64 * rg + r) * ld + wid * kw + 8 * g;
    const bf16_t* wp = Bt + (size_t)(n0 + r) * ld + wid * kw + 8 * g;
    f32x4 acc[4][4];
#pragma unroll
    for (int i = 0; i < 4; ++i)
#pragma unroll
        for (int cb = 0; cb < 4; ++cb) acc[i][cb] = (f32x4){0.f, 0.f, 0.f, 0.f};
    Frags F0, F1;
    load_frags(F0, ap, wp, ld);
    for (int ks = 0; ks < nks; ks += 2) {
        load_frags(F1, ap + (ks + 1) * 32, wp + (ks + 1) * 32, ld);
        mma_frags(F0, acc);
        { const int kn = (ks + 2 < nks) ? ks + 2 : nks - 1; load_frags(F0, ap + kn * 32, wp + kn * 32, ld); }
        mma_frags(F1, acc);
    }
    float* part = (float*)lds + (size_t)(wid * 64 + r) * 64 + 4 * g;
#pragma unroll
    for (int i = 0; i < 4; ++i)
#pragma unroll
        for (int cb = 0; cb < 4; ++cb) *(f32x4*)(part + (size_t)i * 16 * 64 + 16 * cb) = acc[i][cb];
    __syncthreads();
    { const int row = tid >> 3, c8 = (tid & 7) * 8; const float* p = (const float*)lds + (size_t)row * 64 + c8;
      f32x4 s0 = *(const f32x4*)p, s1 = *(const f32x4*)(p + 4);
#pragma unroll
      for (int w = 1; w < 8; ++w) { s0 += *(const f32x4*)(p + (size_t)w * 4096); s1 += *(const f32x4*)(p + (size_t)w * 4096 + 4); }
      out0 = s0; out1 = s1; }
    __syncthreads();
}
}
#define GAS __attribute__((address_space(1)))
#define LAS __attribute__((address_space(3)))
typedef unsigned short bf16;
typedef unsigned v4u __attribute__((ext_vector_type(4)));
typedef float f32x4 __attribute__((ext_vector_type(4)));
typedef short bf16x8 __attribute__((ext_vector_type(8)));
typedef GAS unsigned gu32;
typedef GAS unsigned long long gu64;
#define RLX_AGENT __ATOMIC_RELAXED, __HIP_MEMORY_SCOPE_AGENT
#define LDS_WAIT() asm volatile("s_waitcnt lgkmcnt(0)" ::: "memory")
#define VM_WAIT() asm volatile("s_waitcnt vmcnt(0)" ::: "memory")
__device__ __forceinline__ unsigned long long rt() { return __builtin_amdgcn_s_memrealtime(); }
__device__ __forceinline__ unsigned f2bf(float f) { unsigned u = __builtin_bit_cast(unsigned, f); return (u + 0x7fffu + ((u >> 16) & 1u)) >> 16; }
__device__ __forceinline__ unsigned pk2(float lo, float hi) { return cvt_pk_bf16_rne(lo, hi); }

#define XB_TMO      128
#define XB_XCNT(j)  (256  + 64 * (j))
#define XB_XSUB(j)  (1280 + 64 * (j))
#define XB_XGEN(j)  (2304 + 64 * (j))
#define XB_TOP      3328
#define XB_TOPGEN   3392
#define XCD_BAR_WORDS 3456
#define XB_SPIN_CAP (1u << 18)

__device__ __forceinline__ unsigned xb_ld(unsigned* p)              { return __hip_atomic_load(p, __ATOMIC_RELAXED, __HIP_MEMORY_SCOPE_AGENT); }
__device__ __forceinline__ unsigned xb_add(unsigned* p, unsigned v) { return __hip_atomic_fetch_add(p, v, __ATOMIC_RELAXED, __HIP_MEMORY_SCOPE_AGENT); }
__device__ __forceinline__ unsigned xb_xcc_id() { return (unsigned)__builtin_amdgcn_s_getreg((3 << 11) | 20) & 0xFu; }
#define XB_SPIN(cond, bar) do { unsigned _sp = 0; while (cond) { __builtin_amdgcn_s_sleep(1); \
    if ((++_sp & 255u) == 0u) { if (xb_ld(&(bar)[XB_TMO])) break; if (_sp > XB_SPIN_CAP) { atomicAdd(&(bar)[XB_TMO], 1u); break; } } } } while (0)

struct XcdBarrier {
    unsigned* bar; unsigned x;
    volatile LAS unsigned* st;
};

__device__ __forceinline__ XcdBarrier xcd_barrier_post(unsigned* bar, volatile LAS unsigned* st) {
    XcdBarrier b; b.bar = bar; b.x = xb_xcc_id(); b.st = st;
    if (threadIdx.x == 0) (void)xb_add(&bar[XB_XCNT(b.x)], 1u);
    return b;
}
__device__ __forceinline__ void xcd_barrier_complete(unsigned* bar, unsigned x, unsigned& nloc, unsigned& nx) {
    const unsigned G = gridDim.x * gridDim.y * gridDim.z;
    unsigned sum, cnt, mine, sp = 0u;
    for (;;) {
        sum = 0u; cnt = 0u; mine = 0u;
#pragma unroll
        for (unsigned j = 0; j < 16; ++j) { const unsigned c = xb_ld(&bar[XB_XCNT(j)]); sum += c; cnt += (c > 0u) ? 1u : 0u; mine = (j == x) ? c : mine; }
        if (sum == G) break;
        __builtin_amdgcn_s_sleep(1);
        if ((++sp & 255u) == 0u) { if (xb_ld(&bar[XB_TMO])) break; if (sp > XB_SPIN_CAP) { atomicAdd(&bar[XB_TMO], 1u); break; } }
    }
    nloc = mine > 0u ? mine : 1u; nx = cnt > 0u ? cnt : 1u;
}

__device__ __forceinline__ void xcd_barrier(const XcdBarrier& b) {
    asm volatile("s_waitcnt vmcnt(0)" ::: "memory");
    __syncthreads();
    if (threadIdx.x == 0) {
        unsigned* bar = b.bar;
        __builtin_amdgcn_s_waitcnt(0);
        unsigned nloc = b.st[0], nx = b.st[1];
        if (nloc == 0u) { xcd_barrier_complete(bar, b.x, nloc, nx); b.st[0] = nloc; b.st[1] = nx; }
        const unsigned old = xb_add(&bar[XB_XSUB(b.x)], 1u);
        const unsigned gen = old / nloc;
        if (old + 1u == (gen + 1u) * nloc) {
            __builtin_amdgcn_fence(__ATOMIC_RELEASE, "agent");
            asm volatile("s_waitcnt vmcnt(0)" ::: "memory");
            const unsigned og = xb_add(&bar[XB_TOP], 1u);
            const unsigned tg = og / nx;
            if (og + 1u == (tg + 1u) * nx) xb_add(&bar[XB_TOPGEN], 1u);
            else XB_SPIN(xb_ld(&bar[XB_TOPGEN]) == tg, bar);
            __builtin_amdgcn_fence(__ATOMIC_ACQUIRE, "agent");
            asm volatile("s_waitcnt vmcnt(0)" ::: "memory");
        } else {
            XB_SPIN(xb_ld(&bar[XB_TOPGEN]) == gen, bar);
            __builtin_amdgcn_fence(__ATOMIC_ACQUIRE, "agent");
            asm volatile("s_waitcnt vmcnt(0)" ::: "memory");
        }
    }
    __syncthreads();
}
using pg8::MP; using pg8::MREAL; using pg8::NSAMP; using pg8::LPR; using pg8::SROW0;
constexpr int NWAVES = 8;
constexpr size_t MiB = 1u << 20;
constexpr size_t WS_CTL = 0, CTL_ZERO_BYTES = 1 * MiB;
constexpr int CW_BAR = 4096;
constexpr int CW_CNT = 12288;
constexpr int CW_FLAG = 16384;
constexpr size_t SSQ_OFF = 808 * MiB;
constexpr size_t WS_BIAS1 = 1 * MiB;
constexpr size_t WS_W1T = 2 * MiB, WS_WPCT = 84 * MiB, WS_WPAT = 92 * MiB, WS_WOT = 100 * MiB, WS_WUPT = 116 * MiB, WS_WDNT = 180 * MiB;
constexpr size_t WS_X = 212 * MiB, WS_XB = 280 * MiB, WS_Q = 314 * MiB, WS_K = 331 * MiB, WS_V = 348 * MiB, WS_P = 365 * MiB, WS_BC = 382 * MiB, WS_YC = 399 * MiB, WS_YA = 416 * MiB;
constexpr size_t WS_SGC = 433 * MiB, WS_SGA = 467 * MiB, WS_T1 = 501 * MiB, WS_MG = 569 * MiB, WS_U = 603 * MiB, WS_G = 739 * MiB, WS_LOGF = 807 * MiB, WS_PART = 814 * MiB, WS_CPART = 832 * MiB, WS_HALO = 838 * MiB, WS_PH = 858 * MiB, WS_END = 864 * MiB;
static_assert(WS_W1T + 2ull * 10496 * 2048 * 2 <= WS_WPCT && WS_WUPT + 2ull * 8192 * 2048 * 2 <= WS_WDNT && WS_WDNT + 2ull * 2048 * 4096 * 2 <= WS_X, "weight map");
static_assert(WS_X + (size_t)MP * 2048 * 4 <= WS_XB && WS_XB + (size_t)MP * 2048 * 2 <= WS_Q && WS_Q + (size_t)MP * 1024 * 2 <= WS_K && WS_T1 + (size_t)MP * 2048 * 4 <= WS_MG, "activation map");
static_assert(WS_U + (size_t)MP * 8192 * 2 <= WS_G && WS_G + (size_t)MP * 4096 * 2 <= WS_LOGF && WS_LOGF + (size_t)MP * 8 * 4 <= SSQ_OFF && SSQ_OFF + 5ull * MP * 32 * 4 <= WS_PART && WS_PART + 128ull * pa::PART_FLOATS * 4 <= WS_CPART && WS_CPART + 512ull * sa::PART_SLOT * 4 <= WS_HALO && WS_HALO + (size_t)pg8::HALO_SLOTS * 8192 * 4 <= WS_PH && WS_PH + (size_t)pg8::HALO_SLOTS * 2048 * 4 <= WS_END && (CW_FLAG + 2 * 128 * 64) * 4 <= (int)CTL_ZERO_BYTES, "map");
constexpr int RING_OFF = 0, RING_BYTES = 131072;
constexpr int LDS_BYTES = 147456, LDSCTL_OFF = 146944;
constexpr int RST_OFF = 131072;
constexpr int ATT_BIAS_OFF = 69632;
constexpr int SCAN_SCR_OFF = 103424;
constexpr int TR_PITCH = 65, TR_BYTES = 64 * TR_PITCH * 4;
static_assert(NWAVES * TR_BYTES <= LDSCTL_OFF && pa::LDS_ATT <= ATT_BIAS_OFF && ATT_BIAS_OFF + 8448 * 4 <= SCAN_SCR_OFF && sa::PART_OFF + 8 * sa::PART_STRIDE <= SCAN_SCR_OFF, "LDS map");
constexpr float LOG2E = 1.4426950408889634f;
constexpr int IDLE1 = 34 * 41 - 5 * 256, IDLE5 = 34 * 32 - 4 * 256;

struct Frame {
    LAS unsigned char* lds; volatile LAS unsigned* MISC; gu32* ctl;
    int wv, G, bx;
};
__device__ __forceinline__ int opaque_s(int v) { asm volatile("" : "+s"(v)); return v; }
__device__ __forceinline__ int lane_id() { return (int)__builtin_amdgcn_mbcnt_hi(~0u, __builtin_amdgcn_mbcnt_lo(~0u, 0u)); }
__device__ __forceinline__ int phase_tid(const Frame& F) { int t = F.wv * 64 + lane_id(); asm volatile("" : "+v"(t)); return t; }
struct MapIdent { __device__ __forceinline__ int operator()(int n) const { return n; } };
struct MapIn { __device__ __forceinline__ int operator()(int n) const {
    const int T = n >> 8, c = n & 255;
    if (T < 16) { const int bj = c >> 7, wc = (c >> 5) & 3, nn = (c >> 4) & 1, fq = (c >> 2) & 3, e = c & 3; return (bj * 2 + nn) * 1024 + 64 * T + 16 * wc + 4 * fq + e; }
    if (T < 24) return 4096 + ((T - 16) << 8) + c;
    if (T < 40) return 6152 + (c >> 7) * 2048 + 128 * (T - 24) + (c & 127);
    return c < 8 ? 6144 + c : -1; } };
struct MapUp { __device__ __forceinline__ int operator()(int n) const { const int T = n >> 8, c = n & 255; return (c >> 7) * 4096 + 128 * T + (c & 127); } };
struct TrItem { f32x4 v[16]; };
template <class Map>
__device__ __forceinline__ void tr_load(TrItem& T, const float* __restrict__ W, int Nsrc, int k0, int n0, int lane, Map map) {
    const int nloc = (lane & 15) * 4, src = map(n0 + nloc), kr = lane >> 4;
#pragma unroll
    for (int i = 0; i < 16; ++i) { const int kk = kr + 4 * i; T.v[i] = src >= 0 ? *(const GAS f32x4*)(W + (size_t)(k0 + kk) * Nsrc + src) : (f32x4){0.f, 0.f, 0.f, 0.f}; }
}
__device__ __forceinline__ void tr_store(const TrItem& T, int K  , const float* __restrict__ gsc, bf16* __restrict__ WT, int k0, int n0, LAS float* scr, int lane) {
    const int nloc = (lane & 15) * 4, kr = lane >> 4;
#pragma unroll
    for (int i = 0; i < 16; ++i) { const int kk = kr + 4 * i; const float g = gsc ? gsc[k0 + kk] : 1.0f; LAS float* s = scr + kk * TR_PITCH + nloc;
        s[0] = T.v[i][0] * g; s[1] = T.v[i][1] * g; s[2] = T.v[i][2] * g; s[3] = T.v[i][3] * g; }
    const int c = lane & 7;
#pragma unroll
    for (int j = 0; j < 8; ++j) { const int n = (lane >> 3) + 8 * j; const LAS float* s = scr + (8 * c) * TR_PITCH + n;
        v4u o; o.x = pk2(s[0 * TR_PITCH], s[1 * TR_PITCH]); o.y = pk2(s[2 * TR_PITCH], s[3 * TR_PITCH]); o.z = pk2(s[4 * TR_PITCH], s[5 * TR_PITCH]); o.w = pk2(s[6 * TR_PITCH], s[7 * TR_PITCH]);
        *(GAS v4u*)(WT + (size_t)(n0 + n) * K + k0 + 8 * c) = o; }
}
template <class Map>
__device__ __forceinline__ void transpose_matrix(Frame& F, const int vbx, const int vG, const float* W, int K, int Nsrc, int Ndst, const float* gsc, bf16* WT, Map map, int ldw = 0  ) {
    LAS float* scr = (LAS float*)(F.lds + F.wv * TR_BYTES); const int lane = phase_tid(F) & 63;
    const int nkb = K / 64, nnb = Ndst / 64, nsn = nnb >> 1, nst = (nkb >> 2) * nsn, G = vG, kbo = F.wv >> 1, nbo = F.wv & 1;
    if (vbx >= nst) return;
    const int pitch = ldw ? ldw : K;
    TrItem A, B;
#define TR_K0(st) ((4 * ((st) / nsn) + kbo) * 64)
#define TR_N0(st) ((2 * ((st) % nsn) + nbo) * 64)
    tr_load(A, W, Nsrc, TR_K0(vbx), TR_N0(vbx), lane, map);
    for (int st = vbx; st < nst; st += 2 * G) {
        const int s1 = st + G < nst ? st + G : st, s2 = st + 2 * G < nst ? st + 2 * G : s1;
        tr_load(B, W, Nsrc, TR_K0(s1), TR_N0(s1), lane, map);
        tr_store(A, pitch, gsc, WT, TR_K0(st), TR_N0(st), scr, lane);
        tr_load(A, W, Nsrc, TR_K0(s2), TR_N0(s2), lane, map);
        if (st + G < nst) tr_store(B, pitch, gsc, WT, TR_K0(s1), TR_N0(s1), scr, lane);
    }
#undef TR_K0
#undef TR_N0
}
typedef __attribute__((address_space(4))) const unsigned char* kptr_t;
__device__ __forceinline__ kptr_t kargs() { kptr_t p = (kptr_t)__builtin_amdgcn_kernarg_segment_ptr(); asm volatile("" : "+s"(p)); return p; }
#define ARG_IN(i) (*(const __attribute__((address_space(4))) float* const __attribute__((address_space(4)))*)(kargs() + 8 * (i)))
struct Args { const float* in[21]; float* out; unsigned char* ws; int pad0, pad1; };

__device__ __forceinline__ void phase_conv_yc(Frame& F, const bf16* P, const bf16* BC, bf16* YC, const float* wconv  , const float* state  ) {
    const int NT = F.G * NWAVES * 64, t0 = F.bx * NWAVES * 64 + phase_tid(F);
    for (int idx = t0; idx < MREAL * 128; idx += NT) {
        const int row = idx >> 7, c8 = (idx & 127) * 8;
        const v4u bcv = *(const GAS v4u*)(BC + (size_t)row * 1024 + c8), p0v = *(const GAS v4u*)(P + (size_t)row * 1024 + c8);
        float pm1[8], pm2[8];
        int t; const float* st = nullptr;
        if (row >= SROW0) { t = (row - SROW0) & 15; st = state + (size_t)((row - SROW0) >> 4) * 2048 + c8; } else { t = row; }
        if (t >= 1) { const v4u w = *(const GAS v4u*)(P + (size_t)(row - 1) * 1024 + c8);
#pragma unroll
            for (int e = 0; e < 4; ++e) { pm1[2 * e] = __uint_as_float(w[e] << 16); pm1[2 * e + 1] = __uint_as_float(w[e] & 0xffff0000u); } }
        else {
#pragma unroll
            for (int e = 0; e < 8; ++e) pm1[e] = st ? st[1024 + e] : 0.f; }
        if (t >= 2) { const v4u w = *(const GAS v4u*)(P + (size_t)(row - 2) * 1024 + c8);
#pragma unroll
            for (int e = 0; e < 4; ++e) { pm2[2 * e] = __uint_as_float(w[e] << 16); pm2[2 * e + 1] = __uint_as_float(w[e] & 0xffff0000u); } }
        else {
#pragma unroll
            for (int e = 0; e < 8; ++e) pm2[e] = st ? st[(t == 1 ? 1024 : 0) + e] : 0.f; }
        float y[8];
#pragma unroll
        for (int e = 0; e < 8; ++e) { const unsigned pw = p0v[e >> 1], bw = bcv[e >> 1];
            const float p0 = (e & 1) ? __uint_as_float(pw & 0xffff0000u) : __uint_as_float(pw << 16), bcf = (e & 1) ? __uint_as_float(bw & 0xffff0000u) : __uint_as_float(bw << 16);
            y[e] = bcf * (wconv[c8 + e] * pm2[e] + wconv[1024 + c8 + e] * pm1[e] + wconv[2048 + c8 + e] * p0); }
        v4u o; o.x = pk2(y[0], y[1]); o.y = pk2(y[2], y[3]); o.z = pk2(y[4], y[5]); o.w = pk2(y[6], y[7]);
        *(GAS v4u*)(YC + (size_t)row * 1024 + c8) = o;
    }
}
__device__ __forceinline__ void load_u8(float (&d)[8], const bf16* p) { const v4u w = *(const GAS v4u*)p;
#pragma unroll
    for (int e = 0; e < 4; ++e) { d[2 * e] = __uint_as_float(w[e] << 16); d[2 * e + 1] = __uint_as_float(w[e] & 0xffff0000u); } }
__device__ __forceinline__ void phase_ffn_gate(Frame& F, const bf16* U, bf16* Gb, const float* wf  , const float* bfc  , const float* state  ) {
    const int NT = F.G * NWAVES * 64, t0 = F.bx * NWAVES * 64 + phase_tid(F);
    for (int idx = t0; idx < MREAL * 512; idx += NT) {
        const int row = idx >> 9, ch = (idx & 511) * 8, ua = 256 * (ch >> 7) + (ch & 127);
        float a0[8], a1[8], a2[8], b0[8], b1[8], b2[8];
        load_u8(a0, U + (size_t)row * 8192 + ua); load_u8(b0, U + (size_t)row * 8192 + ua + 128);
        int t; const float* st = nullptr;
        if (row >= SROW0) { t = (row - SROW0) & 15; st = state + (size_t)((row - SROW0) >> 4) * 2 * 8192; } else { t = row; }
        if (t >= 1) { load_u8(a1, U + (size_t)(row - 1) * 8192 + ua); load_u8(b1, U + (size_t)(row - 1) * 8192 + ua + 128); }
        else {
#pragma unroll
            for (int e = 0; e < 8; ++e) { a1[e] = st ? st[8192 + ch + e] : 0.f; b1[e] = st ? st[8192 + 4096 + ch + e] : 0.f; } }
        if (t >= 2) { load_u8(a2, U + (size_t)(row - 2) * 8192 + ua); load_u8(b2, U + (size_t)(row - 2) * 8192 + ua + 128); }
        else { const int so = (t == 1) ? 8192 : 0;
#pragma unroll
            for (int e = 0; e < 8; ++e) { a2[e] = st ? st[so + ch + e] : 0.f; b2[e] = st ? st[so + 4096 + ch + e] : 0.f; } }
        float y[8];
        float w0a[8], w1a[8], w2a[8], bsa[8], w0b[8], w1b[8], w2b[8], bsb[8];
#define LD8(dst, p) do { const f32x4 q0_ = *(const GAS f32x4*)(p), q1_ = *(const GAS f32x4*)((p) + 4); dst[0] = q0_[0]; dst[1] = q0_[1]; dst[2] = q0_[2]; dst[3] = q0_[3]; dst[4] = q1_[0]; dst[5] = q1_[1]; dst[6] = q1_[2]; dst[7] = q1_[3]; } while (0)
        LD8(w0a, wf + ch); LD8(w1a, wf + 8192 + ch); LD8(w2a, wf + 16384 + ch); LD8(bsa, bfc + ch);
        LD8(w0b, wf + 4096 + ch); LD8(w1b, wf + 8192 + 4096 + ch); LD8(w2b, wf + 16384 + 4096 + ch); LD8(bsb, bfc + 4096 + ch);
#undef LD8
#pragma unroll
        for (int e = 0; e < 8; ++e) {
            const float A = w0a[e] * a2[e] + w1a[e] * a1[e] + w2a[e] * a0[e] + bsa[e];
            const float B = w0b[e] * b2[e] + w1b[e] * b1[e] + w2b[e] * b0[e] + bsb[e];
            y[e] = A * pg8::sigmoidf_(A) * B; }
        v4u o; o.x = pk2(y[0], y[1]); o.y = pk2(y[2], y[3]); o.z = pk2(y[4], y[5]); o.w = pk2(y[6], y[7]);
        *(GAS v4u*)(Gb + (size_t)row * 4096 + ch) = o;
    }
}
__device__ __forceinline__ void phase_yc_fixup(Frame& F, const float* PH, bf16* YC, const float* wconv  , const float* state  ) {
    const int NT = F.G * NWAVES * 64, t0 = F.bx * NWAVES * 64 + phase_tid(F);
    for (int idx = t0; idx < 290 * 128; idx += NT) {
        const int ri = idx >> 7, ch = (idx & 127) * 8;
        const int row = ri < 256 ? (ri >> 1) * 64 + (ri & 1) : 8192 + ((ri - 256) >> 1) * 16 + ((ri - 256) & 1);
        const float* u0 = PH + (size_t)pg8::halo_slot(row) * 2048; const float* u1 = nullptr; const float* u2 = nullptr;
        if (row < SROW0) { if (row >= 1) u1 = PH + (size_t)pg8::halo_slot(row - 1) * 2048; if (row >= 2) u2 = PH + (size_t)pg8::halo_slot(row - 2) * 2048; }
        else { const int t = (row - SROW0) & 15; const float* st = state + (size_t)((row - SROW0) >> 4) * 2048;
            if (t == 0) { u1 = st + 1024; u2 = st; } else { u1 = PH + (size_t)pg8::halo_slot(row - 1) * 2048; u2 = st + 1024; } }
        float y[8];
#pragma unroll
        for (int e = 0; e < 8; ++e) { const int c = ch + e; y[e] = u0[1024 + c] * (wconv[c] * (u2 ? u2[c] : 0.f) + wconv[1024 + c] * (u1 ? u1[c] : 0.f) + wconv[2048 + c] * u0[c]); }
        v4u o; o.x = pk2(y[0], y[1]); o.y = pk2(y[2], y[3]); o.z = pk2(y[4], y[5]); o.w = pk2(y[6], y[7]);
        *(GAS v4u*)(YC + (size_t)row * 2048 + ch) = o;
    }
}
__device__ __forceinline__ void phase_ffn_fixup(Frame& F, const float* HALO, bf16* Gb, const float* wf  , const float* bfc  , const float* state  ) {
    const int NT = F.G * NWAVES * 64, t0 = F.bx * NWAVES * 64 + phase_tid(F);
    for (int idx = t0; idx < 290 * 512; idx += NT) {
        const int ri = idx >> 9, ch = (idx & 511) * 8;
        const int row = ri < 256 ? (ri >> 1) * 64 + (ri & 1) : 8192 + ((ri - 256) >> 1) * 16 + ((ri - 256) & 1);
        const float* u0 = HALO + (size_t)pg8::halo_slot(row) * 8192; const float* u1 = nullptr; const float* u2 = nullptr;
        if (row < SROW0) { if (row >= 1) u1 = HALO + (size_t)pg8::halo_slot(row - 1) * 8192; if (row >= 2) u2 = HALO + (size_t)pg8::halo_slot(row - 2) * 8192; }
        else { const int t = (row - SROW0) & 15; const float* st = state + (size_t)((row - SROW0) >> 4) * 2 * 8192;
            if (t == 0) { u1 = st + 8192; u2 = st; } else { u1 = HALO + (size_t)pg8::halo_slot(row - 1) * 8192; u2 = st + 8192; } }
        float y[8];
#pragma unroll
        for (int e = 0; e < 8; ++e) { const int ca = ch + e, cb = 4096 + ch + e;
            const float A = wf[ca] * (u2 ? u2[ca] : 0.f) + wf[8192 + ca] * (u1 ? u1[ca] : 0.f) + wf[16384 + ca] * u0[ca] + bfc[ca];
            const float B = wf[cb] * (u2 ? u2[cb] : 0.f) + wf[8192 + cb] * (u1 ? u1[cb] : 0.f) + wf[16384 + cb] * u0[cb] + bfc[cb];
            y[e] = A * pg8::sigmoidf_(A) * B; }
        v4u o; o.x = pk2(y[0], y[1]); o.y = pk2(y[2], y[3]); o.z = pk2(y[4], y[5]); o.w = pk2(y[6], y[7]);
        *(GAS v4u*)(Gb + (size_t)row * 4096 + ch) = o;
    }
}
template <int CH>
__device__ __forceinline__ void block_cumsum(const float* src, int stride, int n, float* dst, float* wtot, float scale, bool subT, int tid) {
    asm volatile("" : "+v"(tid));
    const int lane = tid & 63, wid = tid >> 6, i0 = tid * CH;
    float v[CH]; float run = 0.f;
#pragma unroll
    for (int j = 0; j < CH; ++j) { const int i = i0 + j; const float x = i < n ? src[(size_t)i * stride] : 0.f; run += x; v[j] = run; }
    const float inc = xl::wave_incl_scan(run, lane);
    if (lane == 63) wtot[wid] = inc;
    __syncthreads();
    float off = inc - run, tot = 0.f;
#pragma unroll
    for (int w = 0; w < 8; ++w) { const float x = wtot[w]; if (w < wid) off += x; tot += x; }
    const float sub = subT ? tot : 0.f;
#pragma unroll
    for (int j = 0; j < CH; ++j) if (i0 + j < n) dst[i0 + j] = scale * (off + v[j] - sub);
    __syncthreads();
}

__device__ __forceinline__ void unpack8(float (&d)[8], const v4u w) {
#pragma unroll
    for (int e = 0; e < 4; ++e) { d[2 * e] = __uint_as_float(w[e] << 16); d[2 * e + 1] = __uint_as_float(w[e] & 0xffff0000u); } }
__device__ __forceinline__ void skinny_merged(Frame& F, const bf16* YCA, const bf16* WCA, const bf16* RG, const unsigned char* SGA, bf16* MG, unsigned char* lds) {
    if (F.bx >= 160) return;
    const int rg = F.bx >> 5, n0 = (F.bx & 31) * 64, tid = phase_tid(F), row = sk::ROW0 + 64 * rg + (tid >> 3), col = n0 + (tid & 7) * 8;
    f32x4 a0, a1, b0, b1;
    sk::job(YCA, WCA, 1024, 2048, rg, n0, (char*)lds, F.wv, a0, a1);
    sk::job(YCA + 1024, WCA + 1024, 1024, 2048, rg, n0, (char*)lds, F.wv, b0, b1);
    if (row >= MREAL) return;
    float r[8], ga[8]; unpack8(r, *(const GAS v4u*)(RG + (size_t)row * 2048 + col));
    { const pg8::u32x2 gq = *(const GAS pg8::u32x2*)(SGA + (size_t)row * 2048 + col);
#pragma unroll
      for (int e = 0; e < 4; ++e) { ga[e] = (float)((gq.x >> (8 * e)) & 255u) * (1.0f / 255.0f); ga[4 + e] = (float)((gq.y >> (8 * e)) & 255u) * (1.0f / 255.0f); } }
    v4u o; o.x = pk2(ga[0] * (r[0] * a0[0] + b0[0]), ga[1] * (r[1] * a0[1] + b0[1])); o.y = pk2(ga[2] * (r[2] * a0[2] + b0[2]), ga[3] * (r[3] * a0[3] + b0[3]));
    o.z = pk2(ga[4] * (r[4] * a1[0] + b1[0]), ga[5] * (r[5] * a1[1] + b1[1])); o.w = pk2(ga[6] * (r[6] * a1[2] + b1[2]), ga[7] * (r[7] * a1[3] + b1[3]));
    *(GAS v4u*)(MG + (size_t)row * 2048 + col) = o;
}
__device__ __forceinline__ void skinny_res(Frame& F, const bf16* A, const bf16* Bt, int K, bf16* XB, float* ssq_next, unsigned char* lds) {
    if (F.bx >= 160) return;
    const int rg = F.bx >> 5, n0 = (F.bx & 31) * 64, tid = phase_tid(F), row = sk::ROW0 + 64 * rg + (tid >> 3), col = n0 + (tid & 7) * 8;
    f32x4 a0, a1;
    sk::job(A, Bt, K, K, rg, n0, (char*)lds, F.wv, a0, a1);
    if (row >= MREAL) return;
    float xo[8]; unpack8(xo, *(const GAS v4u*)(XB + (size_t)row * 2048 + col));
    const f32x4 x0 = (f32x4){xo[0], xo[1], xo[2], xo[3]} + a0, x1 = (f32x4){xo[4], xo[5], xo[6], xo[7]} + a1;
    v4u o; o.x = pk2(x0[0], x0[1]); o.y = pk2(x0[2], x0[3]); o.z = pk2(x1[0], x1[1]); o.w = pk2(x1[2], x1[3]);
    *(GAS v4u*)(XB + (size_t)row * 2048 + col) = o;
    float s = ((x0[0] * x0[0] + x0[1] * x0[1]) + (x0[2] * x0[2] + x0[3] * x0[3])) + ((x1[0] * x1[0] + x1[1] * x1[1]) + (x1[2] * x1[2] + x1[3] * x1[3]));
    s += xl::xor1(s); s += __int_as_float(__builtin_amdgcn_update_dpp(0, __float_as_int(s), 0x4E, 0xf, 0xf, true)); s += xl::row_shr<4>(s);
    if ((tid & 7) == 7) ssq_next[(size_t)row * 32 + (n0 >> 6)] = s;
}
__device__ __forceinline__ void part_arrive2(Frame& F, gu32* cnt_a, unsigned na, gu32* cnt_b, unsigned nb, bool& last_a, bool& last_b) {
    asm volatile("s_waitcnt vmcnt(0)" ::: "memory");
    __syncthreads();
    const int t = phase_tid(F);
    if (t < 2) F.MISC[12 + t] = __hip_atomic_fetch_add((unsigned*)(t == 0 ? cnt_a : cnt_b), 1u, __ATOMIC_RELAXED, __HIP_MEMORY_SCOPE_AGENT);
    __syncthreads();
    const unsigned oa = F.MISC[12], ob = F.MISC[13];
    __syncthreads();
    last_a = oa + 1u == na; last_b = ob + 1u == nb;
}
#define GRID_BAR() do { XcdBarrier b_ = bar; asm volatile("" : "+s"(b_.bar), "+s"(b_.x)); xcd_barrier(b_); } while (0)
#ifndef REP_PR
#define REP_PR 1
#endif
#ifndef REP_CH
#define REP_CH 1
#endif
#ifndef REP_CHS
#define REP_CHS 1
#endif
#ifndef REP_CHT
#define REP_CHT 1
#endif
#ifndef REP_P0
#define REP_P0 1
#endif
#ifndef REP_G1
#define REP_G1 1
#endif
#ifndef REP_ATT
#define REP_ATT 1
#endif
#ifndef REP_G4
#define REP_G4 1
#endif
#ifndef REP_E4
#define REP_E4 1
#endif
#ifndef REP_G2
#define REP_G2 1
#endif
#ifndef STOP_AFTER
#define STOP_AFTER 0
#endif
__device__ __forceinline__ void diag_dump(int k, int t0, int NT, float* out, unsigned char* ws) {
    const bf16* a = nullptr; const bf16* b = nullptr; const float* x = nullptr; int lda = 1024;
    if (k == 1) { a = (const bf16*)(ws + WS_Q); b = (const bf16*)(ws + WS_P); }
    else if (k == 2) { a = (const bf16*)(ws + WS_YA); b = (const bf16*)(ws + WS_YC); }
#if defined(DIAG_SEL) && DIAG_SEL == 1
    else if (k == 3) { const bf16* w = (const bf16*)(ws + WS_WPCT); const bf16* s = (const bf16*)(ws + WS_SGC);
        for (int i = t0; i < 4 * 1024 * 1024; i += NT) out[i] = __uint_as_float((unsigned)w[i] << 16);
        for (int i = t0; i < 6000 * 2048; i += NT) out[4 * 1024 * 1024 + i] = __uint_as_float((unsigned)s[i] << 16);
        return; }
#elif defined(DIAG_SEL) && DIAG_SEL == 2
    else if (k == 3) { const bf16* w = (const bf16*)(ws + WS_WPCT);
        for (int i = t0; i < 16 * 1024 * 1024; i += NT) out[i] = __uint_as_float((unsigned)w[i] << 16);
        return; }
#else
    else if (k == 3) { x = (const float*)(ws + WS_T1); }
#endif
    else if (k == 4) { a = (const bf16*)(ws + WS_MG); lda = 2048; }
    else if (k == 5 || k == 8) { x = (const float*)(ws + WS_X); }
    else if (k == 6) { a = (const bf16*)(ws + WS_U); lda = 8192; }
    else if (k == 7) { a = (const bf16*)(ws + WS_G); lda = 4096; }
    if (x) { for (int i = t0; i < 8192 * 2048; i += NT) out[i] = x[i]; return; }
    if (b) { for (int i = t0; i < 8192 * 1024; i += NT) { out[i] = __uint_as_float((unsigned)a[i] << 16); out[8192 * 1024 + i] = __uint_as_float((unsigned)b[i] << 16); } return; }
    for (int i = t0; i < 8192 * 2048; i += NT) { const int r = i / 2048, c = i % 2048; out[i] = __uint_as_float((unsigned)a[(size_t)r * lda + c] << 16); }
}
#define STOP_AT(k) do { if (STOP_AFTER != 0 && STOP_AFTER == 10 * l + (k)) { diag_dump(k, F.bx * NWAVES * 64 + phase_tid(F), F.G * NWAVES * 64, KOUT(), KWS()); return; } } while (0)
#define KARG_U64(off) (*(const __attribute__((address_space(4))) unsigned long long*)(kargs() + (off)))
#define KIN(i)  ((const float*)(const GAS float*)KARG_U64(8 * (i)))
#define KOUT()  ((float*)(GAS float*)KARG_U64(168))
#define KWS()   ((unsigned char*)(GAS unsigned char*)KARG_U64(176))
#define WSP(T, off) ((T*)(KWS() + (off)))
__global__ void __launch_bounds__(NWAVES * 64, 2) fwd_kernel(Args args) {
    extern __shared__ __attribute__((aligned(16))) unsigned char lds[];
    Frame F;
    F.lds = (LAS unsigned char*)lds; F.MISC = (volatile LAS unsigned*)(F.lds + LDSCTL_OFF);
    F.wv = __builtin_amdgcn_readfirstlane((int)threadIdx.x >> 6); F.G = gridDim.x; F.bx = blockIdx.x;
    F.ctl = (gu32*)(KWS() + WS_CTL);
    for (int u = threadIdx.x; u < (LDS_BYTES - LDSCTL_OFF) / 4; u += NWAVES * 64) ((LAS unsigned*)(F.lds + LDSCTL_OFF))[u] = 0u;
    __syncthreads();
    XcdBarrier bar = xcd_barrier_post((unsigned*)(F.ctl + CW_BAR), F.MISC + 8);

#ifndef SKIP_P0
    for (int rep_ = 0; rep_ < REP_P0; ++rep_) {
    transpose_matrix(F, F.bx, F.G, KIN(9), 2048, 10248, 10496, KIN(8), WSP(bf16, WS_W1T), MapIn());
    { const int NT = F.G * NWAVES * 64; MapIn mp; const float* b_in = KIN(10); float* BIAS1 = WSP(float, WS_BIAS1);
      for (int i = F.bx * NWAVES * 64 + phase_tid(F); i < 2 * 10496; i += NT) { const int l = i / 10496, n = i % 10496, s = mp(n); BIAS1[i] = s >= 0 ? b_in[l * 10248 + s] : 0.f; } }
    {   const int NGW = F.G * NWAVES, gw = NGW - 1 - (F.bx * NWAVES + F.wv), lane = phase_tid(F) & 63;
        const float* xs = KIN(1); const float* xm = KIN(7); const float* xp = KIN(0); bf16* XB = WSP(bf16, WS_XB); float* SSQ = WSP(float, SSQ_OFF);
        for (int m0 = gw; m0 < MP; m0 += 2 * NGW) {
            f32x4 v[2][8];
#pragma unroll
            for (int r = 0; r < 2; ++r) { const int m = m0 + r * NGW; const float* src = nullptr;
                if (m < 16) src = xm + (size_t)m * 2048; else if (m < LPR) src = xp + (size_t)(m - 16) * 2048; else if (m < MREAL) src = xs + (size_t)(m - SROW0) * 2048;
#pragma unroll
                for (int j = 0; j < 8; ++j) v[r][j] = src ? *(const GAS f32x4*)(src + 256 * j + 4 * lane) : (f32x4){0.f, 0.f, 0.f, 0.f}; }
#pragma unroll
            for (int r = 0; r < 2; ++r) { const int m = m0 + r * NGW; if (m >= MP) break; float s = 0.f;
#pragma unroll
                for (int j = 0; j < 8; ++j) { const f32x4 w = v[r][j];
                    *(GAS unsigned long long*)(XB + (size_t)m * 2048 + 256 * j + 4 * lane) = (unsigned long long)pk2(w[0], w[1]) | ((unsigned long long)pk2(w[2], w[3]) << 32);
                    s += (w[0] * w[0] + w[1] * w[1]) + (w[2] * w[2] + w[3] * w[3]); }
                s = xl::wave_sum(s); if (lane < 32) SSQ[(size_t)m * 32 + lane] = lane == 0 ? s : 0.f; }
        }
    }
    }
#endif
    GRID_BAR();

#pragma unroll 1
    for (int l = 0; l < 2; ++l) {
#ifndef SKIP_G1
        for (int rep_ = 0; rep_ < REP_G1; ++rep_) {
        {   pg8::Gemm g{WSP(bf16, WS_XB), WSP(bf16, WS_W1T) + (size_t)l * 10496 * 2048, MP, 10496, 2048}; pg8::StaticOrder S; S.init(MP, 10496, opaque_s(F.G), opaque_s(F.bx));
            pg8::EpiIn E{WSP(float, SSQ_OFF) + (size_t)(2 * l) * MP * 32, WSP(float, WS_BIAS1) + l * 10496, WSP(bf16, WS_YC), WSP(float, WS_PH), KIN(11) + l * 3072, WSP(bf16, WS_Q), WSP(bf16, WS_K), WSP(bf16, WS_V), WSP(bf16, WS_SGC), WSP(unsigned char, WS_SGA), WSP(float, WS_LOGF), KOUT(), l, (LAS float*)(F.lds + RST_OFF)};
            pg8::gemm_phase<pg8::EpiIn, pg8::StaticOrder, true, true>(F.lds + RING_OFF, g, S, E, F.wv); }
        if (F.bx >= IDLE1) {
            const int vb = F.bx - IDLE1, vg = F.G - IDLE1;
            if (l == 0) {
                transpose_matrix(F, vb, vg, KIN(12), 1024, 2048, 2048, nullptr, WSP(bf16, WS_WPCT), MapIdent(), 2048);
                transpose_matrix(F, vb, vg, KIN(13), 1024, 2048, 2048, nullptr, WSP(bf16, WS_WPCT) + 1024, MapIdent(), 2048);
                transpose_matrix(F, vb, vg, KIN(14), 2048, 2048, 2048, nullptr, WSP(bf16, WS_WOT), MapIdent()); }
            transpose_matrix(F, vb, vg, KIN(16) + (size_t)l * 2048 * 8192, 2048, 8192, 8192, KIN(15) + l * 2048, WSP(bf16, WS_WUPT) + (size_t)l * 8192 * 2048, MapUp());
            if (l == 1) transpose_matrix(F, vb, vg, KIN(19) + (size_t)4096 * 2048, 4096, 2048, 2048, nullptr, WSP(bf16, WS_WDNT) + (size_t)2048 * 4096, MapIdent()); }
        if (rep_ + 1 < REP_G1) GRID_BAR();
        }
#endif
        GRID_BAR();
        STOP_AT(1);
        for (int rep_ = 0; rep_ < REP_ATT; ++rep_) {
#ifndef SKIP_CONV
        phase_yc_fixup(F, WSP(float, WS_PH), WSP(bf16, WS_YC), KIN(11) + l * 3072, KIN(5) + (size_t)l * 16 * 2048);
#endif
        {
            const int c_ = F.bx & 255;
#pragma unroll 1
            for (int step = 0; step < 2; ++step) {
                const bool do_chunk = (((c_ >> 3) & 1) != 0) == (step == 0);
                if (!do_chunk) {
#ifndef SKIP_PA
        for (int rpr_ = 0; rpr_ < REP_PR; ++rpr_)
        {
            float* bias = (float*)(lds + ATT_BIAS_OFF); float* wtot = (float*)(lds + SCAN_SCR_OFF);
            const bf16* Qb = WSP(bf16, WS_Q); bf16* YA = WSP(bf16, WS_YC) + 1024; const float* LOGF = WSP(float, WS_LOGF);
            const int c = F.bx & 255, h = c & 7, j = (c >> 3) >> 1, s = (c >> 3) & 1, cj = 62 - 4 * j, qbB = 31 - j;
            const bf16* Kp = WSP(bf16, WS_K) + h * 128; const bf16* Vp = WSP(bf16, WS_V) + h * 128;
            float* part = WSP(float, WS_PART) + (size_t)(h * 16 + j) * pa::PART_FLOATS; unsigned* flag = (unsigned*)(F.ctl + CW_FLAG) + (l * 128 + h * 16 + j) * 64;
            if (F.bx < 256) {
                const int nmax = 64 * (s ? (128 - 4 * j) : (4 * j + 4 > cj ? 4 * j + 4 : cj));
                block_cumsum<16>(LOGF + (size_t)h * MP, 1, nmax, bias, wtot, -1.0f / pa::SCALE, false, phase_tid(F));
                const pa::BlockRef bA{Qb + (size_t)(256 * j) * 1024 + h * 128, Kp, Vp, YA + (size_t)(256 * j) * 2048 + h * 128, 256 * j, 0, 4 * j + 4, 0, nullptr, nullptr};
                const pa::BlockRef bB{Qb + (size_t)(256 * qbB) * 1024 + h * 128, Kp, Vp, YA + (size_t)(256 * qbB) * 2048 + h * 128, 256 * qbB, s ? cj : 0, s ? 128 - 4 * j : cj, s ? 2 : 1, part, flag};
                pa::Seam S;
                if (s == 0) { pa::prime(bA, (char*)lds, S, F.wv); pa::block(bA, bB, (char*)lds, bias, S, F.wv); pa::block(bB, bB, (char*)lds, bias, S, F.wv); }
                else { pa::prime(bB, (char*)lds, S, F.wv); pa::block(bB, bB, (char*)lds, bias, S, F.wv); }
            }
            asm volatile("s_waitcnt vmcnt(0)" ::: "memory"); __syncthreads();
        }
#endif
                } else {
#ifndef SKIP_SA
        for (int rch_ = 0; rch_ < REP_CH; ++rch_)
        {
            float* bias = (float*)lds; float* wtot = (float*)(lds + SCAN_SCR_OFF);
            const float* LOGF = WSP(float, WS_LOGF); float* out = KOUT(); float* slots = WSP(float, WS_CPART);
            if (F.bx < 256) {
                for (int rs_ = 0; rs_ < REP_CHS; ++rs_)
                {   const int item = c_ >> 1, part = c_ & 1, b = item >> 3, h = item & 7; sa::Item it;
                    block_cumsum<8>(KIN(4) + ((size_t)(l * 16 + b) * 4096) * 8 + h, 8, 4096, bias, wtot, -LOG2E, true, phase_tid(F));
                    { const int t_ = phase_tid(F); if (t_ < 64) { const float x = t_ < 16 ? LOGF[(size_t)h * MP + SROW0 + b * 16 + t_] : 0.f; const float inc = xl::wave_incl_scan(x, t_); if (t_ < 16) bias[4096 + t_] = -LOG2E * inc; } }
                    __syncthreads();
                    const size_t cb = ((size_t)(l * 16 + b) * 4096) * 1024 + h * 128;
                    it.Kc = KIN(2) + cb; it.Vc = KIN(3) + cb; it.nk = 4096;
                    it.Kn = out + pg8::OFF_KS + ((size_t)l * 256 + b * 16) * 1024 + h * 128; it.Vn = out + pg8::OFF_VS + ((size_t)l * 256 + b * 16) * 1024 + h * 128;
                    it.Q = WSP(bf16, WS_Q) + (size_t)(SROW0 + b * 16) * 1024 + h * 128; it.O = nullptr;
                    sa::run_part(it, part * 128, part * 128 + 128, part == 1, slots + (size_t)(256 + 2 * item + part) * sa::PART_SLOT, (char*)lds, F.wv); }
                for (int rt_ = 0; rt_ < REP_CHT; ++rt_)
                {   const int h = c_ >> 5, part = c_ & 31; sa::Item it;
                    block_cumsum<17>(LOGF + (size_t)h * MP, 1, LPR, bias, wtot, -LOG2E, false, phase_tid(F));
                    const size_t kb = ((size_t)l * LPR) * 1024 + h * 128;
                    it.Kc = out + pg8::OFF_KP + kb; it.Vc = out + pg8::OFF_VP + kb; it.nk = 8192; it.Kn = it.Kc + (size_t)8192 * 1024; it.Vn = it.Vc + (size_t)8192 * 1024;
                    it.Q = WSP(bf16, WS_Q) + (size_t)8192 * 1024 + h * 128; it.O = nullptr;
                    sa::run_part(it, part * 16, part * 16 + 16, part == 31, slots + (size_t)(h * 32 + part) * sa::PART_SLOT, (char*)lds, F.wv); }
                {   const int item = c_ >> 1, b = item >> 3, hs = item & 7, ht = c_ >> 5, lane = phase_tid(F) & 63; bool last_s, last_t;
                    part_arrive2(F, F.ctl + CW_CNT + l * 136 + item, 2u, F.ctl + CW_CNT + l * 136 + 128 + ht, 32u, last_s, last_t);
                    if (last_s)
                        for (int q = 2 * F.wv; q < 2 * F.wv + 2; ++q) sa::combine_row<2>(slots + (size_t)(256 + 2 * item) * sa::PART_SLOT, q, WSP(bf16, WS_YC) + (size_t)(SROW0 + b * 16 + q) * 2048 + 1024 + hs * 128, lane);
                    if (last_t)
                        for (int q = 2 * F.wv; q < 2 * F.wv + 2; ++q) sa::combine_row<32>(slots + (size_t)(ht * 32) * sa::PART_SLOT, q, WSP(bf16, WS_YC) + (size_t)(8192 + q) * 2048 + 1024 + ht * 128, lane); }
            }
        }
#endif
                }
            }
        }
        if (rep_ + 1 < REP_ATT) GRID_BAR();
        }
        GRID_BAR();
        STOP_AT(2);
#ifndef SKIP_G2
        {   pg8::Gemm g{WSP(bf16, WS_YC), WSP(bf16, WS_WPCT) + (size_t)l * 2048 * 2048, 8192, 2048, 2048}; pg8::StaticOrder S; S.init(8192, 2048, opaque_s(F.G), opaque_s(F.bx));
            pg8::EpiGateK E{WSP(bf16, WS_SGC), WSP(unsigned char, WS_SGA), WSP(bf16, WS_MG)}; pg8::gemm_phase<pg8::EpiGateK, pg8::StaticOrder, true, true, true>(F.lds + RING_OFF, g, S, E, F.wv); }
        skinny_merged(F, WSP(bf16, WS_YC), WSP(bf16, WS_WPCT) + (size_t)l * 2048 * 2048, WSP(bf16, WS_SGC), WSP(unsigned char, WS_SGA), WSP(bf16, WS_MG), lds);
        GRID_BAR();
        STOP_AT(4);
#endif
#ifndef SKIP_G3
        {   pg8::Gemm g{WSP(bf16, WS_MG), WSP(bf16, WS_WOT) + (size_t)l * 2048 * 2048, 8192, 2048, 2048}; pg8::StaticOrder S; S.init(8192, 2048, opaque_s(F.G), opaque_s(F.bx));
            pg8::EpiRes E{WSP(bf16, WS_XB), WSP(float, SSQ_OFF) + (size_t)(2 * l + 1) * MP * 32}; pg8::gemm_phase<pg8::EpiRes, pg8::StaticOrder, true, true>(F.lds + RING_OFF, g, S, E, F.wv); }
        skinny_res(F, WSP(bf16, WS_MG), WSP(bf16, WS_WOT) + (size_t)l * 2048 * 2048, 2048, WSP(bf16, WS_XB), WSP(float, SSQ_OFF) + (size_t)(2 * l + 1) * MP * 32, lds);
        GRID_BAR();
        STOP_AT(5);
#endif
#ifndef SKIP_G4
        for (int rep_ = 0; rep_ < REP_G4; ++rep_) {
        {   pg8::Gemm g{WSP(bf16, WS_XB), WSP(bf16, WS_WUPT) + (size_t)l * 8192 * 2048, MP, 8192, 2048}; pg8::StaticOrder S; S.init(MP, 8192, opaque_s(F.G), opaque_s(F.bx));
            pg8::EpiUpConv E{WSP(float, SSQ_OFF) + (size_t)(2 * l + 1) * MP * 32, WSP(bf16, WS_G), WSP(float, WS_HALO), KIN(17) + (size_t)l * 3 * 8192, KIN(18) + l * 8192, KOUT(), l, (LAS float*)(F.lds + RST_OFF)}; pg8::gemm_phase<pg8::EpiUpConv, pg8::StaticOrder, true, true>(F.lds + RING_OFF, g, S, E, F.wv); }
        if (l == 0 && F.bx >= IDLE5) {
            const int vb = F.bx - IDLE5, vg = F.G - IDLE5;
            transpose_matrix(F, vb, vg, KIN(19), 4096, 2048, 2048, nullptr, WSP(bf16, WS_WDNT), MapIdent());
            transpose_matrix(F, vb, vg, KIN(9) + (size_t)2048 * 10248, 2048, 10248, 10496, KIN(8) + 2048, WSP(bf16, WS_W1T) + (size_t)10496 * 2048, MapIn());
            transpose_matrix(F, vb, vg, KIN(12) + (size_t)1024 * 2048, 1024, 2048, 2048, nullptr, WSP(bf16, WS_WPCT) + (size_t)2048 * 2048, MapIdent(), 2048);
            transpose_matrix(F, vb, vg, KIN(13) + (size_t)1024 * 2048, 1024, 2048, 2048, nullptr, WSP(bf16, WS_WPCT) + (size_t)2048 * 2048 + 1024, MapIdent(), 2048);
            transpose_matrix(F, vb, vg, KIN(14) + (size_t)2048 * 2048, 2048, 2048, 2048, nullptr, WSP(bf16, WS_WOT) + (size_t)2048 * 2048, MapIdent()); }
        GRID_BAR();
        STOP_AT(6);
        if (rep_ + 1 < REP_G4) GRID_BAR();
        }
#endif
#ifndef SKIP_E4
        for (int rep_ = 0; rep_ < REP_E4; ++rep_) {
        phase_ffn_fixup(F, WSP(float, WS_HALO), WSP(bf16, WS_G), KIN(17) + (size_t)l * 3 * 8192, KIN(18) + l * 8192, KIN(6) + (size_t)l * 16 * 2 * 8192);
        GRID_BAR();
        STOP_AT(7);
        if (rep_ + 1 < REP_E4) GRID_BAR();
        }
#endif
#ifndef SKIP_G5
        {   pg8::Gemm g{WSP(bf16, WS_G), WSP(bf16, WS_WDNT) + (size_t)l * 2048 * 4096, 8192, 2048, 4096}; pg8::StaticOrder S; S.init(8192, 2048, opaque_s(F.G), opaque_s(F.bx));
            pg8::EpiRes E{WSP(bf16, WS_XB), WSP(float, SSQ_OFF) + (size_t)(2 * l + 2) * MP * 32}; pg8::gemm_phase<pg8::EpiRes, pg8::StaticOrder, true, true>(F.lds + RING_OFF, g, S, E, F.wv); }
        skinny_res(F, WSP(bf16, WS_G), WSP(bf16, WS_WDNT) + (size_t)l * 2048 * 4096, 4096, WSP(bf16, WS_XB), WSP(float, SSQ_OFF) + (size_t)(2 * l + 2) * MP * 32, lds);
        GRID_BAR();
        STOP_AT(8);
#endif
    }
    {   const int gw = F.bx * NWAVES + F.wv, NGW = F.G * NWAVES, lane = phase_tid(F) & 63; float* out = KOUT(); const bf16* XB = WSP(bf16, WS_XB); const float* SSQ = WSP(float, SSQ_OFF); const float* gf = KIN(20);
        for (int m0 = gw; m0 < MREAL; m0 += 2 * NGW) {
            pg8::u32x2 xv[2][8]; float part[2];
#pragma unroll
            for (int r = 0; r < 2; ++r) { const int m = (m0 + r * NGW < MREAL) ? m0 + r * NGW : m0;
                part[r] = lane < 32 ? SSQ[(size_t)4 * MP * 32 + (size_t)m * 32 + lane] : 0.f;
#pragma unroll
                for (int j = 0; j < 8; ++j) xv[r][j] = *(const GAS pg8::u32x2*)(XB + (size_t)m * 2048 + 256 * j + 4 * lane); }
#pragma unroll
            for (int r = 0; r < 2; ++r) { const int m = m0 + r * NGW; if (m >= MREAL) break;
                float* o; if (m >= SROW0) o = out + pg8::OFF_YS + (size_t)(m - SROW0) * 2048; else if (m >= 16) o = out + pg8::OFF_YP + (size_t)(m - 16) * 2048; else continue;
                const float rs = 1.0f / sqrtf(xl::wave_sum(part[r]) * (1.0f / 2048.0f) + pg8::RMS_EPS);
#pragma unroll
                for (int j = 0; j < 8; ++j) { const f32x4 v = pg8::unpk4(xv[r][j]), gg = *(const GAS f32x4*)(gf + 256 * j + 4 * lane);
                    *(GAS f32x4*)(o + 256 * j + 4 * lane) = v * rs * gg; } }
        }
    }
}

extern "C" void kernel_launch(void* const* d_in, const int* in_sizes, int n_in, void* d_out, int out_size, void* d_ws, size_t ws_size, hipStream_t stream) {
    static int grid = 0;
    if (grid == 0) {
        if (n_in != 21 || out_size != (int)pg8::OUT_TOTAL || ws_size < WS_END) { fprintf(stderr, "kernel_launch: unexpected shapes: n_in %d out %d ws %zu\n", n_in, out_size, ws_size); grid = -1; return; }
        int dev = 0, cus = 0, per_cu = 0;
        if (hipGetDevice(&dev) != hipSuccess || hipDeviceGetAttribute(&cus, hipDeviceAttributeMultiprocessorCount, dev) != hipSuccess) { grid = -1; return; }
        if (hipFuncSetAttribute((const void*)fwd_kernel, hipFuncAttributeMaxDynamicSharedMemorySize, LDS_BYTES) != hipSuccess) { fprintf(stderr, "kernel_launch: hipFuncSetAttribute failed\n"); grid = -1; return; }
        if (hipOccupancyMaxActiveBlocksPerMultiprocessor(&per_cu, (const void*)fwd_kernel, NWAVES * 64, LDS_BYTES) != hipSuccess || per_cu < 1) fprintf(stderr, "kernel_launch: occupancy query reports %d\n", per_cu);
        (void)hipGetLastError();
        grid = cus;
    }
    if (grid < 0) return;
    (void)hipMemsetAsync((char*)d_ws + WS_CTL, 0, CTL_ZERO_BYTES, stream);
    Args a{};
    for (int i = 0; i < 21; ++i) a.in[i] = (const float*)d_in[i];
    a.out = (float*)d_out; a.ws = (unsigned char*)d_ws;
    hipLaunchKernelGGL(fwd_kernel, dim3(grid), dim3(NWAVES * 64), LDS_BYTES, stream, a);
    const hipError_t le = hipPeekAtLastError();
    if (le != hipSuccess) fprintf(stderr, "kernel_launch: launch failed: %s\n", hipGetErrorName(le));
}
```

```cpp
#include <hip/hip_runtime.h>
#include <cstdio>
#include <cstdint>
typedef float f32x2_cv __attribute__((ext_vector_type(2))); typedef __bf16 bf16x2_cv __attribute__((ext_vector_type(2)));
__device__ __forceinline__ unsigned cvt_pk_bf16_rne(float lo, float hi) { const f32x2_cv v = {lo, hi}; const bf16x2_cv b = __builtin_convertvector(v, bf16x2_cv); return __builtin_bit_cast(unsigned, b); }
namespace xl {
typedef unsigned u32x2_t __attribute__((ext_vector_type(2)));
__device__ __forceinline__ float sum_xor32(float v) { const auto r = __builtin_amdgcn_permlane32_swap(__float_as_uint(v), __float_as_uint(v), false, false); return __uint_as_float(r[0]) + __uint_as_float(r[1]); }
__device__ __forceinline__ float sum_xor16(float v) { const auto r = __builtin_amdgcn_permlane16_swap(__float_as_uint(v), __float_as_uint(v), false, false); return __uint_as_float(r[0]) + __uint_as_float(r[1]); }
__device__ __forceinline__ float max_xor32(float v) { const auto r = __builtin_amdgcn_permlane32_swap(__float_as_uint(v), __float_as_uint(v), false, false); return fmaxf(__uint_as_float(r[0]), __uint_as_float(r[1])); }
__device__ __forceinline__ float max_xor16(float v) { const auto r = __builtin_amdgcn_permlane16_swap(__float_as_uint(v), __float_as_uint(v), false, false); return fmaxf(__uint_as_float(r[0]), __uint_as_float(r[1])); }
__device__ __forceinline__ float xor1(float v) { return __int_as_float(__builtin_amdgcn_update_dpp(0, __float_as_int(v), 0xB1, 0xf, 0xf, true)); }
template <int N> __device__ __forceinline__ float row_shr(float v) { return __int_as_float(__builtin_amdgcn_update_dpp(0, __float_as_int(v), 0x110 + N, 0xf, 0xf, true)); }
template <int N> __device__ __forceinline__ float row_ror(float v) { return __int_as_float(__builtin_amdgcn_update_dpp(0, __float_as_int(v), 0x120 + N, 0xf, 0xf, true)); }
__device__ __forceinline__ float wave_incl_scan(float x, int lane) {
    x += row_shr<1>(x); x += row_shr<2>(x); x += row_shr<4>(x); x += row_shr<8>(x);
    const float t0 = __int_as_float(__builtin_amdgcn_readlane(__float_as_int(x), 15)), t1 = __int_as_float(__builtin_amdgcn_readlane(__float_as_int(x), 31)), t2 = __int_as_float(__builtin_amdgcn_readlane(__float_as_int(x), 47));
    const int row = lane >> 4; return x + (row >= 1 ? t0 : 0.f) + (row >= 2 ? t1 : 0.f) + (row >= 3 ? t2 : 0.f);
}
__device__ __forceinline__ float wave_max(float v) { v = fmaxf(v, xor1(v)); v = fmaxf(v, __int_as_float(__builtin_amdgcn_update_dpp(0, __float_as_int(v), 0x4E, 0xf, 0xf, true)));
    v = fmaxf(v, row_ror<4>(v)); v = fmaxf(v, row_ror<8>(v)); v = max_xor16(v); return max_xor32(v); }
__device__ __forceinline__ float wave_sum(float v) { v += xor1(v); v += __int_as_float(__builtin_amdgcn_update_dpp(0, __float_as_int(v), 0x4E, 0xf, 0xf, true));
    v += row_shr<4>(v); v += row_shr<8>(v);
    return __int_as_float(__builtin_amdgcn_readlane(__float_as_int(v), 15)) + __int_as_float(__builtin_amdgcn_readlane(__float_as_int(v), 31)) + __int_as_float(__builtin_amdgcn_readlane(__float_as_int(v), 47)) + __int_as_float(__builtin_amdgcn_readlane(__float_as_int(v), 63)); }
}
namespace pg8 {
#define PG8_LAS __attribute__((address_space(3)))
typedef unsigned short bf16_t;
typedef short bf16x8 __attribute__((ext_vector_type(8)));
typedef float f32x4 __attribute__((ext_vector_type(4)));
typedef unsigned u32x4 __attribute__((ext_vector_type(4)));
constexpr int BM = 256, BK = 64, HALF = 128, HTB = HALF * BK * 2  , STAGE_BYTES = 8 * HTB, NXCD = 8, WGM = 8;

__host__ __device__ __forceinline__ int lds_byte(int r, int c) { const int st = (r >> 4) * 2 + (c >> 5), rr = r & 15, cc = c & 31, ob = rr * 64 + cc * 2; return st * 1024 + (ob ^ (((ob >> 9) & 1) << 5)); }
__host__ __device__ __forceinline__ void stage_rc(int b, int& R, int& C) { const int st = b / 1024, sb = b % 1024, swz = sb ^ (((sb >> 9) & 1) << 5); R = (st >> 1) * 16 + swz / 64; C = (st & 1) * 32 + (swz % 64) / 2; }
__host__ __device__ __forceinline__ int perm32(int rho) { const int n = rho >> 4, i = rho & 15; return 8 * (i >> 2) + 4 * n + (i & 3); }

struct Unit { int pm, pn; };
struct Gemm { const bf16_t* A; const bf16_t* Bt; int M, N, K; };

struct StaticOrder {
    int nM, nN, nwg, G, c;
    __host__ __device__ void init(int M, int N, int G_, int c_) { nM = M / BM; nN = N / BM; nwg = nM * nN; G = G_; c = c_; }
    __host__ __device__ bool next(int i, Unit& u) const {
        const long L = (long)i * G + c; if (L >= nwg) return false;
        int wgid = (int)L; { const int q = nwg / NXCD, r = nwg % NXCD, xcd = wgid % NXCD, off = wgid / NXCD; wgid = (xcd < r ? xcd * (q + 1) : r * (q + 1) + (xcd - r) * q) + off; }
        const int nig = WGM * nN, gid = wgid / nig, fm = gid * WGM, gsz = (nM - fm) < WGM ? (nM - fm) : WGM;
        u.pm = fm + ((wgid % nig) % gsz); u.pn = (wgid % nig) / gsz; return true;
    }
    __device__ __forceinline__ void a_ready(const Unit&) const {}
    __device__ __forceinline__ void done(const Unit&) const {}
};

__device__ __forceinline__ unsigned cvt_pk_bf16(float lo, float hi) { return cvt_pk_bf16_rne(lo, hi); }
typedef float f32x2 __attribute__((ext_vector_type(2)));
constexpr int MP = 8704, MREAL = 8464, NSAMP = 256, LPR = 8208, SROW0 = 8208;
constexpr int DM = 2048, CONVD = 1024, ATTD = 1024, NH = 8, HDIM = 128, DFF = 4096, DFF2 = 8192, NPROJ = 10496, PROJ = 10248;
constexpr float RMS_EPS = 1e-6f;
constexpr long OFF_YP = 0, OFF_YS = 16777216, OFF_KP = 17301504, OFF_VP = 34111488, OFF_LFP = 50921472, OFF_CP = 51052800, OFF_FP = 51056896,
               OFF_KS = 51089664, OFF_VS = 51613952, OFF_LFS = 52138240, OFF_CS = 52142336, OFF_FS = 52207872, OUT_TOTAL = 52732160;
typedef unsigned u32x2 __attribute__((ext_vector_type(2)));
__device__ __forceinline__ u32x2 pk4(const f32x4 v) { u32x2 w; w.x = cvt_pk_bf16(v[0], v[1]); w.y = cvt_pk_bf16(v[2], v[3]); return w; }
__device__ __forceinline__ f32x4 unpk4(const u32x2 w) { f32x4 v; v[0] = __uint_as_float(w.x << 16); v[1] = __uint_as_float(w.x & 0xffff0000u); v[2] = __uint_as_float(w.y << 16); v[3] = __uint_as_float(w.y & 0xffff0000u); return v; }
__device__ __forceinline__ float sigmoidf_(float v) { return __builtin_amdgcn_rcpf(1.0f + __builtin_amdgcn_exp2f(-1.4426950408889634f * v)); }
__device__ __forceinline__ float rowscale(const float* ssq, int row) { const f32x4* p = (const f32x4*)(ssq + (size_t)row * 32); f32x4 a = p[0];
#pragma unroll
    for (int i = 1; i < 8; ++i) a += p[i];
    return 1.0f / sqrtf(((a[0] + a[1]) + (a[2] + a[3])) * (1.0f / 2048.0f) + RMS_EPS); }

constexpr int HALO_SLOTS = 512 + 68;
__device__ __forceinline__ int halo_slot(int row) { return row < 8192 ? (row >> 6) * 4 + ((row + 2) & 3) : 512 + ((row - 8192) >> 4) * 4 + ((row + 2) & 3); }
typedef __attribute__((address_space(1))) f32x4 GAS_F4;
__device__ __forceinline__ float rowscale_asm(const float* ssq_row, const float* extra, f32x4& ex) {
    f32x4 p0, p1, p2, p3, p4, p5, p6, p7; const GAS_F4* q = (const GAS_F4*)ssq_row;
    asm volatile("global_load_dwordx4 %0, %1, off" : "=v"(ex) : "v"((const GAS_F4*)extra));
    asm volatile("global_load_dwordx4 %0, %1, off" : "=v"(p0) : "v"(q + 0)); asm volatile("global_load_dwordx4 %0, %1, off" : "=v"(p1) : "v"(q + 1));
    asm volatile("global_load_dwordx4 %0, %1, off" : "=v"(p2) : "v"(q + 2)); asm volatile("global_load_dwordx4 %0, %1, off" : "=v"(p3) : "v"(q + 3));
    asm volatile("global_load_dwordx4 %0, %1, off" : "=v"(p4) : "v"(q + 4)); asm volatile("global_load_dwordx4 %0, %1, off" : "=v"(p5) : "v"(q + 5));
    asm volatile("global_load_dwordx4 %0, %1, off" : "=v"(p6) : "v"(q + 6)); asm volatile("global_load_dwordx4 %0, %1, off" : "=v"(p7) : "v"(q + 7));
    asm volatile("s_waitcnt vmcnt(0)" : "+v"(p0), "+v"(p1), "+v"(p2), "+v"(p3), "+v"(p4), "+v"(p5), "+v"(p6), "+v"(p7), "+v"(ex));
    const f32x4 a = ((p0 + p1) + (p2 + p3)) + ((p4 + p5) + (p6 + p7));
    return 1.0f / sqrtf(((a[0] + a[1]) + (a[2] + a[3])) * (1.0f / 2048.0f) + RMS_EPS);
}
struct EpiIn {
    static constexpr bool PERM = false, AFTER_DRAIN = false;
    const float* ssq; const float* bias; bf16_t *YC; float* PH; const float* wconv; bf16_t *Q, *Kb, *Vb, *RG; unsigned char* SGA; float* LOGF; float* out; int layer; PG8_LAS float* rst;
    __device__ __forceinline__ void pre_epi(const Unit& u, int wc, int lane) const { const int trow = wc * 64 + lane, pn = u.pn, j = trow - 64;
        const float* ex = bias + pn * 256 + 4 * (trow & 63);
        if (trow >= 64 && trow < 112 && pn < 16) ex = wconv + (j >> 4) * 1024 + 64 * pn + (j & 15) * 4;
        f32x4 e; rst[trow] = rowscale_asm(ssq + (size_t)(u.pm * BM + trow) * 32, ex, e);
        if (trow < 64) *(PG8_LAS f32x4*)(rst + 256 + 4 * trow) = e; else if (trow < 112) *(PG8_LAS f32x4*)(rst + 512 + 4 * j) = e; }
    __device__ __forceinline__ void operator()(const f32x4 (&acc)[2][2][4][2], const Unit& u, int wr, int wc, int fr, int fq) const {
        const int rowb = u.pm * BM + wr * 64 + fr, pn = u.pn;
        const PG8_LAS float* rsl = rst + wr * 64 + fr;
#define EPI_IN_BIAS() f32x4 bv[2][2]; _Pragma("unroll") for (int bj = 0; bj < 2; ++bj) _Pragma("unroll") for (int n = 0; n < 2; ++n) bv[bj][n] = *(const PG8_LAS f32x4*)(rst + 256 + wc * 32 + 4 * fq + bj * HALF + n * 16)
        if (pn < 16) { EPI_IN_BIAS();
            const int ch = 64 * pn + 16 * wc + 4 * fq; const bool samp = u.pm >= 32;
            const f32x4 w0 = *(const PG8_LAS f32x4*)(rst + 512 + 16 * wc + 4 * fq), w1 = *(const PG8_LAS f32x4*)(rst + 576 + 16 * wc + 4 * fq), w2 = *(const PG8_LAS f32x4*)(rst + 640 + 16 * wc + 4 * fq);
#pragma unroll
            for (int ai = 0; ai < 2; ++ai) { f32x4 plast = {0.f, 0.f, 0.f, 0.f};
#pragma unroll
                for (int m = 0; m < 4; ++m) { const int row = rowb + ai * HALF + m * 16; const float rs = rsl[ai * HALF + m * 16];
                    const f32x4 xc = acc[ai][0][m][0] * rs + bv[0][0], bc = acc[ai][0][m][1] * rs + bv[0][1], cc = acc[ai][1][m][0] * rs + bv[1][0], q = acc[ai][1][m][1] * rs + bv[1][1];
                    const f32x4 p = cc * xc; const size_t o = (size_t)row * 1024 + ch;
                    f32x4 y;
#pragma unroll
                    for (int e = 0; e < 4; ++e) { const float s1 = xl::row_ror<1>(fr == 15 ? plast[e] : p[e]), s2 = xl::row_ror<2>(fr >= 14 ? plast[e] : p[e]);
                        y[e] = bc[e] * (w0[e] * s2 + w1[e] * s1 + w2[e] * p[e]); }
                    plast = p;
                    if (!(fr < 2 && (m == 0 || samp))) *(u32x2*)(YC + (size_t)row * 2048 + ch) = pk4(y);
                    *(u32x2*)(Q + o) = pk4(q);
                    const bool halo = samp ? (fr < 2 || fr >= 14) : ((m == 0 && fr < 2) || (m == 3 && fr >= 14));
                    if (halo && row < MREAL) { float* hp = PH + (size_t)halo_slot(row) * 2048 + ch; *(f32x4*)hp = p; *(f32x4*)(hp + 1024) = bc; }
                    if (samp) {
                        if (row >= SROW0) { const int sr = row - SROW0; if (row < MREAL && (sr & 15) >= 14) *(f32x4*)(out + OFF_CS + ((size_t)(layer * 16 + (sr >> 4)) * 2 + ((sr & 15) - 14)) * 1024 + ch) = p; }
                        else if (row >= LPR - 2) *(f32x4*)(out + OFF_CP + (size_t)(layer * 2 + (row - (LPR - 2))) * 1024 + ch) = p; } } }
        } else if (pn < 24) { EPI_IN_BIAS();
            const bool isv = pn >= 20; bf16_t* B = isv ? Vb : Kb; const int colb = 256 * (pn - (isv ? 20 : 16)) + wc * 32 + 4 * fq;
#pragma unroll
            for (int ai = 0; ai < 2; ++ai)
#pragma unroll
                for (int m = 0; m < 4; ++m) { const int row = rowb + ai * HALF + m * 16; const float rs = rsl[ai * HALF + m * 16];
                    long oo = -1; if (row < LPR) oo = (isv ? OFF_VP : OFF_KP) + ((long)layer * LPR + row) * 1024; else if (row < MREAL) oo = (isv ? OFF_VS : OFF_KS) + ((long)layer * 256 + (row - SROW0)) * 1024;
#pragma unroll
                    for (int bj = 0; bj < 2; ++bj)
#pragma unroll
                        for (int n = 0; n < 2; ++n) { const f32x4 v = acc[ai][bj][m][n] * rs + bv[bj][n]; const int col = colb + bj * HALF + n * 16;
                            *(u32x2*)(B + (size_t)row * 1024 + col) = pk4(v); if (oo >= 0) *(f32x4*)(out + oo + col) = v; } }
        } else if (pn < 40) { EPI_IN_BIAS();
            const int colb = 128 * (pn - 24) + wc * 32 + 4 * fq;
#pragma unroll
            for (int ai = 0; ai < 2; ++ai)
#pragma unroll
                for (int m = 0; m < 4; ++m) { const int row = rowb + ai * HALF + m * 16; const float rs = rsl[ai * HALF + m * 16];
#pragma unroll
                    for (int n = 0; n < 2; ++n) { const f32x4 zc = acc[ai][0][m][n] * rs + bv[0][n], za = acc[ai][1][m][n] * rs + bv[1][n]; f32x4 rg, ga;
#pragma unroll
                        for (int e = 0; e < 4; ++e) { const float ea = 1.0f + __builtin_amdgcn_exp2f(fminf(-1.4426950408889634f * za[e], 80.f));
                            ga[e] = fmaxf(__builtin_rintf(255.0f * __builtin_amdgcn_rcpf(ea)), 1.0f);
                            rg[e] = 255.0f * __builtin_amdgcn_rcpf((1.0f + __builtin_amdgcn_exp2f(-1.4426950408889634f * zc[e])) * ga[e]); }
                        const unsigned gq = (unsigned)ga[0] | ((unsigned)ga[1] << 8) | ((unsigned)ga[2] << 16) | ((unsigned)ga[3] << 24);
                        *(u32x2*)(RG + (size_t)row * 2048 + colb + n * 16) = pk4(rg); *(unsigned*)(SGA + (size_t)row * 2048 + colb + n * 16) = gq; } }
        } else {
            if (wc == 0 && fq < 2) { int fq_ = fq; asm volatile("" : "+v"(fq_)); const f32x4 bv00 = *(const PG8_LAS f32x4*)(rst + 256 + 4 * fq_);
#pragma unroll
                for (int ai = 0; ai < 2; ++ai)
#pragma unroll
                    for (int m = 0; m < 4; ++m) { const int row = rowb + ai * HALF + m * 16; const float rs = rsl[ai * HALF + m * 16];
                        f32x4 v = acc[ai][0][m][0] * rs + bv00;
#pragma unroll
                        for (int e = 0; e < 4; ++e) v[e] = fminf(v[e], 0.f) - log1pf(__expf(-fabsf(v[e])));
#pragma unroll
                        for (int e = 0; e < 4; ++e) LOGF[(size_t)(4 * fq + e) * MP + row] = v[e];
                        if (row < LPR) *(f32x4*)(out + OFF_LFP + ((size_t)layer * LPR + row) * 8 + 4 * fq) = v;
                        else if (row < MREAL) *(f32x4*)(out + OFF_LFS + ((size_t)layer * 256 + (row - SROW0)) * 8 + 4 * fq) = v; }
            }
        }
#undef EPI_IN_BIAS
    }
};
typedef unsigned u32x4e __attribute__((ext_vector_type(4)));
__device__ __forceinline__ void unpk8(const u32x4e w, f32x4& lo, f32x4& hi) { lo = unpk4((u32x2){w.x, w.y}); hi = unpk4((u32x2){w.z, w.w}); }
__device__ __forceinline__ u32x4e pk8(const f32x4 lo, const f32x4 hi) { const u32x2 a = pk4(lo), b = pk4(hi); return (u32x4e){a.x, a.y, b.x, b.y}; }
struct EpiGateK {
    static constexpr bool PERM = true, AFTER_DRAIN = false;
    const bf16_t* RG; const unsigned char* SGA; bf16_t* MG;
    __device__ __forceinline__ void pre_epi(const Unit&, int, int) const {}
    __device__ __forceinline__ void mid(f32x4 (&acc)[2][2][4][2], const Unit& u, int wr, int wc, int fr, int fq) const {
        asm volatile("" : "+v"(fr), "+v"(fq));
        const int rowb = u.pm * BM + wr * 64 + fr, colb = u.pn * BM + wc * 32 + 8 * fq;
#pragma unroll
        for (int ai = 0; ai < 2; ++ai)
#pragma unroll
            for (int m = 0; m < 4; ++m) { const size_t ro = (size_t)(rowb + ai * HALF + m * 16) * 2048 + colb;
#pragma unroll
                for (int bj = 0; bj < 2; ++bj) { f32x4 lo, hi; unpk8(*(const u32x4e*)(RG + ro + bj * HALF), lo, hi); acc[ai][bj][m][0] *= lo; acc[ai][bj][m][1] *= hi; } }
    }
    __device__ __forceinline__ void operator()(const f32x4 (&acc)[2][2][4][2], const Unit& u, int wr, int wc, int fr, int fq) const {
        const int rowb = u.pm * BM + wr * 64 + fr, colb = u.pn * BM + wc * 32 + 8 * fq;
#pragma unroll
        for (int ai = 0; ai < 2; ++ai)
#pragma unroll
            for (int m = 0; m < 4; ++m) { const size_t ro = (size_t)(rowb + ai * HALF + m * 16) * 2048 + colb;
#pragma unroll
                for (int bj = 0; bj < 2; ++bj) { const size_t o = ro + bj * HALF; const u32x2 gq = *(const u32x2*)(SGA + o);
                    const f32x4 g0 = {(float)(gq.x & 255u), (float)((gq.x >> 8) & 255u), (float)((gq.x >> 16) & 255u), (float)(gq.x >> 24)};
                    const f32x4 g1 = {(float)(gq.y & 255u), (float)((gq.y >> 8) & 255u), (float)((gq.y >> 16) & 255u), (float)(gq.y >> 24)};
                    *(u32x4e*)(MG + o) = pk8(g0 * (1.0f / 255.0f) * acc[ai][bj][m][0], g1 * (1.0f / 255.0f) * acc[ai][bj][m][1]); } }
    }
};
struct EpiRes {
    static constexpr bool PERM = true, AFTER_DRAIN = false;
    bf16_t* XB; float* ssq_next;
    __device__ __forceinline__ void pre_epi(const Unit&, int, int) const {}
    __device__ __forceinline__ void operator()(const f32x4 (&acc)[2][2][4][2], const Unit& u, int wr, int wc, int fr, int fq) const {
        const int rowb = u.pm * BM + wr * 64 + fr, colb = u.pn * BM + wc * 32 + 8 * fq;
#pragma unroll
        for (int ai = 0; ai < 2; ++ai)
#pragma unroll
            for (int m = 0; m < 4; ++m) { const int row = rowb + ai * HALF + m * 16; const size_t ro = (size_t)row * 2048 + colb; float s = 0.f;
#pragma unroll
                for (int bj = 0; bj < 2; ++bj) { const size_t o = ro + bj * HALF; f32x4 lo, hi; unpk8(*(const u32x4e*)(XB + o), lo, hi);
                    const f32x4 x0 = lo + acc[ai][bj][m][0], x1 = hi + acc[ai][bj][m][1];
                    *(u32x4e*)(XB + o) = pk8(x0, x1);
                    s += ((x0[0] * x0[0] + x0[1] * x0[1]) + (x0[2] * x0[2] + x0[3] * x0[3])) + ((x1[0] * x1[0] + x1[1] * x1[1]) + (x1[2] * x1[2] + x1[3] * x1[3])); }
                s = xl::sum_xor16(s); s = xl::sum_xor32(s);
                if (fq == 0) ssq_next[(size_t)row * 32 + u.pn * 4 + wc] = s; }
    }
};
struct EpiUp {
    static constexpr bool PERM = false, AFTER_DRAIN = false;
    const float* ssq; bf16_t* U; float* out; int layer;
    __device__ __forceinline__ void operator()(const f32x4 (&acc)[2][2][4][2], const Unit& u, int wr, int wc, int fr, int fq) const {
        const int rowb = u.pm * BM + wr * 64 + fr, colb = u.pn * BM + wc * 32 + 4 * fq, natb = 128 * u.pn + wc * 32 + 4 * fq;
#pragma unroll
        for (int ai = 0; ai < 2; ++ai)
#pragma unroll
            for (int m = 0; m < 4; ++m) { const int row = rowb + ai * HALF + m * 16; const float rs = rowscale(ssq, row);
                long oo = -1; if (row >= SROW0) { const int sr = row - SROW0; if (row < MREAL && (sr & 15) >= 14) oo = OFF_FS + ((long)(layer * 16 + (sr >> 4)) * 2 + ((sr & 15) - 14)) * 8192; }
                else if (row >= LPR - 2) oo = OFF_FP + (long)(layer * 2 + (row - (LPR - 2))) * 8192;
#pragma unroll
                for (int bj = 0; bj < 2; ++bj)
#pragma unroll
                    for (int n = 0; n < 2; ++n) { const f32x4 v = acc[ai][bj][m][n] * rs; *(u32x2*)(U + (size_t)row * 8192 + colb + bj * HALF + n * 16) = pk4(v);
                        if (oo >= 0) *(f32x4*)(out + oo + bj * 4096 + natb + n * 16) = v; } }
    }
};

struct EpiUpConv {
    static constexpr bool PERM = false, AFTER_DRAIN = false;
    const float* ssq; bf16_t* G; float* HALO; const float* wf; const float* bfc; float* out; int layer; PG8_LAS float* rst;
    __device__ __forceinline__ void pre_epi(const Unit& u, int wc, int lane) const { const int trow = wc * 64 + lane, vi = trow >> 5, c4 = (trow & 31) * 4;
        const float* ex = ((vi & 3) == 3 ? bfc : wf + (vi & 3) * 8192) + (vi >> 2) * 4096 + 128 * u.pn + c4;
        f32x4 e; rst[trow] = rowscale_asm(ssq + (size_t)(u.pm * BM + trow) * 32, ex, e);
        *(PG8_LAS f32x4*)(rst + 256 + vi * 128 + c4) = e; }
    __device__ __forceinline__ void operator()(const f32x4 (&acc)[2][2][4][2], const Unit& u, int wr, int wc, int fr, int fq) const {
        const int rowb = u.pm * BM + wr * 64 + fr, chb = 128 * u.pn + wc * 32 + 4 * fq; const bool samp = u.pm >= 32;
        float rs[2][4];
#pragma unroll
        for (int ai = 0; ai < 2; ++ai)
#pragma unroll
            for (int m = 0; m < 4; ++m) rs[ai][m] = rst[ai * HALF + wr * 64 + m * 16 + fr];
#pragma unroll
        for (int n = 0; n < 2; ++n) { const int ch = chb + 16 * n;
            const PG8_LAS float* wt = rst + 256 + wc * 32 + 4 * fq + 16 * n;
            const f32x4 w0a = *(const PG8_LAS f32x4*)(wt), w1a = *(const PG8_LAS f32x4*)(wt + 128), w2a = *(const PG8_LAS f32x4*)(wt + 256), ba = *(const PG8_LAS f32x4*)(wt + 384);
            const f32x4 w0b = *(const PG8_LAS f32x4*)(wt + 512), w1b = *(const PG8_LAS f32x4*)(wt + 640), w2b = *(const PG8_LAS f32x4*)(wt + 768), bb = *(const PG8_LAS f32x4*)(wt + 896);
#pragma unroll
            for (int ai = 0; ai < 2; ++ai)
#pragma unroll
                for (int m = 0; m < 4; ++m) { const int row = rowb + ai * HALF + m * 16;
                    const f32x4 ua = acc[ai][0][m][n] * rs[ai][m], ub = acc[ai][1][m][n] * rs[ai][m];
                    f32x4 pa = ua, pb = ub; if (m > 0) { pa = acc[ai][0][m - 1][n] * rs[ai][m - 1]; pb = acc[ai][1][m - 1][n] * rs[ai][m - 1]; }
                    f32x4 A, B;
#pragma unroll
                    for (int e = 0; e < 4; ++e) {
                        const float a1 = xl::row_ror<1>(fr == 15 ? pa[e] : ua[e]), a2 = xl::row_ror<2>(fr >= 14 ? pa[e] : ua[e]);
                        const float b1 = xl::row_ror<1>(fr == 15 ? pb[e] : ub[e]), b2 = xl::row_ror<2>(fr >= 14 ? pb[e] : ub[e]);
                        A[e] = w0a[e] * a2 + w1a[e] * a1 + w2a[e] * ua[e] + ba[e]; B[e] = w0b[e] * b2 + w1b[e] * b1 + w2b[e] * ub[e] + bb[e]; }
                    f32x4 gv;
#pragma unroll
                    for (int e = 0; e < 4; ++e) gv[e] = A[e] * sigmoidf_(A[e]) * B[e];
                    const bool skip = fr < 2 && (m == 0 || samp);
                    if (!skip) *(u32x2*)(G + (size_t)row * 4096 + ch) = pk4(gv);
                    const bool halo = samp ? (fr < 2 || fr >= 14) : ((m == 0 && fr < 2) || (m == 3 && fr >= 14));
                    if (halo && row < MREAL) { float* hp = HALO + (size_t)halo_slot(row) * 8192 + ch; *(f32x4*)hp = ua; *(f32x4*)(hp + 4096) = ub; }
                    if (samp) {
                        long oo = -1; if (row >= SROW0) { const int sr = row - SROW0; if (row < MREAL && (sr & 15) >= 14) oo = OFF_FS + ((long)(layer * 16 + (sr >> 4)) * 2 + ((sr & 15) - 14)) * 8192; }
                        else if (row >= LPR - 2) oo = OFF_FP + (long)(layer * 2 + (row - (LPR - 2))) * 8192;
                        if (oo >= 0) { *(f32x4*)(out + oo + ch) = ua; *(f32x4*)(out + oo + 4096 + ch) = ub; } } }
            asm volatile("" ::: "memory");
        }
    }
};
template <class Epi, class Sched, bool ALIGN_EPI = false, bool SP2 = false, bool MID = false>
__device__ __forceinline__ void gemm_phase(PG8_LAS unsigned char* lds, const Gemm g, const Sched& S, const Epi& E, const int wv  ) {
    int tid_ = wv * 64 + (int)__builtin_amdgcn_mbcnt_hi(~0u, __builtin_amdgcn_mbcnt_lo(~0u, 0u)); asm volatile("" : "+v"(tid_));
    const int tid = tid_, wid = __builtin_amdgcn_readfirstlane(tid >> 6), lane = tid & 63, wr = wid >> 2, wc = wid & 3, fr = lane & 15, fq = lane >> 4;
    const int K = g.K, nt = K / BK;
    unsigned voffA[2], voffB[2];
#pragma unroll
    for (int i = 0; i < 2; ++i) { int R, C; stage_rc(tid * 16 + i * 8192, R, C); const int Rb = Epi::PERM ? ((R & ~31) + perm32(R & 31)) : R;
        voffA[i] = (unsigned)(R * K + C) * 2u; voffB[i] = (unsigned)(Rb * K + C) * 2u; }
    const size_t kstep = (size_t)(BK * 2);
    const size_t hstep = (size_t)HALF * K * 2;
    const size_t tstep = 2 * hstep;
    const unsigned ldsw = (unsigned)wid * 1024u;
    const int aoff = lds_byte(wr * 64 + fr, fq * 8), boff = lds_byte(wc * 32 + fr, fq * 8);
    const unsigned ldsA = (unsigned)(uintptr_t)lds + (unsigned)aoff, ldsB = (unsigned)(uintptr_t)lds + (unsigned)boff;
#define PG8_SA(b, h) (((b) * 2 + (h)) * HTB)
#define PG8_SB(b, h) ((4 + (b) * 2 + (h)) * HTB)
#define PG8_STAGE(bufoff, gbase, voff) do { _Pragma("unroll") for (int _i = 0; _i < 2; ++_i) \
        __builtin_amdgcn_global_load_lds((const unsigned*)((const char*)(gbase) + (voff)[_i]), (PG8_LAS unsigned*)(lds + (bufoff) + ldsw + _i * 8192), 16, 0, 0); } while (0)
#define PG8_DSRD(dst, addr, off) asm volatile("ds_read_b128 %0, %1 offset:%2" : "=v"(dst) : "v"(addr), "i"(off))
#define PG8_LDA(dst, b, h) do { const unsigned a_ = ldsA + PG8_SA(b, h); _Pragma("unroll") for (int m = 0; m < 4; ++m) _Pragma("unroll") for (int k = 0; k < 2; ++k) PG8_DSRD(dst[m][k], a_, m * 2048 + k * 1024); } while (0)
#define PG8_LDB(dst, b, h) do { const unsigned b_ = ldsB + PG8_SB(b, h); _Pragma("unroll") for (int n = 0; n < 2; ++n) _Pragma("unroll") for (int k = 0; k < 2; ++k) PG8_DSRD(dst[n][k], b_, n * 2048 + k * 1024); } while (0)
#define PG8_MMA(ai, bj, At, Bt) do { __builtin_amdgcn_s_setprio(1); _Pragma("unroll") for (int m = 0; m < 4; ++m) _Pragma("unroll") for (int n = 0; n < 2; ++n) _Pragma("unroll") for (int k = 0; k < 2; ++k) \
        acc[ai][bj][m][n] = __builtin_amdgcn_mfma_f32_16x16x32_bf16(Bt[n][k], At[m][k], acc[ai][bj][m][n], 0, 0, 0); __builtin_amdgcn_s_setprio(0); } while (0)
#define PG8_WAIT_V(n) asm volatile("s_waitcnt vmcnt(" #n ")" ::: "memory")
#define PG8_WAIT_L(n) asm volatile("s_waitcnt lgkmcnt(" #n ")" ::: "memory")
#define PG8_BAR __builtin_amdgcn_s_barrier()
#define PG8_SCHED __builtin_amdgcn_sched_barrier(0)
    Unit cur, nxt; int ui = 0;
    if (!S.next(0, cur)) return;
    f32x4 acc[2][2][4][2];
#pragma unroll
    for (int a = 0; a < 2; ++a)
#pragma unroll
        for (int b = 0; b < 2; ++b)
#pragma unroll
            for (int m = 0; m < 4; ++m)
#pragma unroll
                for (int n = 0; n < 2; ++n) acc[a][b][m][n] = (f32x4){0.f, 0.f, 0.f, 0.f};
    bf16x8 At[4][2], B0[2][2], B1[2][2];
    const char* cA = (const char*)g.A + (size_t)cur.pm * tstep; const char* cB = (const char*)g.Bt + (size_t)cur.pn * tstep;
    S.a_ready(cur);
    if constexpr (SP2) {
        PG8_STAGE(PG8_SB(0, 0), cB, voffB); PG8_STAGE(PG8_SB(0, 1), cB + hstep, voffB); PG8_STAGE(PG8_SA(0, 0), cA, voffA); PG8_STAGE(PG8_SA(0, 1), cA + hstep, voffA);
        if (wr == 1) PG8_BAR;
        PG8_WAIT_V(2); PG8_BAR;
        PG8_STAGE(PG8_SB(1, 0), cB + kstep, voffB); PG8_STAGE(PG8_SA(1, 0), cA + kstep, voffA); PG8_STAGE(PG8_SB(1, 1), cB + hstep + kstep, voffB);
        PG8_WAIT_V(6); PG8_BAR;
    } else {
        PG8_STAGE(PG8_SB(0, 0), cB, voffB); PG8_STAGE(PG8_SA(0, 0), cA, voffA); PG8_STAGE(PG8_SB(0, 1), cB + hstep, voffB); PG8_STAGE(PG8_SA(0, 1), cA + hstep, voffA);
        if (wr == 1) PG8_BAR;
        PG8_WAIT_V(4); PG8_BAR;
        PG8_STAGE(PG8_SB(1, 0), cB + kstep, voffB); PG8_STAGE(PG8_SA(1, 0), cA + kstep, voffA); PG8_STAGE(PG8_SB(1, 1), cB + hstep + kstep, voffB);
        PG8_WAIT_V(6); PG8_BAR;
    }
    for (;;) {
        const bool has_next = S.next(ui + 1, nxt);
        const char* nA = has_next ? (const char*)g.A + (size_t)nxt.pm * tstep : cA; const char* nB = has_next ? (const char*)g.Bt + (size_t)nxt.pn * tstep : cB;
        for (int t = 0; t < nt; t += 2) {
            if constexpr (MID) { if (t == (nt >> 1)) {
                if constexpr (ALIGN_EPI) { if (wr == 0) PG8_BAR; }
                E.mid(acc, cur, wr, wc, fr, fq);
                if constexpr (ALIGN_EPI) { if (wr == 1) PG8_BAR; }
                PG8_SCHED; } }
            const bool last = (t == nt - 2);
            const char* a1 = cA + (size_t)(t + 1) * kstep;
            const char* a2 = last ? nA : cA + (size_t)(t + 2) * kstep; const char* b2 = last ? nB : cB + (size_t)(t + 2) * kstep;
            const char* a3 = a2 + kstep; const char* b3 = b2 + kstep;
            if (last && has_next) S.a_ready(nxt);
            if constexpr (SP2) {
            PG8_LDB(B0, 0, 0); PG8_LDB(B1, 0, 1); PG8_SCHED; PG8_LDA(At, 0, 0); PG8_STAGE(PG8_SA(1, 1), a1 + hstep, voffA);
            PG8_WAIT_V(8); PG8_WAIT_L(0); PG8_BAR; PG8_SCHED; PG8_MMA(0, 0, At, B0); PG8_MMA(0, 1, At, B1); PG8_BAR; PG8_SCHED;
            PG8_LDA(At, 0, 1); PG8_STAGE(PG8_SB(0, 0), b2, voffB); PG8_STAGE(PG8_SB(0, 1), b2 + hstep, voffB); PG8_STAGE(PG8_SA(0, 0), a2, voffA);
            PG8_WAIT_V(8); PG8_WAIT_L(0); PG8_BAR; PG8_SCHED; PG8_MMA(1, 0, At, B0); PG8_MMA(1, 1, At, B1); PG8_BAR; PG8_SCHED;
            PG8_LDB(B0, 1, 0); PG8_LDB(B1, 1, 1); PG8_SCHED; PG8_LDA(At, 1, 0); PG8_STAGE(PG8_SA(0, 1), a2 + hstep, voffA);
            PG8_WAIT_V(8); PG8_WAIT_L(0); PG8_BAR; PG8_SCHED; PG8_MMA(0, 0, At, B0); PG8_MMA(0, 1, At, B1); PG8_BAR; PG8_SCHED;
            PG8_LDA(At, 1, 1); PG8_STAGE(PG8_SB(1, 0), b3, voffB); PG8_STAGE(PG8_SB(1, 1), b3 + hstep, voffB); PG8_STAGE(PG8_SA(1, 0), a3, voffA);
            PG8_WAIT_V(8); PG8_WAIT_L(0); PG8_BAR; PG8_SCHED; PG8_MMA(1, 0, At, B0); PG8_MMA(1, 1, At, B1); PG8_BAR; PG8_SCHED;
            } else {
            PG8_LDB(B0, 0, 0); PG8_SCHED; PG8_LDA(At, 0, 0); PG8_STAGE(PG8_SA(1, 1), a1 + hstep, voffA);
            PG8_WAIT_L(8); PG8_BAR; PG8_WAIT_L(0); PG8_SCHED; PG8_MMA(0, 0, At, B0); PG8_BAR; PG8_SCHED;
            PG8_LDB(B1, 0, 1); PG8_STAGE(PG8_SB(0, 0), b2, voffB);
            PG8_BAR; PG8_WAIT_L(0); PG8_SCHED; PG8_MMA(0, 1, At, B1); PG8_BAR;
            PG8_LDA(At, 0, 1); PG8_STAGE(PG8_SA(0, 0), a2, voffA);
            PG8_BAR; PG8_WAIT_L(0); PG8_SCHED; PG8_MMA(1, 0, At, B0); PG8_BAR; PG8_SCHED;
            PG8_STAGE(PG8_SB(0, 1), b2 + hstep, voffB);
            PG8_WAIT_V(6); PG8_BAR; PG8_MMA(1, 1, At, B1); PG8_BAR;
            PG8_LDB(B0, 1, 0); PG8_SCHED; PG8_LDA(At, 1, 0); PG8_STAGE(PG8_SA(0, 1), a2 + hstep, voffA);
            PG8_WAIT_L(8); PG8_BAR; PG8_WAIT_L(0); PG8_SCHED; PG8_MMA(0, 0, At, B0); PG8_BAR; PG8_SCHED;
            PG8_LDB(B1, 1, 1); PG8_STAGE(PG8_SB(1, 0), b3, voffB);
            PG8_BAR; PG8_WAIT_L(0); PG8_SCHED; PG8_MMA(0, 1, At, B1); PG8_BAR;
            PG8_LDA(At, 1, 1); PG8_STAGE(PG8_SA(1, 0), a3, voffA);
            PG8_BAR; PG8_WAIT_L(0); PG8_SCHED; PG8_MMA(1, 0, At, B0); PG8_BAR; PG8_SCHED;
            PG8_STAGE(PG8_SB(1, 1), b3 + hstep, voffB);
            PG8_WAIT_V(6); PG8_BAR; PG8_MMA(1, 1, At, B1); PG8_BAR;
            }
        }
        if constexpr (ALIGN_EPI) { if (wr == 0) { E.pre_epi(cur, wc, lane); PG8_WAIT_L(0); PG8_BAR; } }
        if constexpr (!Epi::AFTER_DRAIN) { E(acc, cur, wr, wc, fr, fq); S.done(cur); }
        if (!has_next) break;
#pragma unroll
        for (int a = 0; a < 2; ++a)
#pragma unroll
            for (int b = 0; b < 2; ++b)
#pragma unroll
                for (int m = 0; m < 4; ++m)
#pragma unroll
                    for (int n = 0; n < 2; ++n) acc[a][b][m][n] = (f32x4){0.f, 0.f, 0.f, 0.f};
        cur = nxt; cA = nA; cB = nB; ++ui;
        if constexpr (ALIGN_EPI) { if (wr == 1) PG8_BAR; }
    }
    PG8_WAIT_V(0);
    if constexpr (!ALIGN_EPI) { if (wr == 0) PG8_BAR; }
    PG8_BAR;
    if constexpr (Epi::AFTER_DRAIN) { E.fused(acc, cur, wr, wc, fr, fq, lds, wid, lane); S.done(cur); }
#undef PG8_SA
#undef PG8_SB
#undef PG8_STAGE
#undef PG8_DSRD
#undef PG8_LDA
#undef PG8_LDB
#undef PG8_MMA
#undef PG8_WAIT_V
#undef PG8_WAIT_L
#undef PG8_BAR
#undef PG8_SCHED
}
}
namespace pa {
typedef unsigned short bf16_t;
typedef short bf16x8 __attribute__((ext_vector_type(8)));
typedef short s16x4 __attribute__((ext_vector_type(4)));
typedef float f32x16 __attribute__((ext_vector_type(16)));
typedef float f32x4 __attribute__((ext_vector_type(4)));
typedef unsigned u32x4 __attribute__((ext_vector_type(4)));
constexpr int D = 128, LD = 1024, LDO = 2048;
constexpr float SCALE = 0.08838834764831845f, C2 = 1.4426950408889634f * SCALE, THR = 8.f;
constexpr int NW = 8, QBLK = 32, KVBLK = 64, QB = NW * QBLK;
constexpr int SHM_V = KVBLK * D * 2, SHM_K = KVBLK * D * 2;
constexpr int LDS_ATT = 2 * SHM_V + 2 * SHM_K + NW * 64 * 4;
#define KSWZ(row, colB) ((row) * 256 + ((colB) ^ (((row) & 7) << 4)))
#define SBAR() __builtin_amdgcn_sched_barrier(0)
__device__ __forceinline__ int v_st(int k, int c) { const int kk = (k & ~0xC) | ((k & 4) << 1) | ((k & 8) >> 1); return ((kk >> 3) * 4 + (c >> 5)) * 512 + ((kk & 7) * 32 + (c & 31)) * 2; }
__device__ __forceinline__ int v_rd_base(int lane) { return ((lane & 3) << 3) | (((lane >> 2) & 3) << 6) | (((lane >> 4) & 1) << 5) | (((lane >> 5) & 1) << 8); }
constexpr int v_rd_off(int d0, int ks, int half) { return d0 * 512 + ks * 4096 + half * 2048; }
__device__ __forceinline__ int crow(int r, int hi) { return (r & 3) + 8 * (r >> 2) + 4 * hi; }
__device__ __forceinline__ unsigned cvtpk(float lo, float hi) { return cvt_pk_bf16_rne(lo, hi); }
__device__ __forceinline__ bf16x8 load8(const bf16_t* p) { return *reinterpret_cast<const bf16x8*>(p); }
__device__ __forceinline__ void mask_tile(f32x16& p0, f32x16& p1, int dq) {
    const float NEG = -__builtin_inff();
#pragma unroll
    for (int r = 0; r < 16; ++r) { const int c = (r & 3) + 8 * (r >> 2); if (dq - c < 0) p0[r] = NEG; if (dq - c - 32 < 0) p1[r] = NEG; }
}
__device__ __forceinline__ void partialSM(f32x16& p0, f32x16& p1, float& m_reg, float& mn, float& alpha) {
    float pmax = p0[0];
#pragma unroll
    for (int r = 1; r < 16; ++r) pmax = fmaxf(pmax, p0[r]);
#pragma unroll
    for (int r = 0; r < 16; ++r) pmax = fmaxf(pmax, p1[r]);
    { auto rr = __builtin_amdgcn_permlane32_swap(__float_as_uint(pmax), __float_as_uint(pmax), false, false);
      pmax = fmaxf(__uint_as_float(rr[0]), __uint_as_float(rr[1])); }
    if (__builtin_expect(__all((pmax - m_reg) * SCALE <= THR), 1)) { mn = m_reg; alpha = 1.f; }
    else { mn = fmaxf(m_reg, pmax); alpha = __builtin_amdgcn_exp2f((m_reg - mn) * C2); m_reg = mn; }
    const float mnL = -mn * C2;
#pragma unroll
    for (int r = 0; r < 16; ++r) p0[r] = fmaf(p0[r], C2, mnL);
#pragma unroll
    for (int r = 0; r < 16; ++r) p1[r] = fmaf(p1[r], C2, mnL);
#pragma unroll
    for (int r = 0; r < 16; ++r) p0[r] = __builtin_amdgcn_exp2f(p0[r]);
}
__device__ __forceinline__ void finishSM(f32x16& p0, f32x16& p1, float alpha, float& l_reg, bf16x8& pa0, bf16x8& pa1, bf16x8& pa2, bf16x8& pa3) {
#pragma unroll
    for (int r = 0; r < 16; ++r) p1[r] = __builtin_amdgcn_exp2f(p1[r]);
    float ps = 0;
#pragma unroll
    for (int r = 0; r < 16; ++r) ps += p0[r];
#pragma unroll
    for (int r = 0; r < 16; ++r) ps += p1[r];
    { auto rr = __builtin_amdgcn_permlane32_swap(__float_as_uint(ps), __float_as_uint(ps), false, false);
      ps = __uint_as_float(rr[0]) + __uint_as_float(rr[1]); }
    l_reg = l_reg * alpha + ps;
#define PK4(P, B_, OUT) do { unsigned a0 = cvtpk(P[B_+0], P[B_+1]), a1 = cvtpk(P[B_+2], P[B_+3]);                          \
        unsigned b0 = cvtpk(P[B_+4], P[B_+5]), b1 = cvtpk(P[B_+6], P[B_+7]);                                             \
        auto r0 = __builtin_amdgcn_permlane32_swap(a0, b0, false, false); auto r1 = __builtin_amdgcn_permlane32_swap(a1, b1, false, false); \
        u32x4 w = {r0[0], r1[0], r0[1], r1[1]}; OUT = *reinterpret_cast<bf16x8*>(&w); } while (0)
    PK4(p0, 0, pa0); PK4(p0, 8, pa1); PK4(p1, 0, pa2); PK4(p1, 8, pa3);
#undef PK4
}
template <int KB>
__device__ __forceinline__ void qkt(f32x16& p0, f32x16& p1, const char* K_lds, int r32, int hi, const bf16x8* qr, const float* bk) {
#pragma unroll
    for (int j = 0; j < 4; ++j) { const f32x4 b0 = *(const f32x4*)(bk + 8 * j), b1 = *(const f32x4*)(bk + 32 + 8 * j);
#pragma unroll
        for (int e = 0; e < 4; ++e) { p0[4 * j + e] = b0[e]; p1[4 * j + e] = b1[e]; } }
    const char* kb[4];
#pragma unroll
    for (int dd = 0; dd < 4; ++dd) kb[dd] = K_lds + KB * SHM_K + KSWZ(r32, (dd * 16 + hi * 8) * 2);
#pragma unroll
    for (int d0 = 0; d0 < 8; ++d0) { const char* a = kb[d0 & 3] + (d0 >> 2) * 128;
        bf16x8 b0 = *reinterpret_cast<const bf16x8*>(a);
        bf16x8 b1 = *reinterpret_cast<const bf16x8*>(a + 32 * 256);
        p0 = __builtin_amdgcn_mfma_f32_32x32x16_bf16(b0, qr[d0], p0, 0, 0, 0);
        p1 = __builtin_amdgcn_mfma_f32_32x32x16_bf16(b1, qr[d0], p1, 0, 0, 0); }
}
template <int VB>
__device__ __forceinline__ void pv_tile(f32x16* o, int vb0, bf16x8 pa0, bf16x8 pa1, bf16x8 pa2, bf16x8 pa3) {
#define TRRD(dst, off) asm volatile("ds_read_b64_tr_b16 %0, %1 offset:%2" : "=&v"(dst) : "v"(vb0), "i"(off) : "memory")
#define PV_D0(d0) do { s16x4 l0, l1, l2, l3, h0, h1, h2, h3; constexpr int b_ = VB * SHM_V + v_rd_off(d0, 0, 0); \
        TRRD(l0, b_); TRRD(h0, b_ + 2048); TRRD(l1, b_ + 4096); TRRD(h1, b_ + 6144); TRRD(l2, b_ + 8192); TRRD(h2, b_ + 10240); TRRD(l3, b_ + 12288); TRRD(h3, b_ + 14336); \
        asm volatile("s_waitcnt lgkmcnt(0)" ::: "memory"); SBAR();   \
        o[d0] = __builtin_amdgcn_mfma_f32_32x32x16_bf16(pa0, (bf16x8){l0[0], l0[1], l0[2], l0[3], h0[0], h0[1], h0[2], h0[3]}, o[d0], 0, 0, 0);   \
        o[d0] = __builtin_amdgcn_mfma_f32_32x32x16_bf16(pa1, (bf16x8){l1[0], l1[1], l1[2], l1[3], h1[0], h1[1], h1[2], h1[3]}, o[d0], 0, 0, 0);   \
        o[d0] = __builtin_amdgcn_mfma_f32_32x32x16_bf16(pa2, (bf16x8){l2[0], l2[1], l2[2], l2[3], h2[0], h2[1], h2[2], h2[3]}, o[d0], 0, 0, 0);   \
        o[d0] = __builtin_amdgcn_mfma_f32_32x32x16_bf16(pa3, (bf16x8){l3[0], l3[1], l3[2], l3[3], h3[0], h3[1], h3[2], h3[3]}, o[d0], 0, 0, 0); } while (0)
    PV_D0(0); PV_D0(1); PV_D0(2); PV_D0(3);
#undef PV_D0
#undef TRRD
}
struct BlockRef { const bf16_t* Q; const bf16_t* K; const bf16_t* V; bf16_t* O; int P0, j_lo, j_hi, mode; float* part; unsigned* flag; };
struct Seam { bf16x8 qr[8]; bf16x8 st_v0, st_v1, st_k0, st_k1; };
#define ROW(p, k0, rr) ((p) + (size_t)((k0) + (rr)) * LD + sc)
#define VMW() asm volatile("s_waitcnt vmcnt(0)" ::: "memory")
#define VMWN(n) asm volatile("s_waitcnt vmcnt(%0)" :: "i"(n) : "memory")
#define SLOAD_H(Kp, Vp, k0) do { S.st_v0 = load8(ROW(Vp, k0, sr)); S.st_v1 = load8(ROW(Vp, k0, 32 + sr));              \
                         S.st_k0 = load8(ROW(Kp, k0, sr)); S.st_k1 = load8(ROW(Kp, k0, 32 + sr)); } while (0)
#define SWRITE_HK(bf) do { *(bf16x8*)(K_lds + (bf) * SHM_K + kws) = S.st_k0; *(bf16x8*)(K_lds + (bf) * SHM_K + kws + 32 * 256) = S.st_k1; } while (0)
#define SWRITE_HV(bf) do { *(bf16x8*)(V_lds + (bf) * SHM_V + vst0) = S.st_v0; *(bf16x8*)(V_lds + (bf) * SHM_V + vst1) = S.st_v1; } while (0)
#define SWRITE_H(bf) do { SWRITE_HV(bf); SWRITE_HK(bf); } while (0)
constexpr int PART_FLOATS = 256 * 128 + 512;
__device__ __forceinline__ void prime(const BlockRef& cur, char* lds, Seam& S, const int wv) {
    int tid_ = wv * 64 + (int)__builtin_amdgcn_mbcnt_hi(~0u, __builtin_amdgcn_mbcnt_lo(~0u, 0u)); asm volatile("" : "+v"(tid_)); const int tid = tid_, wid = __builtin_amdgcn_readfirstlane(tid >> 6), lane = tid & 63, r32 = lane & 31, hi = lane >> 5;
    const int sr = tid >> 4, sc = (tid & 15) * 8, kws = KSWZ(sr, sc * 2); char* K_lds = lds + 2 * SHM_V;
#pragma unroll
    for (int d0 = 0; d0 < 8; ++d0) S.qr[d0] = load8(cur.Q + (size_t)(wid * QBLK + r32) * LD + d0 * 16 + hi * 8);
    SLOAD_H(cur.K, cur.V, cur.j_lo * KVBLK); VMW(); SWRITE_HK(0);
    __syncthreads();
}
__device__ __forceinline__ void block(const BlockRef& cur, const BlockRef& nxt, char* lds, const float* bias, Seam& S, const int wv) {
    int tid_ = wv * 64 + (int)__builtin_amdgcn_mbcnt_hi(~0u, __builtin_amdgcn_mbcnt_lo(~0u, 0u)); asm volatile("" : "+v"(tid_)); const int tid = tid_, wid = __builtin_amdgcn_readfirstlane(tid >> 6), lane = tid & 63, r32 = lane & 31, hi = lane >> 5;
    const int j_lo = cur.j_lo, NT = cur.j_hi - cur.j_lo;
    const int qlo = cur.P0 + wid * QBLK, qm = qlo + r32 - 4 * hi;
    char* V_lds = lds; char* K_lds = lds + 2 * SHM_V;
    float* ws = (float*)(lds + 2 * SHM_V + 2 * SHM_K) + wid * 64; float* li_l = ws, * al_l = ws + 32;
    const float* bk = bias + 4 * hi;
    float m_reg = -1e30f, l_reg = 0; f32x16 o[4] = {};
    const int sr = tid >> 4, sc = (tid & 15) * 8, vst0 = v_st(sr, sc), vst1 = v_st(32 + sr, sc), kws = KSWZ(sr, sc * 2);
    const int vb0 = (int)(uintptr_t)V_lds + v_rd_base(lane);
    const bf16_t* Kh = cur.K; const bf16_t* Vh = cur.V;
#define RESC(a) do { if (__any((a) < 1.f)) { if (hi == 0) al_l[r32] = (a); asm volatile("s_waitcnt lgkmcnt(0)" ::: "memory");              \
                     for (int d_ = 0; d_ < 4; ++d_) for (int r = 0; r < 16; ++r) o[d_][r] *= al_l[crow(r, hi)]; } } while (0)
#define KBASE(t) ((j_lo + (t)) * KVBLK)
#define MASKT(P0_, P1_, t) do { const int kb_ = KBASE(t); if (kb_ + KVBLK - 1 > qlo) mask_tile(P0_, P1_, qm - kb_); } while (0)
    constexpr int NQL = 8;
#define SEAM_K0() do { VMWN(NQL); SWRITE_HK(0); SBAR(); } while (0)
    f32x16 pA0, pA1, pB0, pB1; float mnA, mnB, alA, alB; bf16x8 pa0, pa1, pa2, pa3;
    SWRITE_HV(0); SBAR();
    if (NT > 1) { SLOAD_H(Kh, Vh, KBASE(1)); }
    SBAR(); qkt<0>(pA0, pA1, K_lds, r32, hi, S.qr, bk + KBASE(0));
    MASKT(pA0, pA1, 0); partialSM(pA0, pA1, m_reg, mnA, alA);
    if (NT > 1) { VMW(); SWRITE_H(1); }
    __syncthreads();
#define HALF_STEP(PX0, PX1, mnX, alX, PY0, PY1, alY, t, KB, VB, SB) do {                                                      \
        SBAR(); qkt<KB>(PX0, PX1, K_lds, r32, hi, S.qr, bk + KBASE(t));                                             \
        finishSM(PY0, PY1, alY, l_reg, pa0, pa1, pa2, pa3); SBAR();                                                           \
        if ((t) + 1 < NT) { SLOAD_H(Kh, Vh, KBASE((t) + 1)); SBAR(); }                                               \
        pv_tile<VB>(o, vb0, pa0, pa1, pa2, pa3); MASKT(PX0, PX1, (t)); partialSM(PX0, PX1, m_reg, mnX, alX);                                        \
        __syncthreads();                                                                                                      \
        if ((t) + 1 < NT) { VMW(); SWRITE_H(SB); }                                                                          \
        RESC(alX); __syncthreads(); } while (0)
    for (int t = 1; t + 1 < NT; t += 2) {
        HALF_STEP(pB0, pB1, mnB, alB, pA0, pA1, alA, t, 1, 0, 0);
        HALF_STEP(pA0, pA1, mnA, alA, pB0, pB1, alB, t + 1, 0, 1, 1);
    }
    const bool even = (NT & 1) == 0;
    if (even) { SBAR(); qkt<1>(pB0, pB1, K_lds, r32, hi, S.qr, bk + KBASE(NT - 1)); SBAR(); }
    SLOAD_H(nxt.K, nxt.V, nxt.j_lo * KVBLK); SBAR();
#pragma unroll
    for (int d0 = 0; d0 < 8; ++d0) S.qr[d0] = load8(nxt.Q + (size_t)(wid * QBLK + r32) * LD + d0 * 16 + hi * 8);
    SBAR();
    finishSM(pA0, pA1, alA, l_reg, pa0, pa1, pa2, pa3); SBAR();
    pv_tile<0>(o, vb0, pa0, pa1, pa2, pa3);
    if (even) { MASKT(pB0, pB1, NT - 1); partialSM(pB0, pB1, m_reg, mnB, alB); __syncthreads(); RESC(alB);
        finishSM(pB0, pB1, alB, l_reg, pa0, pa1, pa2, pa3); SBAR(); pv_tile<1>(o, vb0, pa0, pa1, pa2, pa3); }
    SBAR(); SEAM_K0();
    const int mode = cur.mode;
    if (mode == 1) {
        float* P = cur.part;
#pragma unroll
        for (int r = 0; r < 16; ++r) { const int prow = wid * QBLK + crow(r, hi);
#pragma unroll
            for (int d0 = 0; d0 < 4; ++d0) __hip_atomic_store(P + (size_t)prow * 128 + d0 * 32 + r32, o[d0][r], __ATOMIC_RELAXED, __HIP_MEMORY_SCOPE_AGENT); }
        if (hi == 0) { __hip_atomic_store(P + 32768 + wid * QBLK + r32, m_reg, __ATOMIC_RELAXED, __HIP_MEMORY_SCOPE_AGENT); __hip_atomic_store(P + 32768 + 256 + wid * QBLK + r32, l_reg, __ATOMIC_RELAXED, __HIP_MEMORY_SCOPE_AGENT); }
        VMW();
        __syncthreads();
        if (tid == 0) __hip_atomic_store(cur.flag, 1u, __ATOMIC_RELAXED, __HIP_MEMORY_SCOPE_AGENT);
    } else {
        float w_own;
        if (mode == 2) {
            if (tid == 0) { unsigned sp = 0; while (__hip_atomic_load(cur.flag, __ATOMIC_RELAXED, __HIP_MEMORY_SCOPE_AGENT) == 0u) { __builtin_amdgcn_s_sleep(8); if (++sp > (1u << 22)) break; } }
            __syncthreads();
            const float* P = cur.part;
            const float m0 = __hip_atomic_load(P + 32768 + wid * QBLK + r32, __ATOMIC_RELAXED, __HIP_MEMORY_SCOPE_AGENT), l0 = __hip_atomic_load(P + 32768 + 256 + wid * QBLK + r32, __ATOMIC_RELAXED, __HIP_MEMORY_SCOPE_AGENT);
            const float M = fmaxf(m0, m_reg), e0 = __builtin_amdgcn_exp2f((m0 - M) * C2), e1 = __builtin_amdgcn_exp2f((m_reg - M) * C2), inv = 1.0f / (e0 * l0 + e1 * l_reg);
            w_own = e1 * inv; if (hi == 0) al_l[r32] = e0 * inv;
        } else { w_own = 1.0f / l_reg; }
        if (hi == 0) li_l[r32] = w_own;
        asm volatile("s_waitcnt lgkmcnt(0)" ::: "memory");
        bf16_t* Ow = cur.O + (size_t)(wid * QBLK) * LDO;
#pragma unroll
        for (int r = 0; r < 16; ++r) { const int orow = crow(r, hi); const float wr_ = li_l[orow];
            float w0_ = 0.f; if (mode == 2) w0_ = al_l[orow];
#pragma unroll
            for (int d0 = 0; d0 < 4; ++d0) { float v = o[d0][r] * wr_;
                if (mode == 2) v += w0_ * __hip_atomic_load(cur.part + (size_t)(wid * QBLK + orow) * 128 + d0 * 32 + r32, __ATOMIC_RELAXED, __HIP_MEMORY_SCOPE_AGENT);
                const float vn = xl::xor1(v);
                if ((r32 & 1) == 0) *(unsigned*)(Ow + (size_t)orow * LDO + d0 * 32 + r32) = cvtpk(v, vn); } }
        __syncthreads();
    }
#undef RESC
#undef KBASE
#undef MASKT
#undef SEAM_K0
#undef HALF_STEP
}
#undef ROW
#undef VMW
#undef VMWN
#undef SLOAD_H
#undef SWRITE_HK
#undef SWRITE_HV
#undef SWRITE_H
#undef KSWZ
#undef SBAR
}

namespace sa {
typedef unsigned short bf16_t;
typedef short bf16x8 __attribute__((ext_vector_type(8)));
typedef float f32x4 __attribute__((ext_vector_type(4)));
typedef unsigned u32x4 __attribute__((ext_vector_type(4)));
typedef unsigned u32x2 __attribute__((ext_vector_type(2)));
constexpr int LD = 1024;
constexpr float C2 = 0.08838834764831845f * 1.4426950408889634f;
constexpr int PART_OFF = 36864, PART_STRIDE = 8320;
struct Item { const float* Kc; const float* Vc; int nk; const float* Kn; const float* Vn; const bf16_t* Q; bf16_t* O; };
__device__ __forceinline__ unsigned cvtpk(float lo, float hi) { return cvt_pk_bf16_rne(lo, hi); }
__device__ __forceinline__ bf16x8 pack8(f32x4 a, f32x4 b) { u32x4 w = {cvtpk(a[0], a[1]), cvtpk(a[2], a[3]), cvtpk(b[0], b[1]), cvtpk(b[2], b[3])}; return *reinterpret_cast<bf16x8*>(&w); }
struct TileRegs { f32x4 ka[4][2]; f32x4 va[4][2]; };
__device__ __forceinline__ void tile_load(TileRegs& T, const float* K, const float* V, int lane) {
    const int q = lane & 15, g = lane >> 4;
    const float* kp = K + (size_t)q * LD + 4 * g;
#pragma unroll
    for (int s = 0; s < 4; ++s) { T.ka[s][0] = __builtin_nontemporal_load((const f32x4*)(kp + 32 * s)); T.ka[s][1] = __builtin_nontemporal_load((const f32x4*)(kp + 32 * s + 16)); }
#pragma unroll
    for (int v = 0; v < 4; ++v) { const float* vp = V + (size_t)(4 * g + v) * LD + 8 * q; T.va[v][0] = __builtin_nontemporal_load((const f32x4*)vp); T.va[v][1] = __builtin_nontemporal_load((const f32x4*)(vp + 4)); }
}
template <bool ISNEW>
__device__ __forceinline__ void tile_compute(const TileRegs& T, const bf16x8 (&qf)[4], const float* bias_t, f32x4 (&o)[8], float& m, float& l, int lane) {
    const int q = lane & 15, g = lane >> 4;
    f32x4 s4 = {0.f, 0.f, 0.f, 0.f};
#pragma unroll
    for (int s = 0; s < 4; ++s) s4 = __builtin_amdgcn_mfma_f32_16x16x32_bf16(pack8(T.ka[s][0], T.ka[s][1]), qf[s], s4, 0, 0, 0);
    const f32x4 b = *(const f32x4*)(bias_t + 4 * g);
    float t[4];
#pragma unroll
    for (int v = 0; v < 4; ++v) { t[v] = fmaf(s4[v], C2, b[v]); if (ISNEW && (4 * g + v) > q) t[v] = -__builtin_inff(); }
    float pmax = fmaxf(fmaxf(t[0], t[1]), fmaxf(t[2], t[3]));
    pmax = xl::max_xor16(pmax); pmax = xl::max_xor32(pmax);
    const float mn = fmaxf(m, pmax), alpha = __builtin_amdgcn_exp2f(m - mn); m = mn;
    float p[4];
#pragma unroll
    for (int v = 0; v < 4; ++v) p[v] = __builtin_amdgcn_exp2f(t[v] - mn);
    l = l * alpha + ((p[0] + p[1]) + (p[2] + p[3]));
    if (__any(alpha != 1.f)) {
#pragma unroll
        for (int j = 0; j < 8; ++j) o[j] = o[j] * alpha; }
#pragma unroll
    for (int v = 0; v < 4; ++v)
#pragma unroll
        for (int j = 0; j < 8; ++j) o[j] = __builtin_amdgcn_mfma_f32_16x16x4f32(T.va[v][j >> 2][j & 3], p[v], o[j], 0, 0, 0);
}
constexpr int PART_SLOT = 32 + 16 * 128;
__device__ __forceinline__ void run_part(const Item& it, int tb, int te, bool with_new, float* slot, char* lds, const int wv) {
    int tid_ = wv * 64 + (int)__builtin_amdgcn_mbcnt_hi(~0u, __builtin_amdgcn_mbcnt_lo(~0u, 0u)); asm volatile("" : "+v"(tid_)); const int tid = tid_, wid = __builtin_amdgcn_readfirstlane(tid >> 6), lane = tid & 63, q = lane & 15, g = lane >> 4;
    const float* bias = (const float*)lds;
    bf16x8 qf[4];
#pragma unroll
    for (int s = 0; s < 4; ++s) { const u32x2 qa = *(const u32x2*)(it.Q + (size_t)q * LD + 32 * s + 4 * g), qb = *(const u32x2*)(it.Q + (size_t)q * LD + 32 * s + 16 + 4 * g);
        const u32x4 w = {qa.x, qa.y, qb.x, qb.y}; qf[s] = *reinterpret_cast<const bf16x8*>(&w); }
    f32x4 o[8];
#pragma unroll
    for (int j = 0; j < 8; ++j) o[j] = (f32x4){0.f, 0.f, 0.f, 0.f};
    float m = -1e30f, l = 0.f;
    const int per = (te - tb) >> 3, t0 = tb + wid * per, t1 = t0 + per;
    TileRegs A, B;
    tile_load(A, it.Kc + (size_t)t0 * 16 * LD, it.Vc + (size_t)t0 * 16 * LD, lane);
    tile_load(B, it.Kc + (size_t)(t0 + 1) * 16 * LD, it.Vc + (size_t)(t0 + 1) * 16 * LD, lane);
    for (int t = t0; t < t1; t += 2) {
        tile_compute<false>(A, qf, bias + t * 16, o, m, l, lane);
        { const int tn = (t + 2 < t1) ? t + 2 : t1 - 1; tile_load(A, it.Kc + (size_t)tn * 16 * LD, it.Vc + (size_t)tn * 16 * LD, lane); }
        tile_compute<false>(B, qf, bias + (t + 1) * 16, o, m, l, lane);
        { const int tn = (t + 3 < t1) ? t + 3 : t1 - 1; tile_load(B, it.Kc + (size_t)tn * 16 * LD, it.Vc + (size_t)tn * 16 * LD, lane); }
    }
    if (with_new && wid == 7) { tile_load(A, it.Kn, it.Vn, lane); tile_compute<true>(A, qf, bias + it.nk, o, m, l, lane); }
    l = xl::sum_xor16(l); l = xl::sum_xor32(l);
    float* part = (float*)(lds + PART_OFF + wid * PART_STRIDE);
    if (g == 0) { part[q] = m; part[16 + q] = l; }
#pragma unroll
    for (int j = 0; j < 8; ++j)
#pragma unroll
        for (int v = 0; v < 4; ++v) part[32 + q * 128 + 32 * g + 8 * v + j] = o[j][v];
    __syncthreads();
    {   const int qq = tid >> 5, d4 = (tid & 31) * 4;
        float mw[8], M = -1e30f;
#pragma unroll
        for (int w = 0; w < 8; ++w) { mw[w] = ((const float*)(lds + PART_OFF + w * PART_STRIDE))[qq]; M = fmaxf(M, mw[w]); }
        float den = 0.f; f32x4 num = {0.f, 0.f, 0.f, 0.f};
#pragma unroll
        for (int w = 0; w < 8; ++w) { const float* pw = (const float*)(lds + PART_OFF + w * PART_STRIDE); const float e = __builtin_amdgcn_exp2f(mw[w] - M);
            den += e * pw[16 + qq]; num += *(const f32x4*)(pw + 32 + qq * 128 + d4) * e; }
        if ((tid & 31) == 0) { __hip_atomic_store(slot + qq, M, __ATOMIC_RELAXED, __HIP_MEMORY_SCOPE_AGENT); __hip_atomic_store(slot + 16 + qq, den, __ATOMIC_RELAXED, __HIP_MEMORY_SCOPE_AGENT); }
#pragma unroll
        for (int e = 0; e < 4; ++e) __hip_atomic_store(slot + 32 + qq * 128 + d4 + e, num[e], __ATOMIC_RELAXED, __HIP_MEMORY_SCOPE_AGENT); }
    __syncthreads();
}
template <int NP>
__device__ __forceinline__ void combine_row(const float* slot0, int q, bf16_t* orow, int lane) {
    const float* sl = slot0 + (size_t)(lane < NP ? lane : 0) * PART_SLOT;
    float mp = __hip_atomic_load(sl + q, __ATOMIC_RELAXED, __HIP_MEMORY_SCOPE_AGENT), lp = __hip_atomic_load(sl + 16 + q, __ATOMIC_RELAXED, __HIP_MEMORY_SCOPE_AGENT);
    if (lane >= NP) { mp = -1e30f; lp = 0.f; }
    unsigned long long v[NP];
#pragma unroll
    for (int p = 0; p < NP; ++p) v[p] = __hip_atomic_load((const unsigned long long*)(slot0 + (size_t)p * PART_SLOT + 32 + q * 128 + 2 * lane), __ATOMIC_RELAXED, __HIP_MEMORY_SCOPE_AGENT);
    const float M = xl::wave_max(mp);
    float e = __builtin_amdgcn_exp2f(mp - M); if (lane >= NP) e = 0.f;
    const float den = xl::wave_sum(e * lp);
    float n0 = 0.f, n1 = 0.f;
#pragma unroll
    for (int p = 0; p < NP; ++p) { const float ep = __int_as_float(__builtin_amdgcn_readlane(__float_as_int(e), p)); n0 += ep * __uint_as_float((unsigned)v[p]); n1 += ep * __uint_as_float((unsigned)(v[p] >> 32)); }
    const float inv = 1.0f / den;
    *(unsigned*)(orow + 2 * lane) = cvtpk(n0 * inv, n1 * inv);
}
}
namespace sk {
typedef unsigned short bf16_t;
typedef short bf16x8 __attribute__((ext_vector_type(8)));
typedef float f32x4 __attribute__((ext_vector_type(4)));
constexpr int ROW0 = 8192, NRG = 5;
struct Frags { bf16x8 a[4]; bf16x8 w[4]; };
__device__ __forceinline__ void load_frags(Frags& F, const bf16_t* ap, const bf16_t* wp, int K  ) {
#pragma unroll
    for (int i = 0; i < 4; ++i) { F.a[i] = *(const bf16x8*)(ap + (size_t)i * 16 * K); F.w[i] = *(const bf16x8*)(wp + (size_t)i * 16 * K); }
}
__device__ __forceinline__ void mma_frags(const Frags& F, f32x4 (&acc)[4][4]) {
#pragma unroll
    for (int i = 0; i < 4; ++i)
#pragma unroll
        for (int cb = 0; cb < 4; ++cb) acc[i][cb] = __builtin_amdgcn_mfma_f32_16x16x32_bf16(F.w[cb], F.a[i], acc[i][cb], 0, 0, 0);
}
__device__ __forceinline__ void job(const bf16_t* A, const bf16_t* Bt, int K, int ld  , int rg, int n0, char* lds, const int wv, f32x4& out0, f32x4& out1) {
    int tid_ = wv * 64 + (int)__builtin_amdgcn_mbcnt_hi(~0u, __builtin_amdgcn_mbcnt_lo(~0u, 0u)); asm volatile("" : "+v"(tid_)); const int tid = tid_, wid = __builtin_amdgcn_readfirstlane(tid >> 6), lane = tid & 63, r = lane & 15, g = lane >> 4;
    const int kw = K >> 3, nks = kw >> 5;
    const bf16_t* ap = A + (size_t)(ROW0 + 64 * rg + r) * ld + wid * kw + 8 * g;
    const bf16_t* wp = Bt + (size_t)(n0 + r) * ld + wid * kw + 8 * g;
    f32x4 acc[4][4];
#pragma unroll
    for (int i = 0; i < 4; ++i)
#pragma unroll
        for (int cb = 0; cb < 4; ++cb) acc[i][cb] = (f32x4){0.f, 0.f, 0.f, 0.f};
    Frags F0, F1;
    load_frags(F0, ap, wp, ld);
    for (int ks = 0; ks < nks; ks += 2) {
        load_frags(F1, ap + (ks + 1) * 32, wp + (ks + 1) * 32, ld);
        mma_frags(F0, acc);
        { const int kn = (ks + 2 < nks) ? ks + 2 : nks - 1; load_frags(F0, ap + kn * 32, wp + kn * 32, ld); }
        mma_frags(F1, acc);
    }
    float* part = (float*)lds + (size_t)(wid * 64 + r) * 64 + 4 * g;
#pragma unroll
    for (int i = 0; i < 4; ++i)
#pragma unroll
        for (int cb = 0; cb < 4; ++cb) *(f32x4*)(part + (size_t)i * 16 * 64 + 16 * cb) = acc[i][cb];
    __syncthreads();
    { const int row = tid >> 3, c8 = (tid & 7) * 8; const float* p = (const float*)lds + (size_t)row * 64 + c8;
      f32x4 s0 = *(const f32x4*)p, s1 = *(const f32x4*)(p + 4);
#pragma unroll
      for (int w = 1; w < 8; ++w) { s0 += *(const f32x4*)(p + (size_t)w * 4096); s1 += *(const f32x4*)(p + (size_t)w * 4096 + 4); }
      out0 = s0; out1 = s1; }
    __syncthreads();
}
}
#define GAS __attribute__((address_space(1)))
#define LAS __attribute__((address_space(3)))
typedef unsigned short bf16;
typedef unsigned v4u __attribute__((ext_vector_type(4)));
typedef float f32x4 __attribute__((ext_vector_type(4)));
typedef short bf16x8 __attribute__((ext_vector_type(8)));
typedef GAS unsigned gu32;
typedef GAS unsigned long long gu64;
#define RLX_AGENT __ATOMIC_RELAXED, __HIP_MEMORY_SCOPE_AGENT
#define LDS_WAIT() asm volatile("s_waitcnt lgkmcnt(0)" ::: "memory")
#define VM_WAIT() asm volatile("s_waitcnt vmcnt(0)" ::: "memory")
__device__ __forceinline__ unsigned long long rt() { return __builtin_amdgcn_s_memrealtime(); }
__device__ __forceinline__ unsigned f2bf(float f) { unsigned u = __builtin_bit_cast(unsigned, f); return (u + 0x7fffu + ((u >> 16) & 1u)) >> 16; }
__device__ __forceinline__ unsigned pk2(float lo, float hi) { return cvt_pk_bf16_rne(lo, hi); }

#define XB_TMO      128
#define XB_XCNT(j)  (256  + 64 * (j))
#define XB_XSUB(j)  (1280 + 64 * (j))
#define XB_XGEN(j)  (2304 + 64 * (j))
#define XB_TOP      3328
#define XB_TOPGEN   3392
#define XCD_BAR_WORDS 3456
#define XB_SPIN_CAP (1u << 18)

__device__ __forceinline__ unsigned xb_ld(unsigned* p)              { return __hip_atomic_load(p, __ATOMIC_RELAXED, __HIP_MEMORY_SCOPE_AGENT); }
__device__ __forceinline__ unsigned xb_add(unsigned* p, unsigned v) { return __hip_atomic_fetch_add(p, v, __ATOMIC_RELAXED, __HIP_MEMORY_SCOPE_AGENT); }
__device__ __forceinline__ unsigned xb_xcc_id() { return (unsigned)__builtin_amdgcn_s_getreg((3 << 11) | 20) & 0xFu; }
#define XB_SPIN(cond, bar) do { unsigned _sp = 0; while (cond) { __builtin_amdgcn_s_sleep(1); \
    if ((++_sp & 255u) == 0u) { if (xb_ld(&(bar)[XB_TMO])) break; if (_sp > XB_SPIN_CAP) { atomicAdd(&(bar)[XB_TMO], 1u); break; } } } } while (0)

struct XcdBarrier {
    unsigned* bar; unsigned x;
    volatile LAS unsigned* st;
};

__device__ __forceinline__ XcdBarrier xcd_barrier_post(unsigned* bar, volatile LAS unsigned* st) {
    XcdBarrier b; b.bar = bar; b.x = xb_xcc_id(); b.st = st;
    if (threadIdx.x == 0) (void)xb_add(&bar[XB_XCNT(b.x)], 1u);
    return b;
}
__device__ __forceinline__ void xcd_barrier_complete(unsigned* bar, unsigned x, unsigned& nloc, unsigned& nx) {
    const unsigned G = gridDim.x * gridDim.y * gridDim.z;
    unsigned sum, cnt, mine, sp = 0u;
    for (;;) {
        sum = 0u; cnt = 0u; mine = 0u;
#pragma unroll
        for (unsigned j = 0; j < 16; ++j) { const unsigned c = xb_ld(&bar[XB_XCNT(j)]); sum += c; cnt += (c > 0u) ? 1u : 0u; mine = (j == x) ? c : mine; }
        if (sum == G) break;
        __builtin_amdgcn_s_sleep(1);
        if ((++sp & 255u) == 0u) { if (xb_ld(&bar[XB_TMO])) break; if (sp > XB_SPIN_CAP) { atomicAdd(&bar[XB_TMO], 1u); break; } }
    }
    nloc = mine > 0u ? mine : 1u; nx = cnt > 0u ? cnt : 1u;
}

__device__ __forceinline__ void xcd_barrier(const XcdBarrier& b) {
    asm volatile("s_waitcnt vmcnt(0)" ::: "memory");
    __syncthreads();
    if (threadIdx.x == 0) {
        unsigned* bar = b.bar;
        __builtin_amdgcn_s_waitcnt(0);
        unsigned nloc = b.st[0], nx = b.st[1];
        if (nloc == 0u) { xcd_barrier_complete(bar, b.x, nloc, nx); b.st[0] = nloc; b.st[1] = nx; }
        const unsigned old = xb_add(&bar[XB_XSUB(b.x)], 1u);
        const unsigned gen = old / nloc;
        if (old + 1u == (gen + 1u) * nloc) {
            __builtin_amdgcn_fence(__ATOMIC_RELEASE, "agent");
            asm volatile("s_waitcnt vmcnt(0)" ::: "memory");
            const unsigned og = xb_add(&bar[XB_TOP], 1u);
            const unsigned tg = og / nx;
            if (og + 1u == (tg + 1u) * nx) xb_add(&bar[XB_TOPGEN], 1u);
            else XB_SPIN(xb_ld(&bar[XB_TOPGEN]) == tg, bar);
            __builtin_amdgcn_fence(__ATOMIC_ACQUIRE, "agent");
            asm volatile("s_waitcnt vmcnt(0)" ::: "memory");
        } else {
            XB_SPIN(xb_ld(&bar[XB_TOPGEN]) == gen, bar);
            __builtin_amdgcn_fence(__ATOMIC_ACQUIRE, "agent");
            asm volatile("s_waitcnt vmcnt(0)" ::: "memory");
        }
    }
    __syncthreads();
}
using pg8::MP; using pg8::MREAL; using pg8::NSAMP; using pg8::LPR; using pg8::SROW0;
constexpr int NWAVES = 8;
constexpr size_t MiB = 1u << 20;
constexpr size_t WS_CTL = 0, CTL_ZERO_BYTES = 1 * MiB;
constexpr int CW_BAR = 4096;
constexpr int CW_CNT = 12288;
constexpr int CW_FLAG = 16384;
constexpr size_t SSQ_OFF = 808 * MiB;
constexpr size_t WS_BIAS1 = 1 * MiB;
constexpr size_t WS_W1T = 2 * MiB, WS_WPCT = 84 * MiB, WS_WPAT = 92 * MiB, WS_WOT = 100 * MiB, WS_WUPT = 116 * MiB, WS_WDNT = 180 * MiB;
constexpr size_t WS_X = 212 * MiB, WS_XB = 280 * MiB, WS_Q = 314 * MiB, WS_K = 331 * MiB, WS_V = 348 * MiB, WS_P = 365 * MiB, WS_BC = 382 * MiB, WS_YC = 399 * MiB, WS_YA = 416 * MiB;
constexpr size_t WS_SGC = 433 * MiB, WS_SGA = 467 * MiB, WS_T1 = 501 * MiB, WS_MG = 569 * MiB, WS_U = 603 * MiB, WS_G = 739 * MiB, WS_LOGF = 807 * MiB, WS_PART = 814 * MiB, WS_CPART = 832 * MiB, WS_HALO = 838 * MiB, WS_PH = 858 * MiB, WS_END = 864 * MiB;
static_assert(WS_W1T + 2ull * 10496 * 2048 * 2 <= WS_WPCT && WS_WUPT + 2ull * 8192 * 2048 * 2 <= WS_WDNT && WS_WDNT + 2ull * 2048 * 4096 * 2 <= WS_X, "weight map");
static_assert(WS_X + (size_t)MP * 2048 * 4 <= WS_XB && WS_XB + (size_t)MP * 2048 * 2 <= WS_Q && WS_Q + (size_t)MP * 1024 * 2 <= WS_K && WS_T1 + (size_t)MP * 2048 * 4 <= WS_MG, "activation map");
static_assert(WS_U + (size_t)MP * 8192 * 2 <= WS_G && WS_G + (size_t)MP * 4096 * 2 <= WS_LOGF && WS_LOGF + (size_t)MP * 8 * 4 <= SSQ_OFF && SSQ_OFF + 5ull * MP * 32 * 4 <= WS_PART && WS_PART + 128ull * pa::PART_FLOATS * 4 <= WS_CPART && WS_CPART + 512ull * sa::PART_SLOT * 4 <= WS_HALO && WS_HALO + (size_t)pg8::HALO_SLOTS * 8192 * 4 <= WS_PH && WS_PH + (size_t)pg8::HALO_SLOTS * 2048 * 4 <= WS_END && (CW_FLAG + 2 * 128 * 64) * 4 <= (int)CTL_ZERO_BYTES, "map");
constexpr int RING_OFF = 0, RING_BYTES = 131072;
constexpr int LDS_BYTES = 147456, LDSCTL_OFF = 146944;
constexpr int RST_OFF = 131072;
constexpr int ATT_BIAS_OFF = 69632;
constexpr int SCAN_SCR_OFF = 103424;
constexpr int TR_PITCH = 65, TR_BYTES = 64 * TR_PITCH * 4;
static_assert(NWAVES * TR_BYTES <= LDSCTL_OFF && pa::LDS_ATT <= ATT_BIAS_OFF && ATT_BIAS_OFF + 8448 * 4 <= SCAN_SCR_OFF && sa::PART_OFF + 8 * sa::PART_STRIDE <= SCAN_SCR_OFF, "LDS map");
constexpr float LOG2E = 1.4426950408889634f;
constexpr int IDLE1 = 34 * 41 - 5 * 256, IDLE5 = 34 * 32 - 4 * 256;

struct Frame {
    LAS unsigned char* lds; volatile LAS unsigned* MISC; gu32* ctl;
    int wv, G, bx;
};
__device__ __forceinline__ int opaque_s(int v) { asm volatile("" : "+s"(v)); return v; }
__device__ __forceinline__ int lane_id() { return (int)__builtin_amdgcn_mbcnt_hi(~0u, __builtin_amdgcn_mbcnt_lo(~0u, 0u)); }
__device__ __forceinline__ int phase_tid(const Frame& F) { int t = F.wv * 64 + lane_id(); asm volatile("" : "+v"(t)); return t; }
struct MapIdent { __device__ __forceinline__ int operator()(int n) const { return n; } };
struct MapIn { __device__ __forceinline__ int operator()(int n) const {
    const int T = n >> 8, c = n & 255;
    if (T < 16) { const int bj = c >> 7, wc = (c >> 5) & 3, nn = (c >> 4) & 1, fq = (c >> 2) & 3, e = c & 3; return (bj * 2 + nn) * 1024 + 64 * T + 16 * wc + 4 * fq + e; }
    if (T < 24) return 4096 + ((T - 16) << 8) + c;
    if (T < 40) return 6152 + (c >> 7) * 2048 + 128 * (T - 24) + (c & 127);
    return c < 8 ? 6144 + c : -1; } };
struct MapUp { __device__ __forceinline__ int operator()(int n) const { const int T = n >> 8, c = n & 255; return (c >> 7) * 4096 + 128 * T + (c & 127); } };
struct TrItem { f32x4 v[16]; };
template <class Map>
__device__ __forceinline__ void tr_load(TrItem& T, const float* __restrict__ W, int Nsrc, int k0, int n0, int lane, Map map) {
    const int nloc = (lane & 15) * 4, src = map(n0 + nloc), kr = lane >> 4;
#pragma unroll
    for (int i = 0; i < 16; ++i) { const int kk = kr + 4 * i; T.v[i] = src >= 0 ? *(const GAS f32x4*)(W + (size_t)(k0 + kk) * Nsrc + src) : (f32x4){0.f, 0.f, 0.f, 0.f}; }
}
__device__ __forceinline__ void tr_store(const TrItem& T, int K  , const float* __restrict__ gsc, bf16* __restrict__ WT, int k0, int n0, LAS float* scr, int lane) {
    const int nloc = (lane & 15) * 4, kr = lane >> 4;
#pragma unroll
    for (int i = 0; i < 16; ++i) { const int kk = kr + 4 * i; const float g = gsc ? gsc[k0 + kk] : 1.0f; LAS float* s = scr + kk * TR_PITCH + nloc;
        s[0] = T.v[i][0] * g; s[1] = T.v[i][1] * g; s[2] = T.v[i][2] * g; s[3] = T.v[i][3] * g; }
    const int c = lane & 7;
#pragma unroll
    for (int j = 0; j < 8; ++j) { const int n = (lane >> 3) + 8 * j; const LAS float* s = scr + (8 * c) * TR_PITCH + n;
        v4u o; o.x = pk2(s[0 * TR_PITCH], s[1 * TR_PITCH]); o.y = pk2(s[2 * TR_PITCH], s[3 * TR_PITCH]); o.z = pk2(s[4 * TR_PITCH], s[5 * TR_PITCH]); o.w = pk2(s[6 * TR_PITCH], s[7 * TR_PITCH]);
        *(GAS v4u*)(WT + (size_t)(n0 + n) * K + k0 + 8 * c) = o; }
}
template <class Map>
__device__ __forceinline__ void transpose_matrix(Frame& F, const int vbx, const int vG, const float* W, int K, int Nsrc, int Ndst, const float* gsc, bf16* WT, Map map, int ldw = 0  ) {
    LAS float* scr = (LAS float*)(F.lds + F.wv * TR_BYTES); const int lane = phase_tid(F) & 63;
    const int nkb = K / 64, nnb = Ndst / 64, nsn = nnb >> 1, nst = (nkb >> 2) * nsn, G = vG, kbo = F.wv >> 1, nbo = F.wv & 1;
    if (vbx >= nst) return;
    const int pitch = ldw ? ldw : K;
    TrItem A, B;
#define TR_K0(st) ((4 * ((st) / nsn) + kbo) * 64)
#define TR_N0(st) ((2 * ((st) % nsn) + nbo) * 64)
    tr_load(A, W, Nsrc, TR_K0(vbx), TR_N0(vbx), lane, map);
    for (int st = vbx; st < nst; st += 2 * G) {
        const int s1 = st + G < nst ? st + G : st, s2 = st + 2 * G < nst ? st + 2 * G : s1;
        tr_load(B, W, Nsrc, TR_K0(s1), TR_N0(s1), lane, map);
        tr_store(A, pitch, gsc, WT, TR_K0(st), TR_N0(st), scr, lane);
        tr_load(A, W, Nsrc, TR_K0(s2), TR_N0(s2), lane, map);
        if (st + G < nst) tr_store(B, pitch, gsc, WT, TR_K0(s1), TR_N0(s1), scr, lane);
    }
#undef TR_K0
#undef TR_N0
}
typedef __attribute__((address_space(4))) const unsigned char* kptr_t;
__device__ __forceinline__ kptr_t kargs() { kptr_t p = (kptr_t)__builtin_amdgcn_kernarg_segment_ptr(); asm volatile("" : "+s"(p)); return p; }
#define ARG_IN(i) (*(const __attribute__((address_space(4))) float* const __attribute__((address_space(4)))*)(kargs() + 8 * (i)))
struct Args { const float* in[21]; float* out; unsigned char* ws; int pad0, pad1; };

__device__ __forceinline__ void phase_conv_yc(Frame& F, const bf16* P, const bf16* BC, bf16* YC, const float* wconv  , const float* state  ) {
    const int NT = F.G * NWAVES * 64, t0 = F.bx * NWAVES * 64 + phase_tid(F);
    for (int idx = t0; idx < MREAL * 128; idx += NT) {
        const int row = idx >> 7, c8 = (idx & 127) * 8;
        const v4u bcv = *(const GAS v4u*)(BC + (size_t)row * 1024 + c8), p0v = *(const GAS v4u*)(P + (size_t)row * 1024 + c8);
        float pm1[8], pm2[8];
        int t; const float* st = nullptr;
        if (row >= SROW0) { t = (row - SROW0) & 15; st = state + (size_t)((row - SROW0) >> 4) * 2048 + c8; } else { t = row; }
        if (t >= 1) { const v4u w = *(const GAS v4u*)(P + (size_t)(row - 1) * 1024 + c8);
#pragma unroll
            for (int e = 0; e < 4; ++e) { pm1[2 * e] = __uint_as_float(w[e] << 16); pm1[2 * e + 1] = __uint_as_float(w[e] & 0xffff0000u); } }
        else {
#pragma unroll
            for (int e = 0; e < 8; ++e) pm1[e] = st ? st[1024 + e] : 0.f; }
        if (t >= 2) { const v4u w = *(const GAS v4u*)(P + (size_t)(row - 2) * 1024 + c8);
#pragma unroll
            for (int e = 0; e < 4; ++e) { pm2[2 * e] = __uint_as_float(w[e] << 16); pm2[2 * e + 1] = __uint_as_float(w[e] & 0xffff0000u); } }
        else {
#pragma unroll
            for (int e = 0; e < 8; ++e) pm2[e] = st ? st[(t == 1 ? 1024 : 0) + e] : 0.f; }
        float y[8];
#pragma unroll
        for (int e = 0; e < 8; ++e) { const unsigned pw = p0v[e >> 1], bw = bcv[e >> 1];
            const float p0 = (e & 1) ? __uint_as_float(pw & 0xffff0000u) : __uint_as_float(pw << 16), bcf = (e & 1) ? __uint_as_float(bw & 0xffff0000u) : __uint_as_float(bw << 16);
            y[e] = bcf * (wconv[c8 + e] * pm2[e] + wconv[1024 + c8 + e] * pm1[e] + wconv[2048 + c8 + e] * p0); }
        v4u o; o.x = pk2(y[0], y[1]); o.y = pk2(y[2], y[3]); o.z = pk2(y[4], y[5]); o.w = pk2(y[6], y[7]);
        *(GAS v4u*)(YC + (size_t)row * 1024 + c8) = o;
    }
}
__device__ __forceinline__ void load_u8(float (&d)[8], const bf16* p) { const v4u w = *(const GAS v4u*)p;
#pragma unroll
    for (int e = 0; e < 4; ++e) { d[2 * e] = __uint_as_float(w[e] << 16); d[2 * e + 1] = __uint_as_float(w[e] & 0xffff0000u); } }
__device__ __forceinline__ void phase_ffn_gate(Frame& F, const bf16* U, bf16* Gb, const float* wf  , const float* bfc  , const float* state  ) {
    const int NT = F.G * NWAVES * 64, t0 = F.bx * NWAVES * 64 + phase_tid(F);
    for (int idx = t0; idx < MREAL * 512; idx += NT) {
        const int row = idx >> 9, ch = (idx & 511) * 8, ua = 256 * (ch >> 7) + (ch & 127);
        float a0[8], a1[8], a2[8], b0[8], b1[8], b2[8];
        load_u8(a0, U + (size_t)row * 8192 + ua); load_u8(b0, U + (size_t)row * 8192 + ua + 128);
        int t; const float* st = nullptr;
        if (row >= SROW0) { t = (row - SROW0) & 15; st = state + (size_t)((row - SROW0) >> 4) * 2 * 8192; } else { t = row; }
        if (t >= 1) { load_u8(a1, U + (size_t)(row - 1) * 8192 + ua); load_u8(b1, U + (size_t)(row - 1) * 8192 + ua + 128); }
        else {
#pragma unroll
            for (int e = 0; e < 8; ++e) { a1[e] = st ? st[8192 + ch + e] : 0.f; b1[e] = st ? st[8192 + 4096 + ch + e] : 0.f; } }
        if (t >= 2) { load_u8(a2, U + (size_t)(row - 2) * 8192 + ua); load_u8(b2, U + (size_t)(row - 2) * 8192 + ua + 128); }
        else { const int so = (t == 1) ? 8192 : 0;
#pragma unroll
            for (int e = 0; e < 8; ++e) { a2[e] = st ? st[so + ch + e] : 0.f; b2[e] = st ? st[so + 4096 + ch + e] : 0.f; } }
        float y[8];
        float w0a[8], w1a[8], w2a[8], bsa[8], w0b[8], w1b[8], w2b[8], bsb[8];
#define LD8(dst, p) do { const f32x4 q0_ = *(const GAS f32x4*)(p), q1_ = *(const GAS f32x4*)((p) + 4); dst[0] = q0_[0]; dst[1] = q0_[1]; dst[2] = q0_[2]; dst[3] = q0_[3]; dst[4] = q1_[0]; dst[5] = q1_[1]; dst[6] = q1_[2]; dst[7] = q1_[3]; } while (0)
        LD8(w0a, wf + ch); LD8(w1a, wf + 8192 + ch); LD8(w2a, wf + 16384 + ch); LD8(bsa, bfc + ch);
        LD8(w0b, wf + 4096 + ch); LD8(w1b, wf + 8192 + 4096 + ch); LD8(w2b, wf + 16384 + 4096 + ch); LD8(bsb, bfc + 4096 + ch);
#undef LD8
#pragma unroll
        for (int e = 0; e < 8; ++e) {
            const float A = w0a[e] * a2[e] + w1a[e] * a1[e] + w2a[e] * a0[e] + bsa[e];
            const float B = w0b[e] * b2[e] + w1b[e] * b1[e] + w2b[e] * b0[e] + bsb[e];
            y[e] = A * pg8::sigmoidf_(A) * B; }
        v4u o; o.x = pk2(y[0], y[1]); o.y = pk2(y[2], y[3]); o.z = pk2(y[4], y[5]); o.w = pk2(y[6], y[7]);
        *(GAS v4u*)(Gb + (size_t)row * 4096 + ch) = o;
    }
}
__device__ __forceinline__ void phase_yc_fixup(Frame& F, const float* PH, bf16* YC, const float* wconv  , const float* state  ) {
    const int NT = F.G * NWAVES * 64, t0 = F.bx * NWAVES * 64 + phase_tid(F);
    for (int idx = t0; idx < 290 * 128; idx += NT) {
        const int ri = idx >> 7, ch = (idx & 127) * 8;
        const int row = ri < 256 ? (ri >> 1) * 64 + (ri & 1) : 8192 + ((ri - 256) >> 1) * 16 + ((ri - 256) & 1);
        const float* u0 = PH + (size_t)pg8::halo_slot(row) * 2048; const float* u1 = nullptr; const float* u2 = nullptr;
        if (row < SROW0) { if (row >= 1) u1 = PH + (size_t)pg8::halo_slot(row - 1) * 2048; if (row >= 2) u2 = PH + (size_t)pg8::halo_slot(row - 2) * 2048; }
        else { const int t = (row - SROW0) & 15; const float* st = state + (size_t)((row - SROW0) >> 4) * 2048;
            if (t == 0) { u1 = st + 1024; u2 = st; } else { u1 = PH + (size_t)pg8::halo_slot(row - 1) * 2048; u2 = st + 1024; } }
        float y[8];
#pragma unroll
        for (int e = 0; e < 8; ++e) { const int c = ch + e; y[e] = u0[1024 + c] * (wconv[c] * (u2 ? u2[c] : 0.f) + wconv[1024 + c] * (u1 ? u1[c] : 0.f) + wconv[2048 + c] * u0[c]); }
        v4u o; o.x = pk2(y[0], y[1]); o.y = pk2(y[2], y[3]); o.z = pk2(y[4], y[5]); o.w = pk2(y[6], y[7]);
        *(GAS v4u*)(YC + (size_t)row * 2048 + ch) = o;
    }
}
__device__ __forceinline__ void phase_ffn_fixup(Frame& F, const float* HALO, bf16* Gb, const float* wf  , const float* bfc  , const float* state  ) {
    const int NT = F.G * NWAVES * 64, t0 = F.bx * NWAVES * 64 + phase_tid(F);
    for (int idx = t0; idx < 290 * 512; idx += NT) {
        const int ri = idx >> 9, ch = (idx & 511) * 8;
        const int row = ri < 256 ? (ri >> 1) * 64 + (ri & 1) : 8192 + ((ri - 256) >> 1) * 16 + ((ri - 256) & 1);
        const float* u0 = HALO + (size_t)pg8::halo_slot(row) * 8192; const float* u1 = nullptr; const float* u2 = nullptr;
        if (row < SROW0) { if (row >= 1) u1 = HALO + (size_t)pg8::halo_slot(row - 1) * 8192; if (row >= 2) u2 = HALO + (size_t)pg8::halo_slot(row - 2) * 8192; }
        else { const int t = (row - SROW0) & 15; const float* st = state + (size_t)((row - SROW0) >> 4) * 2 * 8192;
            if (t == 0) { u1 = st + 8192; u2 = st; } else { u1 = HALO + (size_t)pg8::halo_slot(row - 1) * 8192; u2 = st + 8192; } }
        float y[8];
#pragma unroll
        for (int e = 0; e < 8; ++e) { const int ca = ch + e, cb = 4096 + ch + e;
            const float A = wf[ca] * (u2 ? u2[ca] : 0.f) + wf[8192 + ca] * (u1 ? u1[ca] : 0.f) + wf[16384 + ca] * u0[ca] + bfc[ca];
            const float B = wf[cb] * (u2 ? u2[cb] : 0.f) + wf[8192 + cb] * (u1 ? u1[cb] : 0.f) + wf[16384 + cb] * u0[cb] + bfc[cb];
            y[e] = A * pg8::sigmoidf_(A) * B; }
        v4u o; o.x = pk2(y[0], y[1]); o.y = pk2(y[2], y[3]); o.z = pk2(y[4], y[5]); o.w = pk2(y[6], y[7]);
        *(GAS v4u*)(Gb + (size_t)row * 4096 + ch) = o;
    }
}
template <int CH>
__device__ __forceinline__ void block_cumsum(const float* src, int stride, int n, float* dst, float* wtot, float scale, bool subT, int tid) {
    asm volatile("" : "+v"(tid));
    const int lane = tid & 63, wid = tid >> 6, i0 = tid * CH;
    float v[CH]; float run = 0.f;
#pragma unroll
    for (int j = 0; j < CH; ++j) { const int i = i0 + j; const float x = i < n ? src[(size_t)i * stride] : 0.f; run += x; v[j] = run; }
    const float inc = xl::wave_incl_scan(run, lane);
    if (lane == 63) wtot[wid] = inc;
    __syncthreads();
    float off = inc - run, tot = 0.f;
#pragma unroll
    for (int w = 0; w < 8; ++w) { const float x = wtot[w]; if (w < wid) off += x; tot += x; }
    const float sub = subT ? tot : 0.f;
#pragma unroll
    for (int j = 0; j < CH; ++j) if (i0 + j < n) dst[i0 + j] = scale * (off + v[j] - sub);
    __syncthreads();
}

__device__ __forceinline__ void unpack8(float (&d)[8], const v4u w) {
#pragma unroll
    for (int e = 0; e < 4; ++e) { d[2 * e] = __uint_as_float(w[e] << 16); d[2 * e + 1] = __uint_as_float(w[e] & 0xffff0000u); } }
__device__ __forceinline__ void skinny_merged(Frame& F, const bf16* YCA, const bf16* WCA, const bf16* RG, const unsigned char* SGA, bf16* MG, unsigned char* lds) {
    if (F.bx >= 160) return;
    const int rg = F.bx >> 5, n0 = (F.bx & 31) * 64, tid = phase_tid(F), row = sk::ROW0 + 64 * rg + (tid >> 3), col = n0 + (tid & 7) * 8;
    f32x4 a0, a1, b0, b1;
    sk::job(YCA, WCA, 1024, 2048, rg, n0, (char*)lds, F.wv, a0, a1);
    sk::job(YCA + 1024, WCA + 1024, 1024, 2048, rg, n0, (char*)lds, F.wv, b0, b1);
    if (row >= MREAL) return;
    float r[8], ga[8]; unpack8(r, *(const GAS v4u*)(RG + (size_t)row * 2048 + col));
    { const pg8::u32x2 gq = *(const GAS pg8::u32x2*)(SGA + (size_t)row * 2048 + col);
#pragma unroll
      for (int e = 0; e < 4; ++e) { ga[e] = (float)((gq.x >> (8 * e)) & 255u) * (1.0f / 255.0f); ga[4 + e] = (float)((gq.y >> (8 * e)) & 255u) * (1.0f / 255.0f); } }
    v4u o; o.x = pk2(ga[0] * (r[0] * a0[0] + b0[0]), ga[1] * (r[1] * a0[1] + b0[1])); o.y = pk2(ga[2] * (r[2] * a0[2] + b0[2]), ga[3] * (r[3] * a0[3] + b0[3]));
    o.z = pk2(ga[4] * (r[4] * a1[0] + b1[0]), ga[5] * (r[5] * a1[1] + b1[1])); o.w = pk2(ga[6] * (r[6] * a1[2] + b1[2]), ga[7] * (r[7] * a1[3] + b1[3]));
    *(GAS v4u*)(MG + (size_t)row * 2048 + col) = o;
}
__device__ __forceinline__ void skinny_res(Frame& F, const bf16* A, const bf16* Bt, int K, bf16* XB, float* ssq_next, unsigned char* lds) {
    if (F.bx >= 160) return;
    const int rg = F.bx >> 5, n0 = (F.bx & 31) * 64, tid = phase_tid(F), row = sk::ROW0 + 64 * rg + (tid >> 3), col = n0 + (tid & 7) * 8;
    f32x4 a0, a1;
    sk::job(A, Bt, K, K, rg, n0, (char*)lds, F.wv, a0, a1);
    if (row >= MREAL) return;
    float xo[8]; unpack8(xo, *(const GAS v4u*)(XB + (size_t)row * 2048 + col));
    const f32x4 x0 = (f32x4){xo[0], xo[1], xo[2], xo[3]} + a0, x1 = (f32x4){xo[4], xo[5], xo[6], xo[7]} + a1;
    v4u o; o.x = pk2(x0[0], x0[1]); o.y = pk2(x0[2], x0[3]); o.z = pk2(x1[0], x1[1]); o.w = pk2(x1[2], x1[3]);
    *(GAS v4u*)(XB + (size_t)row * 2048 + col) = o;
    float s = ((x0[0] * x0[0] + x0[1] * x0[1]) + (x0[2] * x0[2] + x0[3] * x0[3])) + ((x1[0] * x1[0] + x1[1] * x1[1]) + (x1[2] * x1[2] + x1[3] * x1[3]));
    s += xl::xor1(s); s += __int_as_float(__builtin_amdgcn_update_dpp(0, __float_as_int(s), 0x4E, 0xf, 0xf, true)); s += xl::row_shr<4>(s);
    if ((tid & 7) == 7) ssq_next[(size_t)row * 32 + (n0 >> 6)] = s;
}
__device__ __forceinline__ void part_arrive2(Frame& F, gu32* cnt_a, unsigned na, gu32* cnt_b, unsigned nb, bool& last_a, bool& last_b) {
    asm volatile("s_waitcnt vmcnt(0)" ::: "memory");
    __syncthreads();
    const int t = phase_tid(F);
    if (t < 2) F.MISC[12 + t] = __hip_atomic_fetch_add((unsigned*)(t == 0 ? cnt_a : cnt_b), 1u, __ATOMIC_RELAXED, __HIP_MEMORY_SCOPE_AGENT);
    __syncthreads();
    const unsigned oa = F.MISC[12], ob = F.MISC[13];
    __syncthreads();
    last_a = oa + 1u == na; last_b = ob + 1u == nb;
}
#define GRID_BAR() do { XcdBarrier b_ = bar; asm volatile("" : "+s"(b_.bar), "+s"(b_.x)); xcd_barrier(b_); } while (0)
#ifndef REP_PR
#define REP_PR 1
#endif
#ifndef REP_CH
#define REP_CH 1
#endif
#ifndef REP_CHS
#define REP_CHS 1
#endif
#ifndef REP_CHT
#define REP_CHT 1
#endif
#ifndef REP_P0
#define REP_P0 1
#endif
#ifndef REP_G1
#define REP_G1 1
#endif
#ifndef REP_ATT
#define REP_ATT 1
#endif
#ifndef REP_G4
#define REP_G4 1
#endif
#ifndef REP_E4
#define REP_E4 1
#endif
#ifndef REP_G2
#define REP_G2 1
#endif
#ifndef STOP_AFTER
#define STOP_AFTER 0
#endif
__device__ __forceinline__ void diag_dump(int k, int t0, int NT, float* out, unsigned char* ws) {
    const bf16* a = nullptr; const bf16* b = nullptr; const float* x = nullptr; int lda = 1024;
    if (k == 1) { a = (const bf16*)(ws + WS_Q); b = (const bf16*)(ws + WS_P); }
    else if (k == 2) { a = (const bf16*)(ws + WS_YA); b = (const bf16*)(ws + WS_YC); }
#if defined(DIAG_SEL) && DIAG_SEL == 1
    else if (k == 3) { const bf16* w = (const bf16*)(ws + WS_WPCT); const bf16* s = (const bf16*)(ws + WS_SGC);
        for (int i = t0; i < 4 * 1024 * 1024; i += NT) out[i] = __uint_as_float((unsigned)w[i] << 16);
        for (int i = t0; i < 6000 * 2048; i += NT) out[4 * 1024 * 1024 + i] = __uint_as_float((unsigned)s[i] << 16);
        return; }
#elif defined(DIAG_SEL) && DIAG_SEL == 2
    else if (k == 3) { const bf16* w = (const bf16*)(ws + WS_WPCT);
        for (int i = t0; i < 16 * 1024 * 1024; i += NT) out[i] = __uint_as_float((unsigned)w[i] << 16);
        return; }
#else
    else if (k == 3) { x = (const float*)(ws + WS_T1); }
#endif
    else if (k == 4) { a = (const bf16*)(ws + WS_MG); lda = 2048; }
    else if (k == 5 || k == 8) { x = (const float*)(ws + WS_X); }
    else if (k == 6) { a = (const bf16*)(ws + WS_U); lda = 8192; }
    else if (k == 7) { a = (const bf16*)(ws + WS_G); lda = 4096; }
    if (x) { for (int i = t0; i < 8192 * 2048; i += NT) out[i] = x[i]; return; }
    if (b) { for (int i = t0; i < 8192 * 1024; i += NT) { out[i] = __uint_as_float((unsigned)a[i] << 16); out[8192 * 1024 + i] = __uint_as_float((unsigned)b[i] << 16); } return; }
    for (int i = t0; i < 8192 * 2048; i += NT) { const int r = i / 2048, c = i % 2048; out[i] = __uint_as_float((unsigned)a[(size_t)r * lda + c] << 16); }
}
#define STOP_AT(k) do { if (STOP_AFTER != 0 && STOP_AFTER == 10 * l + (k)) { diag_dump(k, F.bx * NWAVES * 64 + phase_tid(F), F.G * NWAVES * 64, KOUT(), KWS()); return; } } while (0)
#define KARG_U64(off) (*(const __attribute__((address_space(4))) unsigned long long*)(kargs() + (off)))
#define KIN(i)  ((const float*)(const GAS float*)KARG_U64(8 * (i)))
#define KOUT()  ((float*)(GAS float*)KARG_U64(168))
#define KWS()   ((unsigned char*)(GAS unsigned char*)KARG_U64(176))
#define WSP(T, off) ((T*)(KWS() + (off)))
__global__ void __launch_bounds__(NWAVES * 64, 2) fwd_kernel(Args args) {
    extern __shared__ __attribute__((aligned(16))) unsigned char lds[];
    Frame F;
    F.lds = (LAS unsigned char*)lds; F.MISC = (volatile LAS unsigned*)(F.lds + LDSCTL_OFF);
    F.wv = __builtin_amdgcn_readfirstlane((int)threadIdx.x >> 6); F.G = gridDim.x; F.bx = blockIdx.x;
    F.ctl = (gu32*)(KWS() + WS_CTL);
    for (int u = threadIdx.x; u < (LDS_BYTES - LDSCTL_OFF) / 4; u += NWAVES * 64) ((LAS unsigned*)(F.lds + LDSCTL_OFF))[u] = 0u;
    __syncthreads();
    XcdBarrier bar = xcd_barrier_post((unsigned*)(F.ctl + CW_BAR), F.MISC + 8);

#ifndef SKIP_P0
    for (int rep_ = 0; rep_ < REP_P0; ++rep_) {
    transpose_matrix(F, F.bx, F.G, KIN(9), 2048, 10248, 10496, KIN(8), WSP(bf16, WS_W1T), MapIn());
    { const int NT = F.G * NWAVES * 64; MapIn mp; const float* b_in = KIN(10); float* BIAS1 = WSP(float, WS_BIAS1);
      for (int i = F.bx * NWAVES * 64 + phase_tid(F); i < 2 * 10496; i += NT) { const int l = i / 10496, n = i % 10496, s = mp(n); BIAS1[i] = s >= 0 ? b_in[l * 10248 + s] : 0.f; } }
    {   const int NGW = F.G * NWAVES, gw = NGW - 1 - (F.bx * NWAVES + F.wv), lane = phase_tid(F) & 63;
        const float* xs = KIN(1); const float* xm = KIN(7); const float* xp = KIN(0); bf16* XB = WSP(bf16, WS_XB); float* SSQ = WSP(float, SSQ_OFF);
        for (int m0 = gw; m0 < MP; m0 += 2 * NGW) {
            f32x4 v[2][8];
#pragma unroll
            for (int r = 0; r < 2; ++r) { const int m = m0 + r * NGW; const float* src = nullptr;
                if (m < 16) src = xm + (size_t)m * 2048; else if (m < LPR) src = xp + (size_t)(m - 16) * 2048; else if (m < MREAL) src = xs + (size_t)(m - SROW0) * 2048;
#pragma unroll
                for (int j = 0; j < 8; ++j) v[r][j] = src ? *(const GAS f32x4*)(src + 256 * j + 4 * lane) : (f32x4){0.f, 0.f, 0.f, 0.f}; }
#pragma unroll
            for (int r = 0; r < 2; ++r) { const int m = m0 + r * NGW; if (m >= MP) break; float s = 0.f;
#pragma unroll
                for (int j = 0; j < 8; ++j) { const f32x4 w = v[r][j];
                    *(GAS unsigned long long*)(XB + (size_t)m * 2048 + 256 * j + 4 * lane) = (unsigned long long)pk2(w[0], w[1]) | ((unsigned long long)pk2(w[2], w[3]) << 32);
                    s += (w[0] * w[0] + w[1] * w[1]) + (w[2] * w[2] + w[3] * w[3]); }
                s = xl::wave_sum(s); if (lane < 32) SSQ[(size_t)m * 32 + lane] = lane == 0 ? s : 0.f; }
        }
    }
    }
#endif
    GRID_BAR();

#pragma unroll 1
    for (int l = 0; l < 2; ++l) {
#ifndef SKIP_G1
        for (int rep_ = 0; rep_ < REP_G1; ++rep_) {
        {   pg8::Gemm g{WSP(bf16, WS_XB), WSP(bf16, WS_W1T) + (size_t)l * 10496 * 2048, MP, 10496, 2048}; pg8::StaticOrder S; S.init(MP, 10496, opaque_s(F.G), opaque_s(F.bx));
            pg8::EpiIn E{WSP(float, SSQ_OFF) + (size_t)(2 * l) * MP * 32, WSP(float, WS_BIAS1) + l * 10496, WSP(bf16, WS_YC), WSP(float, WS_PH), KIN(11) + l * 3072, WSP(bf16, WS_Q), WSP(bf16, WS_K), WSP(bf16, WS_V), WSP(bf16, WS_SGC), WSP(unsigned char, WS_SGA), WSP(float, WS_LOGF), KOUT(), l, (LAS float*)(F.lds + RST_OFF)};
            pg8::gemm_phase<pg8::EpiIn, pg8::StaticOrder, true, true>(F.lds + RING_OFF, g, S, E, F.wv); }
        if (F.bx >= IDLE1) {
            const int vb = F.bx - IDLE1, vg = F.G - IDLE1;
            if (l == 0) {
                transpose_matrix(F, vb, vg, KIN(12), 1024, 2048, 2048, nullptr, WSP(bf16, WS_WPCT), MapIdent(), 2048);
                transpose_matrix(F, vb, vg, KIN(13), 1024, 2048, 2048, nullptr, WSP(bf16, WS_WPCT) + 1024, MapIdent(), 2048);
                transpose_matrix(F, vb, vg, KIN(14), 2048, 2048, 2048, nullptr, WSP(bf16, WS_WOT), MapIdent()); }
            transpose_matrix(F, vb, vg, KIN(16) + (size_t)l * 2048 * 8192, 2048, 8192, 8192, KIN(15) + l * 2048, WSP(bf16, WS_WUPT) + (size_t)l * 8192 * 2048, MapUp());
            transpose_matrix(F, vb, vg, KIN(19) + (size_t)l * 4096 * 2048, 4096, 2048, 2048, nullptr, WSP(bf16, WS_WDNT) + (size_t)l * 2048 * 4096, MapIdent()); }
        if (rep_ + 1 < REP_G1) GRID_BAR();
        }
#endif
        GRID_BAR();
        STOP_AT(1);
        for (int rep_ = 0; rep_ < REP_ATT; ++rep_) {
#ifndef SKIP_CONV
        phase_yc_fixup(F, WSP(float, WS_PH), WSP(bf16, WS_YC), KIN(11) + l * 3072, KIN(5) + (size_t)l * 16 * 2048);
#endif
        {
            const int c_ = F.bx & 255;
#pragma unroll 1
            for (int step = 0; step < 2; ++step) {
                const bool do_chunk = (((c_ >> 3) & 1) != 0) == (step == 0);
                if (!do_chunk) {
#ifndef SKIP_PA
        for (int rpr_ = 0; rpr_ < REP_PR; ++rpr_)
        {
            float* bias = (float*)(lds + ATT_BIAS_OFF); float* wtot = (float*)(lds + SCAN_SCR_OFF);
            const bf16* Qb = WSP(bf16, WS_Q); bf16* YA = WSP(bf16, WS_YC) + 1024; const float* LOGF = WSP(float, WS_LOGF);
            const int c = F.bx & 255, h = c & 7, j = (c >> 3) >> 1, s = (c >> 3) & 1, cj = 62 - 4 * j, qbB = 31 - j;
            const bf16* Kp = WSP(bf16, WS_K) + h * 128; const bf16* Vp = WSP(bf16, WS_V) + h * 128;
            float* part = WSP(float, WS_PART) + (size_t)(h * 16 + j) * pa::PART_FLOATS; unsigned* flag = (unsigned*)(F.ctl + CW_FLAG) + (l * 128 + h * 16 + j) * 64;
            if (F.bx < 256) {
                const int nmax = 64 * (s ? (128 - 4 * j) : (4 * j + 4 > cj ? 4 * j + 4 : cj));
                block_cumsum<16>(LOGF + (size_t)h * MP, 1, nmax, bias, wtot, -1.0f / pa::SCALE, false, phase_tid(F));
                const pa::BlockRef bA{Qb + (size_t)(256 * j) * 1024 + h * 128, Kp, Vp, YA + (size_t)(256 * j) * 2048 + h * 128, 256 * j, 0, 4 * j + 4, 0, nullptr, nullptr};
                const pa::BlockRef bB{Qb + (size_t)(256 * qbB) * 1024 + h * 128, Kp, Vp, YA + (size_t)(256 * qbB) * 2048 + h * 128, 256 * qbB, s ? cj : 0, s ? 128 - 4 * j : cj, s ? 2 : 1, part, flag};
                pa::Seam S;
                if (s == 0) { pa::prime(bA, (char*)lds, S, F.wv); pa::block(bA, bB, (char*)lds, bias, S, F.wv); pa::block(bB, bB, (char*)lds, bias, S, F.wv); }
                else { pa::prime(bB, (char*)lds, S, F.wv); pa::block(bB, bB, (char*)lds, bias, S, F.wv); }
            }
            asm volatile("s_waitcnt vmcnt(0)" ::: "memory"); __syncthreads();
        }
#endif
                } else {
#ifndef SKIP_SA
        for (int rch_ = 0; rch_ < REP_CH; ++rch_)
        {
            float* bias = (float*)lds; float* wtot = (float*)(lds + SCAN_SCR_OFF);
            const float* LOGF = WSP(float, WS_LOGF); float* out = KOUT(); float* slots = WSP(float, WS_CPART);
            if (F.bx < 256) {
                for (int rs_ = 0; rs_ < REP_CHS; ++rs_)
                {   const int item = c_ >> 1, part = c_ & 1, b = item >> 3, h = item & 7; sa::Item it;
                    block_cumsum<8>(KIN(4) + ((size_t)(l * 16 + b) * 4096) * 8 + h, 8, 4096, bias, wtot, -LOG2E, true, phase_tid(F));
                    { const int t_ = phase_tid(F); if (t_ < 64) { const float x = t_ < 16 ? LOGF[(size_t)h * MP + SROW0 + b * 16 + t_] : 0.f; const float inc = xl::wave_incl_scan(x, t_); if (t_ < 16) bias[4096 + t_] = -LOG2E * inc; } }
                    __syncthreads();
                    const size_t cb = ((size_t)(l * 16 + b) * 4096) * 1024 + h * 128;
                    it.Kc = KIN(2) + cb; it.Vc = KIN(3) + cb; it.nk = 4096;
                    it.Kn = out + pg8::OFF_KS + ((size_t)l * 256 + b * 16) * 1024 + h * 128; it.Vn = out + pg8::OFF_VS + ((size_t)l * 256 + b * 16) * 1024 + h * 128;
                    it.Q = WSP(bf16, WS_Q) + (size_t)(SROW0 + b * 16) * 1024 + h * 128; it.O = nullptr;
                    sa::run_part(it, part * 128, part * 128 + 128, part == 1, slots + (size_t)(256 + 2 * item + part) * sa::PART_SLOT, (char*)lds, F.wv); }
                for (int rt_ = 0; rt_ < REP_CHT; ++rt_)
                {   const int h = c_ >> 5, part = c_ & 31; sa::Item it;
                    block_cumsum<17>(LOGF + (size_t)h * MP, 1, LPR, bias, wtot, -LOG2E, false, phase_tid(F));
                    const size_t kb = ((size_t)l * LPR) * 1024 + h * 128;
                    it.Kc = out + pg8::OFF_KP + kb; it.Vc = out + pg8::OFF_VP + kb; it.nk = 8192; it.Kn = it.Kc + (size_t)8192 * 1024; it.Vn = it.Vc + (size_t)8192 * 1024;
                    it.Q = WSP(bf16, WS_Q) + (size_t)8192 * 1024 + h * 128; it.O = nullptr;
                    sa::run_part(it, part * 16, part * 16 + 16, part == 31, slots + (size_t)(h * 32 + part) * sa::PART_SLOT, (char*)lds, F.wv); }
                {   const int item = c_ >> 1, b = item >> 3, hs = item & 7, ht = c_ >> 5, lane = phase_tid(F) & 63; bool last_s, last_t;
                    part_arrive2(F, F.ctl + CW_CNT + l * 136 + item, 2u, F.ctl + CW_CNT + l * 136 + 128 + ht, 32u, last_s, last_t);
                    if (last_s)
                        for (int q = 2 * F.wv; q < 2 * F.wv + 2; ++q) sa::combine_row<2>(slots + (size_t)(256 + 2 * item) * sa::PART_SLOT, q, WSP(bf16, WS_YC) + (size_t)(SROW0 + b * 16 + q) * 2048 + 1024 + hs * 128, lane);
                    if (last_t)
                        for (int q = 2 * F.wv; q < 2 * F.wv + 2; ++q) sa::combine_row<32>(slots + (size_t)(ht * 32) * sa::PART_SLOT, q, WSP(bf16, WS_YC) + (size_t)(8192 + q) * 2048 + 1024 + ht * 128, lane); }
            }
        }
#endif
                }
            }
        }
        if (rep_ + 1 < REP_ATT) GRID_BAR();
        }
        GRID_BAR();
        STOP_AT(2);
#ifndef SKIP_G2
        {   pg8::Gemm g{WSP(bf16, WS_YC), WSP(bf16, WS_WPCT) + (size_t)l * 2048 * 2048, 8192, 2048, 2048}; pg8::StaticOrder S; S.init(8192, 2048, opaque_s(F.G), opaque_s(F.bx));
            pg8::EpiGateK E{WSP(bf16, WS_SGC), WSP(unsigned char, WS_SGA), WSP(bf16, WS_MG)}; pg8::gemm_phase<pg8::EpiGateK, pg8::StaticOrder, true, true, true>(F.lds + RING_OFF, g, S, E, F.wv); }
        skinny_merged(F, WSP(bf16, WS_YC), WSP(bf16, WS_WPCT) + (size_t)l * 2048 * 2048, WSP(bf16, WS_SGC), WSP(unsigned char, WS_SGA), WSP(bf16, WS_MG), lds);
        GRID_BAR();
        STOP_AT(4);
#endif
#ifndef SKIP_G3
        {   pg8::Gemm g{WSP(bf16, WS_MG), WSP(bf16, WS_WOT) + (size_t)l * 2048 * 2048, 8192, 2048, 2048}; pg8::StaticOrder S; S.init(8192, 2048, opaque_s(F.G), opaque_s(F.bx));
            pg8::EpiRes E{WSP(bf16, WS_XB), WSP(float, SSQ_OFF) + (size_t)(2 * l + 1) * MP * 32}; pg8::gemm_phase<pg8::EpiRes, pg8::StaticOrder, true, true>(F.lds + RING_OFF, g, S, E, F.wv); }
        skinny_res(F, WSP(bf16, WS_MG), WSP(bf16, WS_WOT) + (size_t)l * 2048 * 2048, 2048, WSP(bf16, WS_XB), WSP(float, SSQ_OFF) + (size_t)(2 * l + 1) * MP * 32, lds);
        GRID_BAR();
        STOP_AT(5);
#endif
#ifndef SKIP_G4
        for (int rep_ = 0; rep_ < REP_G4; ++rep_) {
        {   pg8::Gemm g{WSP(bf16, WS_XB), WSP(bf16, WS_WUPT) + (size_t)l * 8192 * 2048, MP, 8192, 2048}; pg8::StaticOrder S; S.init(MP, 8192, opaque_s(F.G), opaque_s(F.bx));
            pg8::EpiUpConv E{WSP(float, SSQ_OFF) + (size_t)(2 * l + 1) * MP * 32, WSP(bf16, WS_G), WSP(float, WS_HALO), KIN(17) + (size_t)l * 3 * 8192, KIN(18) + l * 8192, KOUT(), l, (LAS float*)(F.lds + RST_OFF)}; pg8::gemm_phase<pg8::EpiUpConv, pg8::StaticOrder, true, true>(F.lds + RING_OFF, g, S, E, F.wv); }
        if (l == 0 && F.bx >= IDLE5) {
            const int vb = F.bx - IDLE5, vg = F.G - IDLE5;
            transpose_matrix(F, vb, vg, KIN(9) + (size_t)2048 * 10248, 2048, 10248, 10496, KIN(8) + 2048, WSP(bf16, WS_W1T) + (size_t)10496 * 2048, MapIn());
            transpose_matrix(F, vb, vg, KIN(12) + (size_t)1024 * 2048, 1024, 2048, 2048, nullptr, WSP(bf16, WS_WPCT) + (size_t)2048 * 2048, MapIdent(), 2048);
            transpose_matrix(F, vb, vg, KIN(13) + (size_t)1024 * 2048, 1024, 2048, 2048, nullptr, WSP(bf16, WS_WPCT) + (size_t)2048 * 2048 + 1024, MapIdent(), 2048);
            transpose_matrix(F, vb, vg, KIN(14) + (size_t)2048 * 2048, 2048, 2048, 2048, nullptr, WSP(bf16, WS_WOT) + (size_t)2048 * 2048, MapIdent()); }
        GRID_BAR();
        STOP_AT(6);
        if (rep_ + 1 < REP_G4) GRID_BAR();
        }
#endif
#ifndef SKIP_E4
        for (int rep_ = 0; rep_ < REP_E4; ++rep_) {
        phase_ffn_fixup(F, WSP(float, WS_HALO), WSP(bf16, WS_G), KIN(17) + (size_t)l * 3 * 8192, KIN(18) + l * 8192, KIN(6) + (size_t)l * 16 * 2 * 8192);
        GRID_BAR();
        STOP_AT(7);
        if (rep_ + 1 < REP_E4) GRID_BAR();
        }
#endif
#ifndef SKIP_G5
        {   pg8::Gemm g{WSP(bf16, WS_G), WSP(bf16, WS_WDNT) + (size_t)l * 2048 * 4096, 8192, 2048, 4096}; pg8::StaticOrder S; S.init(8192, 2048, opaque_s(F.G), opaque_s(F.bx));
            pg8::EpiRes E{WSP(bf16, WS_XB), WSP(float, SSQ_OFF) + (size_t)(2 * l + 2) * MP * 32}; pg8::gemm_phase<pg8::EpiRes, pg8::StaticOrder, true, true>(F.lds + RING_OFF, g, S, E, F.wv); }
        skinny_res(F, WSP(bf16, WS_G), WSP(bf16, WS_WDNT) + (size_t)l * 2048 * 4096, 4096, WSP(bf16, WS_XB), WSP(float, SSQ_OFF) + (size_t)(2 * l + 2) * MP * 32, lds);
        GRID_BAR();
        STOP_AT(8);
#endif
    }
    {   const int gw = F.bx * NWAVES + F.wv, NGW = F.G * NWAVES, lane = phase_tid(F) & 63; float* out = KOUT(); const bf16* XB = WSP(bf16, WS_XB); const float* SSQ = WSP(float, SSQ_OFF); const float* gf = KIN(20);
        for (int m0 = gw; m0 < MREAL; m0 += 2 * NGW) {
            pg8::u32x2 xv[2][8]; float part[2];
#pragma unroll
            for (int r = 0; r < 2; ++r) { const int m = (m0 + r * NGW < MREAL) ? m0 + r * NGW : m0;
                part[r] = lane < 32 ? SSQ[(size_t)4 * MP * 32 + (size_t)m * 32 + lane] : 0.f;
#pragma unroll
                for (int j = 0; j < 8; ++j) xv[r][j] = *(const GAS pg8::u32x2*)(XB + (size_t)m * 2048 + 256 * j + 4 * lane); }
#pragma unroll
            for (int r = 0; r < 2; ++r) { const int m = m0 + r * NGW; if (m >= MREAL) break;
                float* o; if (m >= SROW0) o = out + pg8::OFF_YS + (size_t)(m - SROW0) * 2048; else if (m >= 16) o = out + pg8::OFF_YP + (size_t)(m - 16) * 2048; else continue;
                const float rs = 1.0f / sqrtf(xl::wave_sum(part[r]) * (1.0f / 2048.0f) + pg8::RMS_EPS);
#pragma unroll
                for (int j = 0; j < 8; ++j) { const f32x4 v = pg8::unpk4(xv[r][j]), gg = *(const GAS f32x4*)(gf + 256 * j + 4 * lane);
                    *(GAS f32x4*)(o + 256 * j + 4 * lane) = v * rs * gg; } }
        }
    }
}

extern "C" void kernel_launch(void* const* d_in, const int* in_sizes, int n_in, void* d_out, int out_size, void* d_ws, size_t ws_size, hipStream_t stream) {
    static int grid = 0;
    if (grid == 0) {
        if (n_in != 21 || out_size != (int)pg8::OUT_TOTAL || ws_size < WS_END) { fprintf(stderr, "kernel_launch: unexpected shapes: n_in %d out %d ws %zu\n", n_in, out_size, ws_size); grid = -1; return; }
        int dev = 0, cus = 0, per_cu = 0;
        if (hipGetDevice(&dev) != hipSuccess || hipDeviceGetAttribute(&cus, hipDeviceAttributeMultiprocessorCount, dev) != hipSuccess) { grid = -1; return; }
        if (hipFuncSetAttribute((const void*)fwd_kernel, hipFuncAttributeMaxDynamicSharedMemorySize, LDS_BYTES) != hipSuccess) { fprintf(stderr, "kernel_launch: hipFuncSetAttribute failed\n"); grid = -1; return; }
        if (hipOccupancyMaxActiveBlocksPerMultiprocessor(&per_cu, (const void*)fwd_kernel, NWAVES * 64, LDS_BYTES) != hipSuccess || per_cu < 1) fprintf(stderr, "kernel_launch: occupancy query reports %d\n", per_cu);
        (void)hipGetLastError();
        grid = cus;
    }
    if (grid < 0) return;
    (void)hipMemsetAsync((char*)d_ws + WS_CTL, 0, CTL_ZERO_BYTES, stream);
    Args a{};
    for (int i = 0; i < 21; ++i) a.in[i] = (const float*)d_in[i];
    a.out = (float*)d_out; a.ws = (unsigned char*)d_ws;
    hipLaunchKernelGGL(fwd_kernel, dim3(grid), dim3(NWAVES * 64), LDS_BYTES, stream, a);
    const hipError_t le = hipPeekAtLastError();
    if (le != hipSuccess) fprintf(stderr, "kernel_launch: launch failed: %s\n", hipGetErrorName(le));
}
```

```cpp
#include <hip/hip_runtime.h>
#include <cstdio>
#include <cstdint>
typedef float f32x2_cv __attribute__((ext_vector_type(2))); typedef __bf16 bf16x2_cv __attribute__((ext_vector_type(2)));
__device__ __forceinline__ unsigned cvt_pk_bf16_rne(float lo, float hi) { const f32x2_cv v = {lo, hi}; const bf16x2_cv b = __builtin_convertvector(v, bf16x2_cv); return __builtin_bit_cast(unsigned, b); }
namespace xl {
typedef unsigned u32x2_t __attribute__((ext_vector_type(2)));
__device__ __forceinline__ float sum_xor32(float v) { const auto r = __builtin_amdgcn_permlane32_swap(__float_as_uint(v), __float_as_uint(v), false, false); return __uint_as_float(r[0]) + __uint_as_float(r[1]); }
__device__ __forceinline__ float sum_xor16(float v) { const auto r = __builtin_amdgcn_permlane16_swap(__float_as_uint(v), __float_as_uint(v), false, false); return __uint_as_float(r[0]) + __uint_as_float(r[1]); }
__device__ __forceinline__ float max_xor32(float v) { const auto r = __builtin_amdgcn_permlane32_swap(__float_as_uint(v), __float_as_uint(v), false, false); return fmaxf(__uint_as_float(r[0]), __uint_as_float(r[1])); }
__device__ __forceinline__ float max_xor16(float v) { const auto r = __builtin_amdgcn_permlane16_swap(__float_as_uint(v), __float_as_uint(v), false, false); return fmaxf(__uint_as_float(r[0]), __uint_as_float(r[1])); }
__device__ __forceinline__ float xor1(float v) { return __int_as_float(__builtin_amdgcn_update_dpp(0, __float_as_int(v), 0xB1, 0xf, 0xf, true)); }
template <int N> __device__ __forceinline__ float row_shr(float v) { return __int_as_float(__builtin_amdgcn_update_dpp(0, __float_as_int(v), 0x110 + N, 0xf, 0xf, true)); }
template <int N> __device__ __forceinline__ float row_ror(float v) { return __int_as_float(__builtin_amdgcn_update_dpp(0, __float_as_int(v), 0x120 + N, 0xf, 0xf, true)); }
__device__ __forceinline__ float wave_incl_scan(float x, int lane) {
    x += row_shr<1>(x); x += row_shr<2>(x); x += row_shr<4>(x); x += row_shr<8>(x);
    const float t0 = __int_as_float(__builtin_amdgcn_readlane(__float_as_int(x), 15)), t1 = __int_as_float(__builtin_amdgcn_readlane(__float_as_int(x), 31)), t2 = __int_as_float(__builtin_amdgcn_readlane(__float_as_int(x), 47));
    const int row = lane >> 4; return x + (row >= 1 ? t0 : 0.f) + (row >= 2 ? t1 : 0.f) + (row >= 3 ? t2 : 0.f);
}
__device__ __forceinline__ float wave_max(float v) { v = fmaxf(v, xor1(v)); v = fmaxf(v, __int_as_float(__builtin_amdgcn_update_dpp(0, __float_as_int(v), 0x4E, 0xf, 0xf, true)));
    v = fmaxf(v, row_ror<4>(v)); v = fmaxf(v, row_ror<8>(v)); v = max_xor16(v); return max_xor32(v); }
__device__ __forceinline__ float wave_sum(float v) { v += xor1(v); v += __int_as_float(__builtin_amdgcn_update_dpp(0, __float_as_int(v), 0x4E, 0xf, 0xf, true));
    v += row_shr<4>(v); v += row_shr<8>(v);
    return __int_as_float(__builtin_amdgcn_readlane(__float_as_int(v), 15)) + __int_as_float(__builtin_amdgcn_readlane(__float_as_int(v), 31)) + __int_as_float(__builtin_amdgcn_readlane(__float_as_int(v), 47)) + __int_as_float(__builtin_amdgcn_readlane(__float_as_int(v), 63)); }
}
namespace pg8 {
#define PG8_LAS __attribute__((address_space(3)))
typedef unsigned short bf16_t;
typedef short bf16x8 __attribute__((ext_vector_type(8)));
typedef float f32x4 __attribute__((ext_vector_type(4)));
typedef unsigned u32x4 __attribute__((ext_vector_type(4)));
constexpr int BM = 256, BK = 64, HALF = 128, HTB = HALF * BK * 2  , STAGE_BYTES = 8 * HTB, NXCD = 8, WGM = 8;

__host__ __device__ __forceinline__ int lds_byte(int r, int c) { const int st = (r >> 4) * 2 + (c >> 5), rr = r & 15, cc = c & 31, ob = rr * 64 + cc * 2; return st * 1024 + (ob ^ (((ob >> 9) & 1) << 5)); }
__host__ __device__ __forceinline__ void stage_rc(int b, int& R, int& C) { const int st = b / 1024, sb = b % 1024, swz = sb ^ (((sb >> 9) & 1) << 5); R = (st >> 1) * 16 + swz / 64; C = (st & 1) * 32 + (swz % 64) / 2; }
__host__ __device__ __forceinline__ int perm32(int rho) { const int n = rho >> 4, i = rho & 15; return 8 * (i >> 2) + 4 * n + (i & 3); }

struct Unit { int pm, pn; };
struct Gemm { const bf16_t* A; const bf16_t* Bt; int M, N, K; };

struct StaticOrder {
    int nM, nN, nwg, G, c;
    __host__ __device__ void init(int M, int N, int G_, int c_) { nM = M / BM; nN = N / BM; nwg = nM * nN; G = G_; c = c_; }
    __host__ __device__ bool next(int i, Unit& u) const {
        const long L = (long)i * G + c; if (L >= nwg) return false;
        int wgid = (int)L; { const int q = nwg / NXCD, r = nwg % NXCD, xcd = wgid % NXCD, off = wgid / NXCD; wgid = (xcd < r ? xcd * (q + 1) : r * (q + 1) + (xcd - r) * q) + off; }
        const int nig = WGM * nN, gid = wgid / nig, fm = gid * WGM, gsz = (nM - fm) < WGM ? (nM - fm) : WGM;
        u.pm = fm + ((wgid % nig) % gsz); u.pn = (wgid % nig) / gsz; return true;
    }
    __device__ __forceinline__ void a_ready(const Unit&) const {}
    __device__ __forceinline__ void done(const Unit&) const {}
};

__device__ __forceinline__ unsigned cvt_pk_bf16(float lo, float hi) { return cvt_pk_bf16_rne(lo, hi); }
typedef float f32x2 __attribute__((ext_vector_type(2)));
constexpr int MP = 8704, MREAL = 8464, NSAMP = 256, LPR = 8208, SROW0 = 8208;
constexpr int DM = 2048, CONVD = 1024, ATTD = 1024, NH = 8, HDIM = 128, DFF = 4096, DFF2 = 8192, NPROJ = 10496, PROJ = 10248;
constexpr float RMS_EPS = 1e-6f;
constexpr long OFF_YP = 0, OFF_YS = 16777216, OFF_KP = 17301504, OFF_VP = 34111488, OFF_LFP = 50921472, OFF_CP = 51052800, OFF_FP = 51056896,
               OFF_KS = 51089664, OFF_VS = 51613952, OFF_LFS = 52138240, OFF_CS = 52142336, OFF_FS = 52207872, OUT_TOTAL = 52732160;
typedef unsigned u32x2 __attribute__((ext_vector_type(2)));
__device__ __forceinline__ u32x2 pk4(const f32x4 v) { u32x2 w; w.x = cvt_pk_bf16(v[0], v[1]); w.y = cvt_pk_bf16(v[2], v[3]); return w; }
__device__ __forceinline__ f32x4 unpk4(const u32x2 w) { f32x4 v; v[0] = __uint_as_float(w.x << 16); v[1] = __uint_as_float(w.x & 0xffff0000u); v[2] = __uint_as_float(w.y << 16); v[3] = __uint_as_float(w.y & 0xffff0000u); return v; }
__device__ __forceinline__ float sigmoidf_(float v) { return __builtin_amdgcn_rcpf(1.0f + __builtin_amdgcn_exp2f(-1.4426950408889634f * v)); }
__device__ __forceinline__ float rowscale(const float* ssq, int row) { const f32x4* p = (const f32x4*)(ssq + (size_t)row * 32); f32x4 a = p[0];
#pragma unroll
    for (int i = 1; i < 8; ++i) a += p[i];
    return 1.0f / sqrtf(((a[0] + a[1]) + (a[2] + a[3])) * (1.0f / 2048.0f) + RMS_EPS); }

constexpr int HALO_SLOTS = 512 + 68;
__device__ __forceinline__ int halo_slot(int row) { return row < 8192 ? (row >> 6) * 4 + ((row + 2) & 3) : 512 + ((row - 8192) >> 4) * 4 + ((row + 2) & 3); }
typedef __attribute__((address_space(1))) f32x4 GAS_F4;
__device__ __forceinline__ float rowscale_asm(const float* ssq_row, const float* extra, f32x4& ex) {
    f32x4 p0, p1, p2, p3, p4, p5, p6, p7; const GAS_F4* q = (const GAS_F4*)ssq_row;
    asm volatile("global_load_dwordx4 %0, %1, off" : "=v"(ex) : "v"((const GAS_F4*)extra));
    asm volatile("global_load_dwordx4 %0, %1, off" : "=v"(p0) : "v"(q + 0)); asm volatile("global_load_dwordx4 %0, %1, off" : "=v"(p1) : "v"(q + 1));
    asm volatile("global_load_dwordx4 %0, %1, off" : "=v"(p2) : "v"(q + 2)); asm volatile("global_load_dwordx4 %0, %1, off" : "=v"(p3) : "v"(q + 3));
    asm volatile("global_load_dwordx4 %0, %1, off" : "=v"(p4) : "v"(q + 4)); asm volatile("global_load_dwordx4 %0, %1, off" : "=v"(p5) : "v"(q + 5));
    asm volatile("global_load_dwordx4 %0, %1, off" : "=v"(p6) : "v"(q + 6)); asm volatile("global_load_dwordx4 %0, %1, off" : "=v"(p7) : "v"(q + 7));
    asm volatile("s_waitcnt vmcnt(0)" : "+v"(p0), "+v"(p1), "+v"(p2), "+v"(p3), "+v"(p4), "+v"(p5), "+v"(p6), "+v"(p7), "+v"(ex));
    const f32x4 a = ((p0 + p1) + (p2 + p3)) + ((p4 + p5) + (p6 + p7));
    return 1.0f / sqrtf(((a[0] + a[1]) + (a[2] + a[3])) * (1.0f / 2048.0f) + RMS_EPS);
}
struct EpiIn {
    static constexpr bool PERM = false, AFTER_DRAIN = false;
    const float* ssq; const float* bias; bf16_t *YC; float* PH; const float* wconv; bf16_t *Q, *Kb, *Vb, *RG; unsigned char* SGA; float* LOGF; float* out; int layer; PG8_LAS float* rst;
    __device__ __forceinline__ void pre_epi(const Unit& u, int wc, int lane) const { const int trow = wc * 64 + lane, pn = u.pn, j = trow - 64;
        const float* ex = bias + pn * 256 + 4 * (trow & 63);
        if (trow >= 64 && trow < 112 && pn < 16) ex = wconv + (j >> 4) * 1024 + 64 * pn + (j & 15) * 4;
        f32x4 e; rst[trow] = rowscale_asm(ssq + (size_t)(u.pm * BM + trow) * 32, ex, e);
        if (trow < 64) *(PG8_LAS f32x4*)(rst + 256 + 4 * trow) = e; else if (trow < 112) *(PG8_LAS f32x4*)(rst + 512 + 4 * j) = e; }
    __device__ __forceinline__ void operator()(const f32x4 (&acc)[2][2][4][2], const Unit& u, int wr, int wc, int fr, int fq) const {
        const int rowb = u.pm * BM + wr * 64 + fr, pn = u.pn;
        const PG8_LAS float* rsl = rst + wr * 64 + fr;
#define EPI_IN_BIAS() f32x4 bv[2][2]; _Pragma("unroll") for (int bj = 0; bj < 2; ++bj) _Pragma("unroll") for (int n = 0; n < 2; ++n) bv[bj][n] = *(const PG8_LAS f32x4*)(rst + 256 + wc * 32 + 4 * fq + bj * HALF + n * 16)
        if (pn < 16) { EPI_IN_BIAS();
            const int ch = 64 * pn + 16 * wc + 4 * fq; const bool samp = u.pm >= 32;
            const f32x4 w0 = *(const PG8_LAS f32x4*)(rst + 512 + 16 * wc + 4 * fq), w1 = *(const PG8_LAS f32x4*)(rst + 576 + 16 * wc + 4 * fq), w2 = *(const PG8_LAS f32x4*)(rst + 640 + 16 * wc + 4 * fq);
#pragma unroll
            for (int ai = 0; ai < 2; ++ai) { f32x4 plast = {0.f, 0.f, 0.f, 0.f};
#pragma unroll
                for (int m = 0; m < 4; ++m) { const int row = rowb + ai * HALF + m * 16; const float rs = rsl[ai * HALF + m * 16];
                    const f32x4 xc = acc[ai][0][m][0] * rs + bv[0][0], bc = acc[ai][0][m][1] * rs + bv[0][1], cc = acc[ai][1][m][0] * rs + bv[1][0], q = acc[ai][1][m][1] * rs + bv[1][1];
                    const f32x4 p = cc * xc; const size_t o = (size_t)row * 1024 + ch;
                    f32x4 y;
#pragma unroll
                    for (int e = 0; e < 4; ++e) { const float s1 = xl::row_ror<1>(fr == 15 ? plast[e] : p[e]), s2 = xl::row_ror<2>(fr >= 14 ? plast[e] : p[e]);
                        y[e] = bc[e] * (w0[e] * s2 + w1[e] * s1 + w2[e] * p[e]); }
                    plast = p;
                    if (!(fr < 2 && (m == 0 || samp))) *(u32x2*)(YC + (size_t)row * 2048 + ch) = pk4(y);
                    *(u32x2*)(Q + o) = pk4(q);
                    const bool halo = samp ? (fr < 2 || fr >= 14) : ((m == 0 && fr < 2) || (m == 3 && fr >= 14));
                    if (halo && row < MREAL) { float* hp = PH + (size_t)halo_slot(row) * 2048 + ch; *(f32x4*)hp = p; *(f32x4*)(hp + 1024) = bc; }
                    if (samp) {
                        if (row >= SROW0) { const int sr = row - SROW0; if (row < MREAL && (sr & 15) >= 14) *(f32x4*)(out + OFF_CS + ((size_t)(layer * 16 + (sr >> 4)) * 2 + ((sr & 15) - 14)) * 1024 + ch) = p; }
                        else if (row >= LPR - 2) *(f32x4*)(out + OFF_CP + (size_t)(layer * 2 + (row - (LPR - 2))) * 1024 + ch) = p; } } }
        } else if (pn < 24) { EPI_IN_BIAS();
            const bool isv = pn >= 20; bf16_t* B = isv ? Vb : Kb; const int colb = 256 * (pn - (isv ? 20 : 16)) + wc * 32 + 4 * fq;
#pragma unroll
            for (int ai = 0; ai < 2; ++ai)
#pragma unroll
                for (int m = 0; m < 4; ++m) { const int row = rowb + ai * HALF + m * 16; const float rs = rsl[ai * HALF + m * 16];
                    long oo = -1; if (row < LPR) oo = (isv ? OFF_VP : OFF_KP) + ((long)layer * LPR + row) * 1024; else if (row < MREAL) oo = (isv ? OFF_VS : OFF_KS) + ((long)layer * 256 + (row - SROW0)) * 1024;
#pragma unroll
                    for (int bj = 0; bj < 2; ++bj)
#pragma unroll
                        for (int n = 0; n < 2; ++n) { const f32x4 v = acc[ai][bj][m][n] * rs + bv[bj][n]; const int col = colb + bj * HALF + n * 16;
                            *(u32x2*)(B + (size_t)row * 1024 + col) = pk4(v); if (oo >= 0) *(f32x4*)(out + oo + col) = v; } }
        } else if (pn < 40) { EPI_IN_BIAS();
            const int colb = 128 * (pn - 24) + wc * 32 + 4 * fq;
#pragma unroll
            for (int ai = 0; ai < 2; ++ai)
#pragma unroll
                for (int m = 0; m < 4; ++m) { const int row = rowb + ai * HALF + m * 16; const float rs = rsl[ai * HALF + m * 16];
#pragma unroll
                    for (int n = 0; n < 2; ++n) { const f32x4 zc = acc[ai][0][m][n] * rs + bv[0][n], za = acc[ai][1][m][n] * rs + bv[1][n]; f32x4 rg, ga;
#pragma unroll
                        for (int e = 0; e < 4; ++e) { const float ea = 1.0f + __builtin_amdgcn_exp2f(fminf(-1.4426950408889634f * za[e], 80.f));
                            ga[e] = fmaxf(__builtin_rintf(255.0f * __builtin_amdgcn_rcpf(ea)), 1.0f);
                            rg[e] = 255.0f * __builtin_amdgcn_rcpf((1.0f + __builtin_amdgcn_exp2f(-1.4426950408889634f * zc[e])) * ga[e]); }
                        const unsigned gq = (unsigned)ga[0] | ((unsigned)ga[1] << 8) | ((unsigned)ga[2] << 16) | ((unsigned)ga[3] << 24);
                        *(u32x2*)(RG + (size_t)row * 2048 + colb + n * 16) = pk4(rg); *(unsigned*)(SGA + (size_t)row * 2048 + colb + n * 16) = gq; } }
        } else {
            if (wc == 0 && fq < 2) { int fq_ = fq; asm volatile("" : "+v"(fq_)); const f32x4 bv00 = *(const PG8_LAS f32x4*)(rst + 256 + 4 * fq_);
#pragma unroll
                for (int ai = 0; ai < 2; ++ai)
#pragma unroll
                    for (int m = 0; m < 4; ++m) { const int row = rowb + ai * HALF + m * 16; const float rs = rsl[ai * HALF + m * 16];
                        f32x4 v = acc[ai][0][m][0] * rs + bv00;
#pragma unroll
                        for (int e = 0; e < 4; ++e) v[e] = fminf(v[e], 0.f) - log1pf(__expf(-fabsf(v[e])));
#pragma unroll
                        for (int e = 0; e < 4; ++e) LOGF[(size_t)(4 * fq + e) * MP + row] = v[e];
                        if (row < LPR) *(f32x4*)(out + OFF_LFP + ((size_t)layer * LPR + row) * 8 + 4 * fq) = v;
                        else if (row < MREAL) *(f32x4*)(out + OFF_LFS + ((size_t)layer * 256 + (row - SROW0)) * 8 + 4 * fq) = v; }
            }
        }
#undef EPI_IN_BIAS
    }
};
typedef unsigned u32x4e __attribute__((ext_vector_type(4)));
__device__ __forceinline__ void unpk8(const u32x4e w, f32x4& lo, f32x4& hi) { lo = unpk4((u32x2){w.x, w.y}); hi = unpk4((u32x2){w.z, w.w}); }
__device__ __forceinline__ u32x4e pk8(const f32x4 lo, const f32x4 hi) { const u32x2 a = pk4(lo), b = pk4(hi); return (u32x4e){a.x, a.y, b.x, b.y}; }
struct EpiGateK {
    static constexpr bool PERM = true, AFTER_DRAIN = false;
    const bf16_t* RG; const unsigned char* SGA; bf16_t* MG;
    __device__ __forceinline__ void pre_epi(const Unit&, int, int) const {}
    __device__ __forceinline__ void mid(f32x4 (&acc)[2][2][4][2], const Unit& u, int wr, int wc, int fr, int fq) const {
        asm volatile("" : "+v"(fr), "+v"(fq));
        const int rowb = u.pm * BM + wr * 64 + fr, colb = u.pn * BM + wc * 32 + 8 * fq;
#pragma unroll
        for (int ai = 0; ai < 2; ++ai)
#pragma unroll
            for (int m = 0; m < 4; ++m) { const size_t ro = (size_t)(rowb + ai * HALF + m * 16) * 2048 + colb;
#pragma unroll
                for (int bj = 0; bj < 2; ++bj) { f32x4 lo, hi; unpk8(*(const u32x4e*)(RG + ro + bj * HALF), lo, hi); acc[ai][bj][m][0] *= lo; acc[ai][bj][m][1] *= hi; } }
    }
    __device__ __forceinline__ void operator()(const f32x4 (&acc)[2][2][4][2], const Unit& u, int wr, int wc, int fr, int fq) const {
        const int rowb = u.pm * BM + wr * 64 + fr, colb = u.pn * BM + wc * 32 + 8 * fq;
#pragma unroll
        for (int ai = 0; ai < 2; ++ai)
#pragma unroll
            for (int m = 0; m < 4; ++m) { const size_t ro = (size_t)(rowb + ai * HALF + m * 16) * 2048 + colb;
#pragma unroll
                for (int bj = 0; bj < 2; ++bj) { const size_t o = ro + bj * HALF; const u32x2 gq = *(const u32x2*)(SGA + o);
                    const f32x4 g0 = {(float)(gq.x & 255u), (float)((gq.x >> 8) & 255u), (float)((gq.x >> 16) & 255u), (float)(gq.x >> 24)};
                    const f32x4 g1 = {(float)(gq.y & 255u), (float)((gq.y >> 8) & 255u), (float)((gq.y >> 16) & 255u), (float)(gq.y >> 24)};
                    *(u32x4e*)(MG + o) = pk8(g0 * (1.0f / 255.0f) * acc[ai][bj][m][0], g1 * (1.0f / 255.0f) * acc[ai][bj][m][1]); } }
    }
};
struct EpiRes {
    static constexpr bool PERM = true, AFTER_DRAIN = false;
    bf16_t* XB; float* ssq_next;
    __device__ __forceinline__ void pre_epi(const Unit&, int, int) const {}
    __device__ __forceinline__ void operator()(const f32x4 (&acc)[2][2][4][2], const Unit& u, int wr, int wc, int fr, int fq) const {
        const int rowb = u.pm * BM + wr * 64 + fr, colb = u.pn * BM + wc * 32 + 8 * fq;
#pragma unroll
        for (int ai = 0; ai < 2; ++ai)
#pragma unroll
            for (int m = 0; m < 4; ++m) { const int row = rowb + ai * HALF + m * 16; const size_t ro = (size_t)row * 2048 + colb; float s = 0.f;
#pragma unroll
                for (int bj = 0; bj < 2; ++bj) { const size_t o = ro + bj * HALF; f32x4 lo, hi; unpk8(*(const u32x4e*)(XB + o), lo, hi);
                    const f32x4 x0 = lo + acc[ai][bj][m][0], x1 = hi + acc[ai][bj][m][1];
                    *(u32x4e*)(XB + o) = pk8(x0, x1);
                    s += ((x0[0] * x0[0] + x0[1] * x0[1]) + (x0[2] * x0[2] + x0[3] * x0[3])) + ((x1[0] * x1[0] + x1[1] * x1[1]) + (x1[2] * x1[2] + x1[3] * x1[3])); }
                s = xl::sum_xor16(s); s = xl::sum_xor32(s);
                if (fq == 0) ssq_next[(size_t)row * 32 + u.pn * 4 + wc] = s; }
    }
};
struct EpiUp {
    static constexpr bool PERM = false, AFTER_DRAIN = false;
    const float* ssq; bf16_t* U; float* out; int layer;
    __device__ __forceinline__ void operator()(const f32x4 (&acc)[2][2][4][2], const Unit& u, int wr, int wc, int fr, int fq) const {
        const int rowb = u.pm * BM + wr * 64 + fr, colb = u.pn * BM + wc * 32 + 4 * fq, natb = 128 * u.pn + wc * 32 + 4 * fq;
#pragma unroll
        for (int ai = 0; ai < 2; ++ai)
#pragma unroll
            for (int m = 0; m < 4; ++m) { const int row = rowb + ai * HALF + m * 16; const float rs = rowscale(ssq, row);
                long oo = -1; if (row >= SROW0) { const int sr = row - SROW0; if (row < MREAL && (sr & 15) >= 14) oo = OFF_FS + ((long)(layer * 16 + (sr >> 4)) * 2 + ((sr & 15) - 14)) * 8192; }
                else if (row >= LPR - 2) oo = OFF_FP + (long)(layer * 2 + (row - (LPR - 2))) * 8192;
#pragma unroll
                for (int bj = 0; bj < 2; ++bj)
#pragma unroll
                    for (int n = 0; n < 2; ++n) { const f32x4 v = acc[ai][bj][m][n] * rs; *(u32x2*)(U + (size_t)row * 8192 + colb + bj * HALF + n * 16) = pk4(v);
                        if (oo >= 0) *(f32x4*)(out + oo + bj * 4096 + natb + n * 16) = v; } }
    }
};

struct EpiUpConv {
    static constexpr bool PERM = false, AFTER_DRAIN = false;
    const float* ssq; bf16_t* G; float* HALO; const float* wf; const float* bfc; float* out; int layer; PG8_LAS float* rst;
    __device__ __forceinline__ void pre_epi(const Unit& u, int wc, int lane) const { const int trow = wc * 64 + lane, vi = trow >> 5, c4 = (trow & 31) * 4;
        const float* ex = ((vi & 3) == 3 ? bfc : wf + (vi & 3) * 8192) + (vi >> 2) * 4096 + 128 * u.pn + c4;
        f32x4 e; rst[trow] = rowscale_asm(ssq + (size_t)(u.pm * BM + trow) * 32, ex, e);
        *(PG8_LAS f32x4*)(rst + 256 + vi * 128 + c4) = e; }
    __device__ __forceinline__ void operator()(const f32x4 (&acc)[2][2][4][2], const Unit& u, int wr, int wc, int fr, int fq) const {
        const int rowb = u.pm * BM + wr * 64 + fr, chb = 128 * u.pn + wc * 32 + 4 * fq; const bool samp = u.pm >= 32;
        float rs[2][4];
#pragma unroll
        for (int ai = 0; ai < 2; ++ai)
#pragma unroll
            for (int m = 0; m < 4; ++m) rs[ai][m] = rst[ai * HALF + wr * 64 + m * 16 + fr];
#pragma unroll
        for (int n = 0; n < 2; ++n) { const int ch = chb + 16 * n;
            const PG8_LAS float* wt = rst + 256 + wc * 32 + 4 * fq + 16 * n;
            const f32x4 w0a = *(const PG8_LAS f32x4*)(wt), w1a = *(const PG8_LAS f32x4*)(wt + 128), w2a = *(const PG8_LAS f32x4*)(wt + 256), ba = *(const PG8_LAS f32x4*)(wt + 384);
            const f32x4 w0b = *(const PG8_LAS f32x4*)(wt + 512), w1b = *(const PG8_LAS f32x4*)(wt + 640), w2b = *(const PG8_LAS f32x4*)(wt + 768), bb = *(const PG8_LAS f32x4*)(wt + 896);
#pragma unroll
            for (int ai = 0; ai < 2; ++ai)
#pragma unroll
                for (int m = 0; m < 4; ++m) { const int row = rowb + ai * HALF + m * 16;
                    const f32x4 ua = acc[ai][0][m][n] * rs[ai][m], ub = acc[ai][1][m][n] * rs[ai][m];
                    f32x4 pa = ua, pb = ub; if (m > 0) { pa = acc[ai][0][m - 1][n] * rs[ai][m - 1]; pb = acc[ai][1][m - 1][n] * rs[ai][m - 1]; }
                    f32x4 A, B;
#pragma unroll
                    for (int e = 0; e < 4; ++e) {
                        const float a1 = xl::row_ror<1>(fr == 15 ? pa[e] : ua[e]), a2 = xl::row_ror<2>(fr >= 14 ? pa[e] : ua[e]);
                        const float b1 = xl::row_ror<1>(fr == 15 ? pb[e] : ub[e]), b2 = xl::row_ror<2>(fr >= 14 ? pb[e] : ub[e]);
                        A[e] = w0a[e] * a2 + w1a[e] * a1 + w2a[e] * ua[e] + ba[e]; B[e] = w0b[e] * b2 + w1b[e] * b1 + w2b[e] * ub[e] + bb[e]; }
                    f32x4 gv;
#pragma unroll
                    for (int e = 0; e < 4; ++e) gv[e] = A[e] * sigmoidf_(A[e]) * B[e];
                    const bool skip = fr < 2 && (m == 0 || samp);
                    if (!skip) *(u32x2*)(G + (size_t)row * 4096 + ch) = pk4(gv);
                    const bool halo = samp ? (fr < 2 || fr >= 14) : ((m == 0 && fr < 2) || (m == 3 && fr >= 14));
                    if (halo && row < MREAL) { float* hp = HALO + (size_t)halo_slot(row) * 8192 + ch; *(f32x4*)hp = ua; *(f32x4*)(hp + 4096) = ub; }
                    if (samp) {
                        long oo = -1; if (row >= SROW0) { const int sr = row - SROW0; if (row < MREAL && (sr & 15) >= 14) oo = OFF_FS + ((long)(layer * 16 + (sr >> 4)) * 2 + ((sr & 15) - 14)) * 8192; }
                        else if (row >= LPR - 2) oo = OFF_FP + (long)(layer * 2 + (row - (LPR - 2))) * 8192;
                        if (oo >= 0) { *(f32x4*)(out + oo + ch) = ua; *(f32x4*)(out + oo + 4096 + ch) = ub; } } }
            asm volatile("" ::: "memory");
        }
    }
};
template <class Epi, class Sched, bool ALIGN_EPI = false, bool SP2 = false, bool MID = false>
__device__ __forceinline__ void gemm_phase(PG8_LAS unsigned char* lds, const Gemm g, const Sched& S, const Epi& E, const int wv  ) {
    int tid_ = wv * 64 + (int)__builtin_amdgcn_mbcnt_hi(~0u, __builtin_amdgcn_mbcnt_lo(~0u, 0u)); asm volatile("" : "+v"(tid_));
    const int tid = tid_, wid = __builtin_amdgcn_readfirstlane(tid >> 6), lane = tid & 63, wr = wid >> 2, wc = wid & 3, fr = lane & 15, fq = lane >> 4;
    const int K = g.K, nt = K / BK;
    unsigned voffA[2], voffB[2];
#pragma unroll
    for (int i = 0; i < 2; ++i) { int R, C; stage_rc(tid * 16 + i * 8192, R, C); const int Rb = Epi::PERM ? ((R & ~31) + perm32(R & 31)) : R;
        voffA[i] = (unsigned)(R * K + C) * 2u; voffB[i] = (unsigned)(Rb * K + C) * 2u; }
    const size_t kstep = (size_t)(BK * 2);
    const size_t hstep = (size_t)HALF * K * 2;
    const size_t tstep = 2 * hstep;
    const unsigned ldsw = (unsigned)wid * 1024u;
    const int aoff = lds_byte(wr * 64 + fr, fq * 8), boff = lds_byte(wc * 32 + fr, fq * 8);
    const unsigned ldsA = (unsigned)(uintptr_t)lds + (unsigned)aoff, ldsB = (unsigned)(uintptr_t)lds + (unsigned)boff;
#define PG8_SA(b, h) (((b) * 2 + (h)) * HTB)
#define PG8_SB(b, h) ((4 + (b) * 2 + (h)) * HTB)
#define PG8_STAGE(bufoff, gbase, voff) do { _Pragma("unroll") for (int _i = 0; _i < 2; ++_i) \
        __builtin_amdgcn_global_load_lds((const unsigned*)((const char*)(gbase) + (voff)[_i]), (PG8_LAS unsigned*)(lds + (bufoff) + ldsw + _i * 8192), 16, 0, 0); } while (0)
#define PG8_DSRD(dst, addr, off) asm volatile("ds_read_b128 %0, %1 offset:%2" : "=v"(dst) : "v"(addr), "i"(off))
#define PG8_LDA(dst, b, h) do { const unsigned a_ = ldsA + PG8_SA(b, h); _Pragma("unroll") for (int m = 0; m < 4; ++m) _Pragma("unroll") for (int k = 0; k < 2; ++k) PG8_DSRD(dst[m][k], a_, m * 2048 + k * 1024); } while (0)
#define PG8_LDB(dst, b, h) do { const unsigned b_ = ldsB + PG8_SB(b, h); _Pragma("unroll") for (int n = 0; n < 2; ++n) _Pragma("unroll") for (int k = 0; k < 2; ++k) PG8_DSRD(dst[n][k], b_, n * 2048 + k * 1024); } while (0)
#define PG8_MMA(ai, bj, At, Bt) do { __builtin_amdgcn_s_setprio(1); _Pragma("unroll") for (int m = 0; m < 4; ++m) _Pragma("unroll") for (int n = 0; n < 2; ++n) _Pragma("unroll") for (int k = 0; k < 2; ++k) \
        acc[ai][bj][m][n] = __builtin_amdgcn_mfma_f32_16x16x32_bf16(Bt[n][k], At[m][k], acc[ai][bj][m][n], 0, 0, 0); __builtin_amdgcn_s_setprio(0); } while (0)
#define PG8_WAIT_V(n) asm volatile("s_waitcnt vmcnt(" #n ")" ::: "memory")
#define PG8_WAIT_L(n) asm volatile("s_waitcnt lgkmcnt(" #n ")" ::: "memory")
#define PG8_BAR __builtin_amdgcn_s_barrier()
#define PG8_SCHED __builtin_amdgcn_sched_barrier(0)
    Unit cur, nxt; int ui = 0;
    if (!S.next(0, cur)) return;
    f32x4 acc[2][2][4][2];
#pragma unroll
    for (int a = 0; a < 2; ++a)
#pragma unroll
        for (int b = 0; b < 2; ++b)
#pragma unroll
            for (int m = 0; m < 4; ++m)
#pragma unroll
                for (int n = 0; n < 2; ++n) acc[a][b][m][n] = (f32x4){0.f, 0.f, 0.f, 0.f};
    bf16x8 At[4][2], B0[2][2], B1[2][2];
    const char* cA = (const char*)g.A + (size_t)cur.pm * tstep; const char* cB = (const char*)g.Bt + (size_t)cur.pn * tstep;
    S.a_ready(cur);
    if constexpr (SP2) {
        PG8_STAGE(PG8_SB(0, 0), cB, voffB); PG8_STAGE(PG8_SB(0, 1), cB + hstep, voffB); PG8_STAGE(PG8_SA(0, 0), cA, voffA); PG8_STAGE(PG8_SA(0, 1), cA + hstep, voffA);
        if (wr == 1) PG8_BAR;
        PG8_WAIT_V(2); PG8_BAR;
        PG8_STAGE(PG8_SB(1, 0), cB + kstep, voffB); PG8_STAGE(PG8_SA(1, 0), cA + kstep, voffA); PG8_STAGE(PG8_SB(1, 1), cB + hstep + kstep, voffB);
        PG8_WAIT_V(6); PG8_BAR;
    } else {
        PG8_STAGE(PG8_SB(0, 0), cB, voffB); PG8_STAGE(PG8_SA(0, 0), cA, voffA); PG8_STAGE(PG8_SB(0, 1), cB + hstep, voffB); PG8_STAGE(PG8_SA(0, 1), cA + hstep, voffA);
        if (wr == 1) PG8_BAR;
        PG8_WAIT_V(4); PG8_BAR;
        PG8_STAGE(PG8_SB(1, 0), cB + kstep, voffB); PG8_STAGE(PG8_SA(1, 0), cA + kstep, voffA); PG8_STAGE(PG8_SB(1, 1), cB + hstep + kstep, voffB);
        PG8_WAIT_V(6); PG8_BAR;
    }
    for (;;) {
        const bool has_next = S.next(ui + 1, nxt);
        const char* nA = has_next ? (const char*)g.A + (size_t)nxt.pm * tstep : cA; const char* nB = has_next ? (const char*)g.Bt + (size_t)nxt.pn * tstep : cB;
        for (int t = 0; t < nt; t += 2) {
            if constexpr (MID) { if (t == (nt >> 1)) {
                if constexpr (ALIGN_EPI) { if (wr == 0) PG8_BAR; }
                E.mid(acc, cur, wr, wc, fr, fq);
                if constexpr (ALIGN_EPI) { if (wr == 1) PG8_BAR; }
                PG8_SCHED; } }
            const bool last = (t == nt - 2);
            const char* a1 = cA + (size_t)(t + 1) * kstep;
            const char* a2 = last ? nA : cA + (size_t)(t + 2) * kstep; const char* b2 = last ? nB : cB + (size_t)(t + 2) * kstep;
            const char* a3 = a2 + kstep; const char* b3 = b2 + kstep;
            if (last && has_next) S.a_ready(nxt);
            if constexpr (SP2) {
            PG8_LDB(B0, 0, 0); PG8_LDB(B1, 0, 1); PG8_SCHED; PG8_LDA(At, 0, 0); PG8_STAGE(PG8_SA(1, 1), a1 + hstep, voffA);
            PG8_WAIT_V(8); PG8_WAIT_L(0); PG8_BAR; PG8_SCHED; PG8_MMA(0, 0, At, B0); PG8_MMA(0, 1, At, B1); PG8_BAR; PG8_SCHED;
            PG8_LDA(At, 0, 1); PG8_STAGE(PG8_SB(0, 0), b2, voffB); PG8_STAGE(PG8_SB(0, 1), b2 + hstep, voffB); PG8_STAGE(PG8_SA(0, 0), a2, voffA);
            PG8_WAIT_V(8); PG8_WAIT_L(0); PG8_BAR; PG8_SCHED; PG8_MMA(1, 0, At, B0); PG8_MMA(1, 1, At, B1); PG8_BAR; PG8_SCHED;
            PG8_LDB(B0, 1, 0); PG8_LDB(B1, 1, 1); PG8_SCHED; PG8_LDA(At, 1, 0); PG8_STAGE(PG8_SA(0, 1), a2 + hstep, voffA);
            PG8_WAIT_V(8); PG8_WAIT_L(0); PG8_BAR; PG8_SCHED; PG8_MMA(0, 0, At, B0); PG8_MMA(0, 1, At, B1); PG8_BAR; PG8_SCHED;
            PG8_LDA(At, 1, 1); PG8_STAGE(PG8_SB(1, 0), b3, voffB); PG8_STAGE(PG8_SB(1, 1), b3 + hstep, voffB); PG8_STAGE(PG8_SA(1, 0), a3, voffA);
            PG8_WAIT_V(8); PG8_WAIT_L(0); PG8_BAR; PG8_SCHED; PG8_MMA(1, 0, At, B0); PG8_MMA(1, 1, At, B1); PG8_BAR; PG8_SCHED;
            } else {
            PG8_LDB(B0, 0, 0); PG8_SCHED; PG8_LDA(At, 0, 0); PG8_STAGE(PG8_SA(1, 1), a1 + hstep, voffA);
            PG8_WAIT_L(8); PG8_BAR; PG8_WAIT_L(0); PG8_SCHED; PG8_MMA(0, 0, At, B0); PG8_BAR; PG8_SCHED;
            PG8_LDB(B1, 0, 1); PG8_STAGE(PG8_SB(0, 0), b2, voffB);
            PG8_BAR; PG8_WAIT_L(0); PG8_SCHED; PG8_MMA(0, 1, At, B1); PG8_BAR;
            PG8_LDA(At, 0, 1); PG8_STAGE(PG8_SA(0, 0), a2, voffA);
            PG8_BAR; PG8_WAIT_L(0); PG8_SCHED; PG8_MMA(1, 0, At, B0); PG8_BAR; PG8_SCHED;
            PG8_STAGE(PG8_SB(0, 1), b2 + hstep, voffB);
            PG8_WAIT_V(6); PG8_BAR; PG8_MMA(1, 1, At, B1); PG8_BAR;
            PG8_LDB(B0, 1, 0); PG8_SCHED; PG8_LDA(At, 1, 0); PG8_STAGE(PG8_SA(0, 1), a2 + hstep, voffA);
            PG8_WAIT_L(8); PG8_BAR; PG8_WAIT_L(0); PG8_SCHED; PG8_MMA(0, 0, At, B0); PG8_BAR; PG8_SCHED;
            PG8_LDB(B1, 1, 1); PG8_STAGE(PG8_SB(1, 0), b3, voffB);
            PG8_BAR; PG8_WAIT_L(0); PG8_SCHED; PG8_MMA(0, 1, At, B1); PG8_BAR;
            PG8_LDA(At, 1, 1); PG8_STAGE(PG8_SA(1, 0), a3, voffA);
            PG8_BAR; PG8_WAIT_L(0); PG8_SCHED; PG8_MMA(1, 0, At, B0); PG8_BAR; PG8_SCHED;
            PG8_STAGE(PG8_SB(1, 1), b3 + hstep, voffB);
            PG8_WAIT_V(6); PG8_BAR; PG8_MMA(1, 1, At, B1); PG8_BAR;
            }
        }
        if constexpr (ALIGN_EPI) { if (wr == 0) { E.pre_epi(cur, wc, lane); PG8_WAIT_L(0); PG8_BAR; } }
        if constexpr (!Epi::AFTER_DRAIN) { E(acc, cur, wr, wc, fr, fq); S.done(cur); }
        if (!has_next) break;
#pragma unroll
        for (int a = 0; a < 2; ++a)
#pragma unroll
            for (int b = 0; b < 2; ++b)
#pragma unroll
                for (int m = 0; m < 4; ++m)
#pragma unroll
                    for (int n = 0; n < 2; ++n) acc[a][b][m][n] = (f32x4){0.f, 0.f, 0.f, 0.f};
        cur = nxt; cA = nA; cB = nB; ++ui;
        if constexpr (ALIGN_EPI) { if (wr == 1) PG8_BAR; }
    }
    PG8_WAIT_V(0);
    if constexpr (!ALIGN_EPI) { if (wr == 0) PG8_BAR; }
    PG8_BAR;
    if constexpr (Epi::AFTER_DRAIN) { E.fused(acc, cur, wr, wc, fr, fq, lds, wid, lane); S.done(cur); }
#undef PG8_SA
#undef PG8_SB
#undef PG8_STAGE
#undef PG8_DSRD
#undef PG8_LDA
#undef PG8_LDB
#undef PG8_MMA
#undef PG8_WAIT_V
#undef PG8_WAIT_L
#undef PG8_BAR
#undef PG8_SCHED
}
}
namespace pa {
typedef unsigned short bf16_t;
typedef short bf16x8 __attribute__((ext_vector_type(8)));
typedef short s16x4 __attribute__((ext_vector_type(4)));
typedef float f32x16 __attribute__((ext_vector_type(16)));
typedef float f32x4 __attribute__((ext_vector_type(4)));
typedef unsigned u32x4 __attribute__((ext_vector_type(4)));
constexpr int D = 128, LD = 1024, LDO = 2048;
constexpr float SCALE = 0.08838834764831845f, C2 = 1.4426950408889634f * SCALE, THR = 8.f;
constexpr int NW = 8, QBLK = 32, KVBLK = 64, QB = NW * QBLK;
constexpr int SHM_V = KVBLK * D * 2, SHM_K = KVBLK * D * 2;
constexpr int LDS_ATT = 2 * SHM_V + 2 * SHM_K + NW * 64 * 4;
#define KSWZ(row, colB) ((row) * 256 + ((colB) ^ (((row) & 7) << 4)))
#define SBAR() __builtin_amdgcn_sched_barrier(0)
__device__ __forceinline__ int v_st(int k, int c) { const int kk = (k & ~0xC) | ((k & 4) << 1) | ((k & 8) >> 1); return ((kk >> 3) * 4 + (c >> 5)) * 512 + ((kk & 7) * 32 + (c & 31)) * 2; }
__device__ __forceinline__ int v_rd_base(int lane) { return ((lane & 3) << 3) | (((lane >> 2) & 3) << 6) | (((lane >> 4) & 1) << 5) | (((lane >> 5) & 1) << 8); }
constexpr int v_rd_off(int d0, int ks, int half) { return d0 * 512 + ks * 4096 + half * 2048; }
__device__ __forceinline__ int crow(int r, int hi) { return (r & 3) + 8 * (r >> 2) + 4 * hi; }
__device__ __forceinline__ unsigned cvtpk(float lo, float hi) { return cvt_pk_bf16_rne(lo, hi); }
__device__ __forceinline__ bf16x8 load8(const bf16_t* p) { return *reinterpret_cast<const bf16x8*>(p); }
__device__ __forceinline__ void mask_tile(f32x16& p0, f32x16& p1, int dq) {
    const float NEG = -__builtin_inff();
#pragma unroll
    for (int r = 0; r < 16; ++r) { const int c = (r & 3) + 8 * (r >> 2); if (dq - c < 0) p0[r] = NEG; if (dq - c - 32 < 0) p1[r] = NEG; }
}
__device__ __forceinline__ void partialSM(f32x16& p0, f32x16& p1, float& m_reg, float& mn, float& alpha) {
    float pmax = p0[0];
#pragma unroll
    for (int r = 1; r < 16; ++r) pmax = fmaxf(pmax, p0[r]);
#pragma unroll
    for (int r = 0; r < 16; ++r) pmax = fmaxf(pmax, p1[r]);
    { auto rr = __builtin_amdgcn_permlane32_swap(__float_as_uint(pmax), __float_as_uint(pmax), false, false);
      pmax = fmaxf(__uint_as_float(rr[0]), __uint_as_float(rr[1])); }
    if (__builtin_expect(__all((pmax - m_reg) * SCALE <= THR), 1)) { mn = m_reg; alpha = 1.f; }
    else { mn = fmaxf(m_reg, pmax); alpha = __builtin_amdgcn_exp2f((m_reg - mn) * C2); m_reg = mn; }
    const float mnL = -mn * C2;
#pragma unroll
    for (int r = 0; r < 16; ++r) p0[r] = fmaf(p0[r], C2, mnL);
#pragma unroll
    for (int r = 0; r < 16; ++r) p1[r] = fmaf(p1[r], C2, mnL);
#pragma unroll
    for (int r = 0; r < 16; ++r) p0[r] = __builtin_amdgcn_exp2f(p0[r]);
}
__device__ __forceinline__ void finishSM(f32x16& p0, f32x16& p1, float alpha, float& l_reg, bf16x8& pa0, bf16x8& pa1, bf16x8& pa2, bf16x8& pa3) {
#pragma unroll
    for (int r = 0; r < 16; ++r) p1[r] = __builtin_amdgcn_exp2f(p1[r]);
    float ps = 0;
#pragma unroll
    for (int r = 0; r < 16; ++r) ps += p0[r];
#pragma unroll
    for (int r = 0; r < 16; ++r) ps += p1[r];
    { auto rr = __builtin_amdgcn_permlane32_swap(__float_as_uint(ps), __float_as_uint(ps), false, false);
      ps = __uint_as_float(rr[0]) + __uint_as_float(rr[1]); }
    l_reg = l_reg * alpha + ps;
#define PK4(P, B_, OUT) do { unsigned a0 = cvtpk(P[B_+0], P[B_+1]), a1 = cvtpk(P[B_+2], P[B_+3]);                          \
        unsigned b0 = cvtpk(P[B_+4], P[B_+5]), b1 = cvtpk(P[B_+6], P[B_+7]);                                             \
        auto r0 = __builtin_amdgcn_permlane32_swap(a0, b0, false, false); auto r1 = __builtin_amdgcn_permlane32_swap(a1, b1, false, false); \
        u32x4 w = {r0[0], r1[0], r0[1], r1[1]}; OUT = *reinterpret_cast<bf16x8*>(&w); } while (0)
    PK4(p0, 0, pa0); PK4(p0, 8, pa1); PK4(p1, 0, pa2); PK4(p1, 8, pa3);
#undef PK4
}
template <int KB>
__device__ __forceinline__ void qkt(f32x16& p0, f32x16& p1, const char* K_lds, int r32, int hi, const bf16x8* qr, const float* bk) {
#pragma unroll
    for (int j = 0; j < 4; ++j) { const f32x4 b0 = *(const f32x4*)(bk + 8 * j), b1 = *(const f32x4*)(bk + 32 + 8 * j);
#pragma unroll
        for (int e = 0; e < 4; ++e) { p0[4 * j + e] = b0[e]; p1[4 * j + e] = b1[e]; } }
    const char* kb[4];
#pragma unroll
    for (int dd = 0; dd < 4; ++dd) kb[dd] = K_lds + KB * SHM_K + KSWZ(r32, (dd * 16 + hi * 8) * 2);
#pragma unroll
    for (int d0 = 0; d0 < 8; ++d0) { const char* a = kb[d0 & 3] + (d0 >> 2) * 128;
        bf16x8 b0 = *reinterpret_cast<const bf16x8*>(a);
        bf16x8 b1 = *reinterpret_cast<const bf16x8*>(a + 32 * 256);
        p0 = __builtin_amdgcn_mfma_f32_32x32x16_bf16(b0, qr[d0], p0, 0, 0, 0);
        p1 = __builtin_amdgcn_mfma_f32_32x32x16_bf16(b1, qr[d0], p1, 0, 0, 0); }
}
template <int VB>
__device__ __forceinline__ void pv_tile(f32x16* o, int vb0, bf16x8 pa0, bf16x8 pa1, bf16x8 pa2, bf16x8 pa3) {
#define TRRD(dst, off) asm volatile("ds_read_b64_tr_b16 %0, %1 offset:%2" : "=&v"(dst) : "v"(vb0), "i"(off) : "memory")
#define PV_D0(d0) do { s16x4 l0, l1, l2, l3, h0, h1, h2, h3; constexpr int b_ = VB * SHM_V + v_rd_off(d0, 0, 0); \
        TRRD(l0, b_); TRRD(h0, b_ + 2048); TRRD(l1, b_ + 4096); TRRD(h1, b_ + 6144); TRRD(l2, b_ + 8192); TRRD(h2, b_ + 10240); TRRD(l3, b_ + 12288); TRRD(h3, b_ + 14336); \
        asm volatile("s_waitcnt lgkmcnt(0)" ::: "memory"); SBAR();   \
        o[d0] = __builtin_amdgcn_mfma_f32_32x32x16_bf16(pa0, (bf16x8){l0[0], l0[1], l0[2], l0[3], h0[0], h0[1], h0[2], h0[3]}, o[d0], 0, 0, 0);   \
        o[d0] = __builtin_amdgcn_mfma_f32_32x32x16_bf16(pa1, (bf16x8){l1[0], l1[1], l1[2], l1[3], h1[0], h1[1], h1[2], h1[3]}, o[d0], 0, 0, 0);   \
        o[d0] = __builtin_amdgcn_mfma_f32_32x32x16_bf16(pa2, (bf16x8){l2[0], l2[1], l2[2], l2[3], h2[0], h2[1], h2[2], h2[3]}, o[d0], 0, 0, 0);   \
        o[d0] = __builtin_amdgcn_mfma_f32_32x32x16_bf16(pa3, (bf16x8){l3[0], l3[1], l3[2], l3[3], h3[0], h3[1], h3[2], h3[3]}, o[d0], 0, 0, 0); } while (0)
    PV_D0(0); PV_D0(1); PV_D0(2); PV_D0(3);
#undef PV_D0
#undef TRRD
}
struct BlockRef { const bf16_t* Q; const bf16_t* K; const bf16_t* V; bf16_t* O; int P0, j_lo, j_hi, mode; float* part; unsigned* flag; };
struct Seam { bf16x8 qr[8]; bf16x8 st_v0, st_v1, st_k0, st_k1; };
#define ROW(p, k0, rr) ((p) + (size_t)((k0) + (rr)) * LD + sc)
#define VMW() asm volatile("s_waitcnt vmcnt(0)" ::: "memory")
#define VMWN(n) asm volatile("s_waitcnt vmcnt(%0)" :: "i"(n) : "memory")
#define SLOAD_H(Kp, Vp, k0) do { S.st_v0 = load8(ROW(Vp, k0, sr)); S.st_v1 = load8(ROW(Vp, k0, 32 + sr));              \
                         S.st_k0 = load8(ROW(Kp, k0, sr)); S.st_k1 = load8(ROW(Kp, k0, 32 + sr)); } while (0)
#define SWRITE_HK(bf) do { *(bf16x8*)(K_lds + (bf) * SHM_K + kws) = S.st_k0; *(bf16x8*)(K_lds + (bf) * SHM_K + kws + 32 * 256) = S.st_k1; } while (0)
#define SWRITE_HV(bf) do { *(bf16x8*)(V_lds + (bf) * SHM_V + vst0) = S.st_v0; *(bf16x8*)(V_lds + (bf) * SHM_V + vst1) = S.st_v1; } while (0)
#define SWRITE_H(bf) do { SWRITE_HV(bf); SWRITE_HK(bf); } while (0)
constexpr int PART_FLOATS = 256 * 128 + 512;
__device__ __forceinline__ void prime(const BlockRef& cur, char* lds, Seam& S, const int wv) {
    int tid_ = wv * 64 + (int)__builtin_amdgcn_mbcnt_hi(~0u, __builtin_amdgcn_mbcnt_lo(~0u, 0u)); asm volatile("" : "+v"(tid_)); const int tid = tid_, wid = __builtin_amdgcn_readfirstlane(tid >> 6), lane = tid & 63, r32 = lane & 31, hi = lane >> 5;
    const int sr = tid >> 4, sc = (tid & 15) * 8, kws = KSWZ(sr, sc * 2); char* K_lds = lds + 2 * SHM_V;
#pragma unroll
    for (int d0 = 0; d0 < 8; ++d0) S.qr[d0] = load8(cur.Q + (size_t)(wid * QBLK + r32) * LD + d0 * 16 + hi * 8);
    SLOAD_H(cur.K, cur.V, cur.j_lo * KVBLK); VMW(); SWRITE_HK(0);
    __syncthreads();
}
__device__ __forceinline__ void block(const BlockRef& cur, const BlockRef& nxt, char* lds, const float* bias, Seam& S, const int wv) {
    int tid_ = wv * 64 + (int)__builtin_amdgcn_mbcnt_hi(~0u, __builtin_amdgcn_mbcnt_lo(~0u, 0u)); asm volatile("" : "+v"(tid_)); const int tid = tid_, wid = __builtin_amdgcn_readfirstlane(tid >> 6), lane = tid & 63, r32 = lane & 31, hi = lane >> 5;
    const int j_lo = cur.j_lo, NT = cur.j_hi - cur.j_lo;
    const int qlo = cur.P0 + wid * QBLK, qm = qlo + r32 - 4 * hi;
    char* V_lds = lds; char* K_lds = lds + 2 * SHM_V;
    float* ws = (float*)(lds + 2 * SHM_V + 2 * SHM_K) + wid * 64; float* li_l = ws, * al_l = ws + 32;
    const float* bk = bias + 4 * hi;
    float m_reg = -1e30f, l_reg = 0; f32x16 o[4] = {};
    const int sr = tid >> 4, sc = (tid & 15) * 8, vst0 = v_st(sr, sc), vst1 = v_st(32 + sr, sc), kws = KSWZ(sr, sc * 2);
    const int vb0 = (int)(uintptr_t)V_lds + v_rd_base(lane);
    const bf16_t* Kh = cur.K; const bf16_t* Vh = cur.V;
#define RESC(a) do { if (__any((a) < 1.f)) { if (hi == 0) al_l[r32] = (a); asm volatile("s_waitcnt lgkmcnt(0)" ::: "memory");              \
                     for (int d_ = 0; d_ < 4; ++d_) for (int r = 0; r < 16; ++r) o[d_][r] *= al_l[crow(r, hi)]; } } while (0)
#define KBASE(t) ((j_lo + (t)) * KVBLK)
#define MASKT(P0_, P1_, t) do { const int kb_ = KBASE(t); if (kb_ + KVBLK - 1 > qlo) mask_tile(P0_, P1_, qm - kb_); } while (0)
    constexpr int NQL = 8;
#define SEAM_K0() do { VMWN(NQL); SWRITE_HK(0); SBAR(); } while (0)
    f32x16 pA0, pA1, pB0, pB1; float mnA, mnB, alA, alB; bf16x8 pa0, pa1, pa2, pa3;
    SWRITE_HV(0); SBAR();
    if (NT > 1) { SLOAD_H(Kh, Vh, KBASE(1)); }
    SBAR(); qkt<0>(pA0, pA1, K_lds, r32, hi, S.qr, bk + KBASE(0));
    MASKT(pA0, pA1, 0); partialSM(pA0, pA1, m_reg, mnA, alA);
    if (NT > 1) { VMW(); SWRITE_H(1); }
    __syncthreads();
#define HALF_STEP(PX0, PX1, mnX, alX, PY0, PY1, alY, t, KB, VB, SB) do {                                                      \
        SBAR(); qkt<KB>(PX0, PX1, K_lds, r32, hi, S.qr, bk + KBASE(t));                                             \
        finishSM(PY0, PY1, alY, l_reg, pa0, pa1, pa2, pa3); SBAR();                                                           \
        if ((t) + 1 < NT) { SLOAD_H(Kh, Vh, KBASE((t) + 1)); SBAR(); }                                               \
        pv_tile<VB>(o, vb0, pa0, pa1, pa2, pa3); MASKT(PX0, PX1, (t)); partialSM(PX0, PX1, m_reg, mnX, alX);                                        \
        __syncthreads();                                                                                                      \
        if ((t) + 1 < NT) { VMW(); SWRITE_H(SB); }                                                                          \
        RESC(alX); __syncthreads(); } while (0)
    for (int t = 1; t + 1 < NT; t += 2) {
        HALF_STEP(pB0, pB1, mnB, alB, pA0, pA1, alA, t, 1, 0, 0);
        HALF_STEP(pA0, pA1, mnA, alA, pB0, pB1, alB, t + 1, 0, 1, 1);
    }
    const bool even = (NT & 1) == 0;
    if (even) { SBAR(); qkt<1>(pB0, pB1, K_lds, r32, hi, S.qr, bk + KBASE(NT - 1)); SBAR(); }
    SLOAD_H(nxt.K, nxt.V, nxt.j_lo * KVBLK); SBAR();
#pragma unroll
    for (int d0 = 0; d0 < 8; ++d0) S.qr[d0] = load8(nxt.Q + (size_t)(wid * QBLK + r32) * LD + d0 * 16 + hi * 8);
    SBAR();
    finishSM(pA0, pA1, alA, l_reg, pa0, pa1, pa2, pa3); SBAR();
    pv_tile<0>(o, vb0, pa0, pa1, pa2, pa3);
    if (even) { MASKT(pB0, pB1, NT - 1); partialSM(pB0, pB1, m_reg, mnB, alB); __syncthreads(); RESC(alB);
        finishSM(pB0, pB1, alB, l_reg, pa0, pa1, pa2, pa3); SBAR(); pv_tile<1>(o, vb0, pa0, pa1, pa2, pa3); }
    SBAR(); SEAM_K0();
    const int mode = cur.mode;
    if (mode == 1) {
        float* P = cur.part;
#pragma unroll
        for (int r = 0; r < 16; ++r) { const int prow = wid * QBLK + crow(r, hi);
#pragma unroll
            for (int d0 = 0; d0 < 4; ++d0) __hip_atomic_store(P + (size_t)prow * 128 + d0 * 32 + r32, o[d0][r], __ATOMIC_RELAXED, __HIP_MEMORY_SCOPE_AGENT); }
        if (hi == 0) { __hip_atomic_store(P + 32768 + wid * QBLK + r32, m_reg, __ATOMIC_RELAXED, __HIP_MEMORY_SCOPE_AGENT); __hip_atomic_store(P + 32768 + 256 + wid * QBLK + r32, l_reg, __ATOMIC_RELAXED, __HIP_MEMORY_SCOPE_AGENT); }
        VMW();
        __syncthreads();
        if (tid == 0) __hip_atomic_store(cur.flag, 1u, __ATOMIC_RELAXED, __HIP_MEMORY_SCOPE_AGENT);
    } else {
        float w_own;
        if (mode == 2) {
            if (tid == 0) { unsigned sp = 0; while (__hip_atomic_load(cur.flag, __ATOMIC_RELAXED, __HIP_MEMORY_SCOPE_AGENT) == 0u) { __builtin_amdgcn_s_sleep(8); if (++sp > (1u << 22)) break; } }
            __syncthreads();
            const float* P = cur.part;
            const float m0 = __hip_atomic_load(P + 32768 + wid * QBLK + r32, __ATOMIC_RELAXED, __HIP_MEMORY_SCOPE_AGENT), l0 = __hip_atomic_load(P + 32768 + 256 + wid * QBLK + r32, __ATOMIC_RELAXED, __HIP_MEMORY_SCOPE_AGENT);
            const float M = fmaxf(m0, m_reg), e0 = __builtin_amdgcn_exp2f((m0 - M) * C2), e1 = __builtin_amdgcn_exp2f((m_reg - M) * C2), inv = 1.0f / (e0 * l0 + e1 * l_reg);
            w_own = e1 * inv; if (hi == 0) al_l[r32] = e0 * inv;
        } else { w_own = 1.0f / l_reg; }
        if (hi == 0) li_l[r32] = w_own;
        asm volatile("s_waitcnt lgkmcnt(0)" ::: "memory");
        bf16_t* Ow = cur.O + (size_t)(wid * QBLK) * LDO;
#pragma unroll
        for (int r = 0; r < 16; ++r) { const int orow = crow(r, hi); const float wr_ = li_l[orow];
            float w0_ = 0.f; if (mode == 2) w0_ = al_l[orow];
#pragma unroll
            for (int d0 = 0; d0 < 4; ++d0) { float v = o[d0][r] * wr_;
                if (mode == 2) v += w0_ * __hip_atomic_load(cur.part + (size_t)(wid * QBLK + orow) * 128 + d0 * 32 + r32, __ATOMIC_RELAXED, __HIP_MEMORY_SCOPE_AGENT);
                const float vn = xl::xor1(v);
                if ((r32 & 1) == 0) *(unsigned*)(Ow + (size_t)orow * LDO + d0 * 32 + r32) = cvtpk(v, vn); } }
        __syncthreads();
    }
#undef RESC
#undef KBASE
#undef MASKT
#undef SEAM_K0
#undef HALF_STEP
}
#undef ROW
#undef VMW
#undef VMWN
#undef SLOAD_H
#undef SWRITE_HK
#undef SWRITE_HV
#undef SWRITE_H
#undef KSWZ
#undef SBAR
}

namespace sa {
typedef unsigned short bf16_t;
typedef short bf16x8 __attribute__((ext_vector_type(8)));
typedef float f32x4 __attribute__((ext_vector_type(4)));
typedef unsigned u32x4 __attribute__((ext_vector_type(4)));
typedef unsigned u32x2 __attribute__((ext_vector_type(2)));
constexpr int LD = 1024;
constexpr float C2 = 0.08838834764831845f * 1.4426950408889634f;
constexpr int PART_OFF = 36864, PART_STRIDE = 8320;
struct Item { const float* Kc; const float* Vc; int nk; const float* Kn; const float* Vn; const bf16_t* Q; bf16_t* O; };
__device__ __forceinline__ unsigned cvtpk(float lo, float hi) { return cvt_pk_bf16_rne(lo, hi); }
__device__ __forceinline__ bf16x8 pack8(f32x4 a, f32x4 b) { u32x4 w = {cvtpk(a[0], a[1]), cvtpk(a[2], a[3]), cvtpk(b[0], b[1]), cvtpk(b[2], b[3])}; return *reinterpret_cast<bf16x8*>(&w); }
struct TileRegs { f32x4 ka[4][2]; f32x4 va[4][2]; };
__device__ __forceinline__ void tile_load(TileRegs& T, const float* K, const float* V, int lane) {
    const int q = lane & 15, g = lane >> 4;
    const float* kp = K + (size_t)q * LD + 4 * g;
#pragma unroll
    for (int s = 0; s < 4; ++s) { T.ka[s][0] = __builtin_nontemporal_load((const f32x4*)(kp + 32 * s)); T.ka[s][1] = __builtin_nontemporal_load((const f32x4*)(kp + 32 * s + 16)); }
#pragma unroll
    for (int v = 0; v < 4; ++v) { const float* vp = V + (size_t)(4 * g + v) * LD + 4 * q; T.va[v][0] = __builtin_nontemporal_load((const f32x4*)vp); T.va[v][1] = __builtin_nontemporal_load((const f32x4*)(vp + 64)); }
}
template <bool ISNEW>
__device__ __forceinline__ void tile_compute(const TileRegs& T, const bf16x8 (&qf)[4], const float* bias_t, f32x4 (&o)[8], float& m, float& l, int lane) {
    const int q = lane & 15, g = lane >> 4;
    f32x4 s4 = {0.f, 0.f, 0.f, 0.f};
#pragma unroll
    for (int s = 0; s < 4; ++s) s4 = __builtin_amdgcn_mfma_f32_16x16x32_bf16(pack8(T.ka[s][0], T.ka[s][1]), qf[s], s4, 0, 0, 0);
    const f32x4 b = *(const f32x4*)(bias_t + 4 * g);
    float t[4];
#pragma unroll
    for (int v = 0; v < 4; ++v) { t[v] = fmaf(s4[v], C2, b[v]); if (ISNEW && (4 * g + v) > q) t[v] = -__builtin_inff(); }
    float pmax = fmaxf(fmaxf(t[0], t[1]), fmaxf(t[2], t[3]));
    pmax = xl::max_xor16(pmax); pmax = xl::max_xor32(pmax);
    const float mn = fmaxf(m, pmax), alpha = __builtin_amdgcn_exp2f(m - mn); m = mn;
    float p[4];
#pragma unroll
    for (int v = 0; v < 4; ++v) p[v] = __builtin_amdgcn_exp2f(t[v] - mn);
    l = l * alpha + ((p[0] + p[1]) + (p[2] + p[3]));
    if (__any(alpha != 1.f)) {
#pragma unroll
        for (int j = 0; j < 8; ++j) o[j] = o[j] * alpha; }
#pragma unroll
    for (int v = 0; v < 4; ++v)
#pragma unroll
        for (int j = 0; j < 8; ++j) o[j] = __builtin_amdgcn_mfma_f32_16x16x4f32(T.va[v][j >> 2][j & 3], p[v], o[j], 0, 0, 0);
}
constexpr int PART_SLOT = 32 + 16 * 128;
__device__ __forceinline__ void run_part(const Item& it, int tb, int te, bool with_new, float* slot, char* lds, const int wv) {
    int tid_ = wv * 64 + (int)__builtin_amdgcn_mbcnt_hi(~0u, __builtin_amdgcn_mbcnt_lo(~0u, 0u)); asm volatile("" : "+v"(tid_)); const int tid = tid_, wid = __builtin_amdgcn_readfirstlane(tid >> 6), lane = tid & 63, q = lane & 15, g = lane >> 4;
    const float* bias = (const float*)lds;
    bf16x8 qf[4];
#pragma unroll
    for (int s = 0; s < 4; ++s) { const u32x2 qa = *(const u32x2*)(it.Q + (size_t)q * LD + 32 * s + 4 * g), qb = *(const u32x2*)(it.Q + (size_t)q * LD + 32 * s + 16 + 4 * g);
        const u32x4 w = {qa.x, qa.y, qb.x, qb.y}; qf[s] = *reinterpret_cast<const bf16x8*>(&w); }
    f32x4 o[8];
#pragma unroll
    for (int j = 0; j < 8; ++j) o[j] = (f32x4){0.f, 0.f, 0.f, 0.f};
    float m = -1e30f, l = 0.f;
    const int per = (te - tb) >> 3, t0 = tb + wid * per, t1 = t0 + per;
    TileRegs A, B;
    tile_load(A, it.Kc + (size_t)t0 * 16 * LD, it.Vc + (size_t)t0 * 16 * LD, lane);
    tile_load(B, it.Kc + (size_t)(t0 + 1) * 16 * LD, it.Vc + (size_t)(t0 + 1) * 16 * LD, lane);
    for (int t = t0; t < t1; t += 2) {
        tile_compute<false>(A, qf, bias + t * 16, o, m, l, lane);
        { const int tn = (t + 2 < t1) ? t + 2 : t1 - 1; tile_load(A, it.Kc + (size_t)tn * 16 * LD, it.Vc + (size_t)tn * 16 * LD, lane); }
        tile_compute<false>(B, qf, bias + (t + 1) * 16, o, m, l, lane);
        { const int tn = (t + 3 < t1) ? t + 3 : t1 - 1; tile_load(B, it.Kc + (size_t)tn * 16 * LD, it.Vc + (size_t)tn * 16 * LD, lane); }
    }
    if (with_new && wid == 7) { tile_load(A, it.Kn, it.Vn, lane); tile_compute<true>(A, qf, bias + it.nk, o, m, l, lane); }
    l = xl::sum_xor16(l); l = xl::sum_xor32(l);
    float* part = (float*)(lds + PART_OFF + wid * PART_STRIDE);
    if (g == 0) { part[q] = m; part[16 + q] = l; }
#pragma unroll
    for (int j = 0; j < 8; ++j)
#pragma unroll
        for (int v = 0; v < 4; ++v) part[32 + q * 128 + (j < 4 ? 0 : 64) + 16 * g + 4 * v + (j & 3)] = o[j][v];
    __syncthreads();
    {   const int qq = tid >> 5, d4 = (tid & 31) * 4;
        float mw[8], M = -1e30f;
#pragma unroll
        for (int w = 0; w < 8; ++w) { mw[w] = ((const float*)(lds + PART_OFF + w * PART_STRIDE))[qq]; M = fmaxf(M, mw[w]); }
        float den = 0.f; f32x4 num = {0.f, 0.f, 0.f, 0.f};
#pragma unroll
        for (int w = 0; w < 8; ++w) { const float* pw = (const float*)(lds + PART_OFF + w * PART_STRIDE); const float e = __builtin_amdgcn_exp2f(mw[w] - M);
            den += e * pw[16 + qq]; num += *(const f32x4*)(pw + 32 + qq * 128 + d4) * e; }
        if ((tid & 31) == 0) { __hip_atomic_store(slot + qq, M, __ATOMIC_RELAXED, __HIP_MEMORY_SCOPE_AGENT); __hip_atomic_store(slot + 16 + qq, den, __ATOMIC_RELAXED, __HIP_MEMORY_SCOPE_AGENT); }
#pragma unroll
        for (int e = 0; e < 4; ++e) __hip_atomic_store(slot + 32 + qq * 128 + d4 + e, num[e], __ATOMIC_RELAXED, __HIP_MEMORY_SCOPE_AGENT); }
    __syncthreads();
}
template <int NP>
__device__ __forceinline__ void combine_row(const float* slot0, int q, bf16_t* orow, int lane) {
    const float* sl = slot0 + (size_t)(lane < NP ? lane : 0) * PART_SLOT;
    float mp = __hip_atomic_load(sl + q, __ATOMIC_RELAXED, __HIP_MEMORY_SCOPE_AGENT), lp = __hip_atomic_load(sl + 16 + q, __ATOMIC_RELAXED, __HIP_MEMORY_SCOPE_AGENT);
    if (lane >= NP) { mp = -1e30f; lp = 0.f; }
    unsigned long long v[NP];
#pragma unroll
    for (int p = 0; p < NP; ++p) v[p] = __hip_atomic_load((const unsigned long long*)(slot0 + (size_t)p * PART_SLOT + 32 + q * 128 + 2 * lane), __ATOMIC_RELAXED, __HIP_MEMORY_SCOPE_AGENT);
    const float M = xl::wave_max(mp);
    float e = __builtin_amdgcn_exp2f(mp - M); if (lane >= NP) e = 0.f;
    const float den = xl::wave_sum(e * lp);
    float n0 = 0.f, n1 = 0.f;
#pragma unroll
    for (int p = 0; p < NP; ++p) { const float ep = __int_as_float(__builtin_amdgcn_readlane(__float_as_int(e), p)); n0 += ep * __uint_as_float((unsigned)v[p]); n1 += ep * __uint_as_float((unsigned)(v[p] >> 32)); }
    const float inv = 1.0f / den;
    *(unsigned*)(orow + 2 * lane) = cvtpk(n0 * inv, n1 * inv);
}
}
namespace sk {
typedef unsigned short bf16_t;
typedef short bf16x8 __attribute__((ext_vector_type(8)));
typedef float f32x4 __attribute__((ext_vector_type(4)));
constexpr int ROW0 = 8192, NRG = 5;
struct Frags { bf16x8 a[4]; bf16x8 w[4]; };
__device__ __forceinline__ void load_frags(Frags& F, const bf16_t* ap, const bf16_t* wp, int K  ) {
#pragma unroll
    for (int i = 0; i < 4; ++i) { F.a[i] = *(const bf16x8*)(ap + (size_t)i * 16 * K); F.w[i] = *(const bf16x8*)(wp + (size_t)i * 16 * K); }
}
__device__ __forceinline__ void mma_frags(const Frags& F, f32x4 (&acc)[4][4]) {
#pragma unroll
    for (int i = 0; i < 4; ++i)
#pragma unroll
        for (int cb = 0; cb < 4; ++cb) acc[i][cb] = __builtin_amdgcn_mfma_f32_16x16x32_bf16(F.w[cb], F.a[i], acc[i][cb], 0, 0, 0);
}
__device__ __forceinline__ void job(const bf16_t* A, const bf16_t* Bt, int K, int ld  , int rg, int n0, char* lds, const int wv, f32x4& out0, f32x4& out1) {
    int tid_ = wv * 64 + (int)__builtin_amdgcn_mbcnt_hi(~0u, __builtin_amdgcn_mbcnt_lo(~0u, 0u)); asm volatile("" : "+v"(tid_)); const int tid = tid_, wid = __builtin_amdgcn_readfirstlane(tid >> 6), lane = tid & 63, r = lane & 15, g = lane >> 4;
    const int kw = K >> 3, nks = kw >> 5;
    const bf16_t* ap = A + (size_t)(ROW0 + 64 * rg + r) * ld + wid * kw + 8 * g;
    const bf16_t* wp = Bt + (size_t)(n0 + r) * ld + wid * kw + 8 * g;
    f32x4 acc[4][4];
#pragma unroll
    for (int i = 0; i < 4; ++i)
#pragma unroll
        for (int cb = 0; cb < 4; ++cb) acc[i][cb] = (f32x4){0.f, 0.f, 0.f, 0.f};
    Frags F0, F1;
    load_frags(F0, ap, wp, ld);
    for (int ks = 0; ks < nks; ks += 2) {
        load_frags(F1, ap + (ks + 1) * 32, wp + (ks + 1) * 32, ld);
        mma_frags(F0, acc);
        { const int kn = (ks + 2 < nks) ? ks + 2 : nks - 1; load_frags(F0, ap + kn * 32, wp + kn * 32, ld); }
        mma_frags(F1, acc);
    }
    float* part = (float*)lds + (size_t)(wid * 64 + r) * 64 + 4 * g;
#pragma unroll
    for (int i = 0; i < 4; ++i)
#pragma unroll
        for (int cb = 0; cb < 4; ++cb) *(f32x4*)(part + (size_t)i * 16 * 64 + 16 * cb) = acc[i][cb];
    __syncthreads();
    { const int row = tid >> 3, c8 = (tid & 7) * 8; const float* p = (const float*)lds + (size_t)row * 64 + c8;
      f32x4 s0 = *(const f32x4*)p, s1 = *(const f32x4*)(p + 4);
#pragma unroll
      for (int w = 1; w < 8; ++w) { s0 += *(const f32x4*)(p + (size_t)w * 4096); s1 += *(const f32x4*)(p + (size_t)w * 4096 + 4); }
      out0 = s0; out1 = s1; }
    __syncthreads();
}
}
#define GAS __attribute__((address_space(1)))
#define LAS __attribute__((address_space(3)))
typedef unsigned short bf16;
typedef unsigned v4u __attribute__((ext_vector_type(4)));
typedef float f32x4 __attribute__((ext_vector_type(4)));
typedef short bf16x8 __attribute__((ext_vector_type(8)));
typedef GAS unsigned gu32;
typedef GAS unsigned long long gu64;
#define RLX_AGENT __ATOMIC_RELAXED, __HIP_MEMORY_SCOPE_AGENT
#define LDS_WAIT() asm volatile("s_waitcnt lgkmcnt(0)" ::: "memory")
#define VM_WAIT() asm volatile("s_waitcnt vmcnt(0)" ::: "memory")
__device__ __forceinline__ unsigned long long rt() { return __builtin_amdgcn_s_memrealtime(); }
__device__ __forceinline__ unsigned f2bf(float f) { unsigned u = __builtin_bit_cast(unsigned, f); return (u + 0x7fffu + ((u >> 16) & 1u)) >> 16; }
__device__ __forceinline__ unsigned pk2(float lo, float hi) { return cvt_pk_bf16_rne(lo, hi); }

#define XB_TMO      128
#define XB_XCNT(j)  (256  + 64 * (j))
#define XB_XSUB(j)  (1280 + 64 * (j))
#define XB_XGEN(j)  (2304 + 64 * (j))
#define XB_TOP      3328
#define XB_TOPGEN   3392
#define XCD_BAR_WORDS 3456
#define XB_SPIN_CAP (1u << 18)

__device__ __forceinline__ unsigned xb_ld(unsigned* p)              { return __hip_atomic_load(p, __ATOMIC_RELAXED, __HIP_MEMORY_SCOPE_AGENT); }
__device__ __forceinline__ unsigned xb_add(unsigned* p, unsigned v) { return __hip_atomic_fetch_add(p, v, __ATOMIC_RELAXED, __HIP_MEMORY_SCOPE_AGENT); }
__device__ __forceinline__ unsigned xb_xcc_id() { return (unsigned)__builtin_amdgcn_s_getreg((3 << 11) | 20) & 0xFu; }
#define XB_SPIN(cond, bar) do { unsigned _sp = 0; while (cond) { __builtin_amdgcn_s_sleep(1); \
    if ((++_sp & 255u) == 0u) { if (xb_ld(&(bar)[XB_TMO])) break; if (_sp > XB_SPIN_CAP) { atomicAdd(&(bar)[XB_TMO], 1u); break; } } } } while (0)

struct XcdBarrier {
    unsigned* bar; unsigned x;
    volatile LAS unsigned* st;
};

__device__ __forceinline__ XcdBarrier xcd_barrier_post(unsigned* bar, volatile LAS unsigned* st) {
    XcdBarrier b; b.bar = bar; b.x = xb_xcc_id(); b.st = st;
    if (threadIdx.x == 0) (void)xb_add(&bar[XB_XCNT(b.x)], 1u);
    return b;
}
__device__ __forceinline__ void xcd_barrier_complete(unsigned* bar, unsigned x, unsigned& nloc, unsigned& nx) {
    const unsigned G = gridDim.x * gridDim.y * gridDim.z;
    unsigned sum, cnt, mine, sp = 0u;
    for (;;) {
        sum = 0u; cnt = 0u; mine = 0u;
#pragma unroll
        for (unsigned j = 0; j < 16; ++j) { const unsigned c = xb_ld(&bar[XB_XCNT(j)]); sum += c; cnt += (c > 0u) ? 1u : 0u; mine = (j == x) ? c : mine; }
        if (sum == G) break;
        __builtin_amdgcn_s_sleep(1);
        if ((++sp & 255u) == 0u) { if (xb_ld(&bar[XB_TMO])) break; if (sp > XB_SPIN_CAP) { atomicAdd(&bar[XB_TMO], 1u); break; } }
    }
    nloc = mine > 0u ? mine : 1u; nx = cnt > 0u ? cnt : 1u;
}

__device__ __forceinline__ void xcd_barrier(const XcdBarrier& b) {
    asm volatile("s_waitcnt vmcnt(0)" ::: "memory");
    __syncthreads();
    if (threadIdx.x == 0) {
        unsigned* bar = b.bar;
        __builtin_amdgcn_s_waitcnt(0);
        unsigned nloc = b.st[0], nx = b.st[1];
        if (nloc == 0u) { xcd_barrier_complete(bar, b.x, nloc, nx); b.st[0] = nloc; b.st[1] = nx; }
        const unsigned old = xb_add(&bar[XB_XSUB(b.x)], 1u);
        const unsigned gen = old / nloc;
        if (old + 1u == (gen + 1u) * nloc) {
            __builtin_amdgcn_fence(__ATOMIC_RELEASE, "agent");
            asm volatile("s_waitcnt vmcnt(0)" ::: "memory");
            const unsigned og = xb_add(&bar[XB_TOP], 1u);
            const unsigned tg = og / nx;
            if (og + 1u == (tg + 1u) * nx) xb_add(&bar[XB_TOPGEN], 1u);
            else XB_SPIN(xb_ld(&bar[XB_TOPGEN]) == tg, bar);
            __builtin_amdgcn_fence(__ATOMIC_ACQUIRE, "agent");
            asm volatile("s_waitcnt vmcnt(0)" ::: "memory");
        } else {
            XB_SPIN(xb_ld(&bar[XB_TOPGEN]) == gen, bar);
            __builtin_amdgcn_fence(__ATOMIC_ACQUIRE, "agent");
            asm volatile("s_waitcnt vmcnt(0)" ::: "memory");
        }
    }
    __syncthreads();
}
using pg8::MP; using pg8::MREAL; using pg8::NSAMP; using pg8::LPR; using pg8::SROW0;
constexpr int NWAVES = 8;
constexpr size_t MiB = 1u << 20;
constexpr size_t WS_CTL = 0, CTL_ZERO_BYTES = 1 * MiB;
constexpr int CW_BAR = 4096;
constexpr int CW_CNT = 12288;
constexpr int CW_FLAG = 16384;
constexpr size_t SSQ_OFF = 808 * MiB;
constexpr size_t WS_BIAS1 = 1 * MiB;
constexpr size_t WS_W1T = 2 * MiB, WS_WPCT = 84 * MiB, WS_WPAT = 92 * MiB, WS_WOT = 100 * MiB, WS_WUPT = 116 * MiB, WS_WDNT = 180 * MiB;
constexpr size_t WS_X = 212 * MiB, WS_XB = 280 * MiB, WS_Q = 314 * MiB, WS_K = 331 * MiB, WS_V = 348 * MiB, WS_P = 365 * MiB, WS_BC = 382 * MiB, WS_YC = 399 * MiB, WS_YA = 416 * MiB;
constexpr size_t WS_SGC = 433 * MiB, WS_SGA = 467 * MiB, WS_T1 = 501 * MiB, WS_MG = 569 * MiB, WS_U = 603 * MiB, WS_G = 739 * MiB, WS_LOGF = 807 * MiB, WS_PART = 814 * MiB, WS_CPART = 832 * MiB, WS_HALO = 838 * MiB, WS_PH = 858 * MiB, WS_END = 864 * MiB;
static_assert(WS_W1T + 2ull * 10496 * 2048 * 2 <= WS_WPCT && WS_WUPT + 2ull * 8192 * 2048 * 2 <= WS_WDNT && WS_WDNT + 2ull * 2048 * 4096 * 2 <= WS_X, "weight map");
static_assert(WS_X + (size_t)MP * 2048 * 4 <= WS_XB && WS_XB + (size_t)MP * 2048 * 2 <= WS_Q && WS_Q + (size_t)MP * 1024 * 2 <= WS_K && WS_T1 + (size_t)MP * 2048 * 4 <= WS_MG, "activation map");
static_assert(WS_U + (size_t)MP * 8192 * 2 <= WS_G && WS_G + (size_t)MP * 4096 * 2 <= WS_LOGF && WS_LOGF + (size_t)MP * 8 * 4 <= SSQ_OFF && SSQ_OFF + 5ull * MP * 32 * 4 <= WS_PART && WS_PART + 128ull * pa::PART_FLOATS * 4 <= WS_CPART && WS_CPART + 512ull * sa::PART_SLOT * 4 <= WS_HALO && WS_HALO + (size_t)pg8::HALO_SLOTS * 8192 * 4 <= WS_PH && WS_PH + (size_t)pg8::HALO_SLOTS * 2048 * 4 <= WS_END && (CW_FLAG + 2 * 128 * 64) * 4 <= (int)CTL_ZERO_BYTES, "map");
constexpr int RING_OFF = 0, RING_BYTES = 131072;
constexpr int LDS_BYTES = 147456, LDSCTL_OFF = 146944;
constexpr int RST_OFF = 131072;
constexpr int ATT_BIAS_OFF = 69632;
constexpr int SCAN_SCR_OFF = 103424;
constexpr int TR_PITCH = 65, TR_BYTES = 64 * TR_PITCH * 4;
static_assert(NWAVES * TR_BYTES <= LDSCTL_OFF && pa::LDS_ATT <= ATT_BIAS_OFF && ATT_BIAS_OFF + 8448 * 4 <= SCAN_SCR_OFF && sa::PART_OFF + 8 * sa::PART_STRIDE <= SCAN_SCR_OFF, "LDS map");
constexpr float LOG2E = 1.4426950408889634f;
constexpr int IDLE1 = 34 * 41 - 5 * 256, IDLE5 = 34 * 32 - 4 * 256;

struct Frame {
    LAS unsigned char* lds; volatile LAS unsigned* MISC; gu32* ctl;
    int wv, G, bx;
};
__device__ __forceinline__ int opaque_s(int v) { asm volatile("" : "+s"(v)); return v; }
__device__ __forceinline__ int lane_id() { return (int)__builtin_amdgcn_mbcnt_hi(~0u, __builtin_amdgcn_mbcnt_lo(~0u, 0u)); }
__device__ __forceinline__ int phase_tid(const Frame& F) { int t = F.wv * 64 + lane_id(); asm volatile("" : "+v"(t)); return t; }
struct MapIdent { __device__ __forceinline__ int operator()(int n) const { return n; } };
struct MapIn { __device__ __forceinline__ int operator()(int n) const {
    const int T = n >> 8, c = n & 255;
    if (T < 16) { const int bj = c >> 7, wc = (c >> 5) & 3, nn = (c >> 4) & 1, fq = (c >> 2) & 3, e = c & 3; return (bj * 2 + nn) * 1024 + 64 * T + 16 * wc + 4 * fq + e; }
    if (T < 24) return 4096 + ((T - 16) << 8) + c;
    if (T < 40) return 6152 + (c >> 7) * 2048 + 128 * (T - 24) + (c & 127);
    return c < 8 ? 6144 + c : -1; } };
struct MapUp { __device__ __forceinline__ int operator()(int n) const { const int T = n >> 8, c = n & 255; return (c >> 7) * 4096 + 128 * T + (c & 127); } };
struct TrItem { f32x4 v[16]; };
template <class Map>
__device__ __forceinline__ void tr_load(TrItem& T, const float* __restrict__ W, int Nsrc, int k0, int n0, int lane, Map map) {
    const int nloc = (lane & 15) * 4, src = map(n0 + nloc), kr = lane >> 4;
#pragma unroll
    for (int i = 0; i < 16; ++i) { const int kk = kr + 4 * i; T.v[i] = src >= 0 ? *(const GAS f32x4*)(W + (size_t)(k0 + kk) * Nsrc + src) : (f32x4){0.f, 0.f, 0.f, 0.f}; }
}
__device__ __forceinline__ void tr_store(const TrItem& T, int K  , const float* __restrict__ gsc, bf16* __restrict__ WT, int k0, int n0, LAS float* scr, int lane) {
    const int nloc = (lane & 15) * 4, kr = lane >> 4;
#pragma unroll
    for (int i = 0; i < 16; ++i) { const int kk = kr + 4 * i; const float g = gsc ? gsc[k0 + kk] : 1.0f; LAS float* s = scr + kk * TR_PITCH + nloc;
        s[0] = T.v[i][0] * g; s[1] = T.v[i][1] * g; s[2] = T.v[i][2] * g; s[3] = T.v[i][3] * g; }
    const int c = lane & 7;
#pragma unroll
    for (int j = 0; j < 8; ++j) { const int n = (lane >> 3) + 8 * j; const LAS float* s = scr + (8 * c) * TR_PITCH + n;
        v4u o; o.x = pk2(s[0 * TR_PITCH], s[1 * TR_PITCH]); o.y = pk2(s[2 * TR_PITCH], s[3 * TR_PITCH]); o.z = pk2(s[4 * TR_PITCH], s[5 * TR_PITCH]); o.w = pk2(s[6 * TR_PITCH], s[7 * TR_PITCH]);
        *(GAS v4u*)(WT + (size_t)(n0 + n) * K + k0 + 8 * c) = o; }
}
template <class Map>
__device__ __forceinline__ void transpose_matrix(Frame& F, const int vbx, const int vG, const float* W, int K, int Nsrc, int Ndst, const float* gsc, bf16* WT, Map map, int ldw = 0  ) {
    LAS float* scr = (LAS float*)(F.lds + F.wv * TR_BYTES); const int lane = phase_tid(F) & 63;
    const int nkb = K / 64, nnb = Ndst / 64, nsn = nnb >> 1, nst = (nkb >> 2) * nsn, G = vG, kbo = F.wv >> 1, nbo = F.wv & 1;
    if (vbx >= nst) return;
    const int pitch = ldw ? ldw : K;
    TrItem A, B;
#define TR_K0(st) ((4 * ((st) / nsn) + kbo) * 64)
#define TR_N0(st) ((2 * ((st) % nsn) + nbo) * 64)
    tr_load(A, W, Nsrc, TR_K0(vbx), TR_N0(vbx), lane, map);
    for (int st = vbx; st < nst; st += 2 * G) {
        const int s1 = st + G < nst ? st + G : st, s2 = st + 2 * G < nst ? st + 2 * G : s1;
        tr_load(B, W, Nsrc, TR_K0(s1), TR_N0(s1), lane, map);
        tr_store(A, pitch, gsc, WT, TR_K0(st), TR_N0(st), scr, lane);
        tr_load(A, W, Nsrc, TR_K0(s2), TR_N0(s2), lane, map);
        if (st + G < nst) tr_store(B, pitch, gsc, WT, TR_K0(s1), TR_N0(s1), scr, lane);
    }
#undef TR_K0
#undef TR_N0
}
typedef __attribute__((address_space(4))) const unsigned char* kptr_t;
__device__ __forceinline__ kptr_t kargs() { kptr_t p = (kptr_t)__builtin_amdgcn_kernarg_segment_ptr(); asm volatile("" : "+s"(p)); return p; }
#define ARG_IN(i) (*(const __attribute__((address_space(4))) float* const __attribute__((address_space(4)))*)(kargs() + 8 * (i)))
struct Args { const float* in[21]; float* out; unsigned char* ws; int pad0, pad1; };

__device__ __forceinline__ void phase_conv_yc(Frame& F, const bf16* P, const bf16* BC, bf16* YC, const float* wconv  , const float* state  ) {
    const int NT = F.G * NWAVES * 64, t0 = F.bx * NWAVES * 64 + phase_tid(F);
    for (int idx = t0; idx < MREAL * 128; idx += NT) {
        const int row = idx >> 7, c8 = (idx & 127) * 8;
        const v4u bcv = *(const GAS v4u*)(BC + (size_t)row * 1024 + c8), p0v = *(const GAS v4u*)(P + (size_t)row * 1024 + c8);
        float pm1[8], pm2[8];
        int t; const float* st = nullptr;
        if (row >= SROW0) { t = (row - SROW0) & 15; st = state + (size_t)((row - SROW0) >> 4) * 2048 + c8; } else { t = row; }
        if (t >= 1) { const v4u w = *(const GAS v4u*)(P + (size_t)(row - 1) * 1024 + c8);
#pragma unroll
            for (int e = 0; e < 4; ++e) { pm1[2 * e] = __uint_as_float(w[e] << 16); pm1[2 * e + 1] = __uint_as_float(w[e] & 0xffff0000u); } }
        else {
#pragma unroll
            for (int e = 0; e < 8; ++e) pm1[e] = st ? st[1024 + e] : 0.f; }
        if (t >= 2) { const v4u w = *(const GAS v4u*)(P + (size_t)(row - 2) * 1024 + c8);
#pragma unroll
            for (int e = 0; e < 4; ++e) { pm2[2 * e] = __uint_as_float(w[e] << 16); pm2[2 * e + 1] = __uint_as_float(w[e] & 0xffff0000u); } }
        else {
#pragma unroll
            for (int e = 0; e < 8; ++e) pm2[e] = st ? st[(t == 1 ? 1024 : 0) + e] : 0.f; }
        float y[8];
#pragma unroll
        for (int e = 0; e < 8; ++e) { const unsigned pw = p0v[e >> 1], bw = bcv[e >> 1];
            const float p0 = (e & 1) ? __uint_as_float(pw & 0xffff0000u) : __uint_as_float(pw << 16), bcf = (e & 1) ? __uint_as_float(bw & 0xffff0000u) : __uint_as_float(bw << 16);
            y[e] = bcf * (wconv[c8 + e] * pm2[e] + wconv[1024 + c8 + e] * pm1[e] + wconv[2048 + c8 + e] * p0); }
        v4u o; o.x = pk2(y[0], y[1]); o.y = pk2(y[2], y[3]); o.z = pk2(y[4], y[5]); o.w = pk2(y[6], y[7]);
        *(GAS v4u*)(YC + (size_t)row * 1024 + c8) = o;
    }
}
__device__ __forceinline__ void load_u8(float (&d)[8], const bf16* p) { const v4u w = *(const GAS v4u*)p;
#pragma unroll
    for (int e = 0; e < 4; ++e) { d[2 * e] = __uint_as_float(w[e] << 16); d[2 * e + 1] = __uint_as_float(w[e] & 0xffff0000u); } }
__device__ __forceinline__ void phase_ffn_gate(Frame& F, const bf16* U, bf16* Gb, const float* wf  , const float* bfc  , const float* state  ) {
    const int NT = F.G * NWAVES * 64, t0 = F.bx * NWAVES * 64 + phase_tid(F);
    for (int idx = t0; idx < MREAL * 512; idx += NT) {
        const int row = idx >> 9, ch = (idx & 511) * 8, ua = 256 * (ch >> 7) + (ch & 127);
        float a0[8], a1[8], a2[8], b0[8], b1[8], b2[8];
        load_u8(a0, U + (size_t)row * 8192 + ua); load_u8(b0, U + (size_t)row * 8192 + ua + 128);
        int t; const float* st = nullptr;
        if (row >= SROW0) { t = (row - SROW0) & 15; st = state + (size_t)((row - SROW0) >> 4) * 2 * 8192; } else { t = row; }
        if (t >= 1) { load_u8(a1, U + (size_t)(row - 1) * 8192 + ua); load_u8(b1, U + (size_t)(row - 1) * 8192 + ua + 128); }
        else {
#pragma unroll
            for (int e = 0; e < 8; ++e) { a1[e] = st ? st[8192 + ch + e] : 0.f; b1[e] = st ? st[8192 + 4096 + ch + e] : 0.f; } }
        if (t >= 2) { load_u8(a2, U + (size_t)(row - 2) * 8192 + ua); load_u8(b2, U + (size_t)(row - 2) * 8192 + ua + 128); }
        else { const int so = (t == 1) ? 8192 : 0;
#pragma unroll
            for (int e = 0; e < 8; ++e) { a2[e] = st ? st[so + ch + e] : 0.f; b2[e] = st ? st[so + 4096 + ch + e] : 0.f; } }
        float y[8];
        float w0a[8], w1a[8], w2a[8], bsa[8], w0b[8], w1b[8], w2b[8], bsb[8];
#define LD8(dst, p) do { const f32x4 q0_ = *(const GAS f32x4*)(p), q1_ = *(const GAS f32x4*)((p) + 4); dst[0] = q0_[0]; dst[1] = q0_[1]; dst[2] = q0_[2]; dst[3] = q0_[3]; dst[4] = q1_[0]; dst[5] = q1_[1]; dst[6] = q1_[2]; dst[7] = q1_[3]; } while (0)
        LD8(w0a, wf + ch); LD8(w1a, wf + 8192 + ch); LD8(w2a, wf + 16384 + ch); LD8(bsa, bfc + ch);
        LD8(w0b, wf + 4096 + ch); LD8(w1b, wf + 8192 + 4096 + ch); LD8(w2b, wf + 16384 + 4096 + ch); LD8(bsb, bfc + 4096 + ch);
#undef LD8
#pragma unroll
        for (int e = 0; e < 8; ++e) {
            const float A = w0a[e] * a2[e] + w1a[e] * a1[e] + w2a[e] * a0[e] + bsa[e];
            const float B = w0b[e] * b2[e] + w1b[e] * b1[e] + w2b[e] * b0[e] + bsb[e];
            y[e] = A * pg8::sigmoidf_(A) * B; }
        v4u o; o.x = pk2(y[0], y[1]); o.y = pk2(y[2], y[3]); o.z = pk2(y[4], y[5]); o.w = pk2(y[6], y[7]);
        *(GAS v4u*)(Gb + (size_t)row * 4096 + ch) = o;
    }
}
__device__ __forceinline__ void phase_yc_fixup(Frame& F, const float* PH, bf16* YC, const float* wconv  , const float* state  ) {
    const int NT = F.G * NWAVES * 64, t0 = F.bx * NWAVES * 64 + phase_tid(F);
    for (int idx = t0; idx < 290 * 128; idx += NT) {
        const int ri = idx >> 7, ch = (idx & 127) * 8;
        const int row = ri < 256 ? (ri >> 1) * 64 + (ri & 1) : 8192 + ((ri - 256) >> 1) * 16 + ((ri - 256) & 1);
        const float* u0 = PH + (size_t)pg8::halo_slot(row) * 2048; const float* u1 = nullptr; const float* u2 = nullptr;
        if (row < SROW0) { if (row >= 1) u1 = PH + (size_t)pg8::halo_slot(row - 1) * 2048; if (row >= 2) u2 = PH + (size_t)pg8::halo_slot(row - 2) * 2048; }
        else { const int t = (row - SROW0) & 15; const float* st = state + (size_t)((row - SROW0) >> 4) * 2048;
            if (t == 0) { u1 = st + 1024; u2 = st; } else { u1 = PH + (size_t)pg8::halo_slot(row - 1) * 2048; u2 = st + 1024; } }
        float y[8];
#pragma unroll
        for (int e = 0; e < 8; ++e) { const int c = ch + e; y[e] = u0[1024 + c] * (wconv[c] * (u2 ? u2[c] : 0.f) + wconv[1024 + c] * (u1 ? u1[c] : 0.f) + wconv[2048 + c] * u0[c]); }
        v4u o; o.x = pk2(y[0], y[1]); o.y = pk2(y[2], y[3]); o.z = pk2(y[4], y[5]); o.w = pk2(y[6], y[7]);
        *(GAS v4u*)(YC + (size_t)row * 2048 + ch) = o;
    }
}
__device__ __forceinline__ void phase_ffn_fixup(Frame& F, const float* HALO, bf16* Gb, const float* wf  , const float* bfc  , const float* state  ) {
    const int NT = F.G * NWAVES * 64, t0 = F.bx * NWAVES * 64 + phase_tid(F);
    for (int idx = t0; idx < 290 * 512; idx += NT) {
        const int ri = idx >> 9, ch = (idx & 511) * 8;
        const int row = ri < 256 ? (ri >> 1) * 64 + (ri & 1) : 8192 + ((ri - 256) >> 1) * 16 + ((ri - 256) & 1);
        const float* u0 = HALO + (size_t)pg8::halo_slot(row) * 8192; const float* u1 = nullptr; const float* u2 = nullptr;
        if (row < SROW0) { if (row >= 1) u1 = HALO + (size_t)pg8::halo_slot(row - 1) * 8192; if (row >= 2) u2 = HALO + (size_t)pg8::halo_slot(row - 2) * 8192; }
        else { const int t = (row - SROW0) & 15; const float* st = state + (size_t)((row - SROW0) >> 4) * 2 * 8192;
            if (t == 0) { u1 = st + 8192; u2 = st; } else { u1 = HALO + (size_t)pg8::halo_slot(row - 1) * 8192; u2 = st + 8192; } }
        float y[8];
#pragma unroll
        for (int e = 0; e < 8; ++e) { const int ca = ch + e, cb = 4096 + ch + e;
            const float A = wf[ca] * (u2 ? u2[ca] : 0.f) + wf[8192 + ca] * (u1 ? u1[ca] : 0.f) + wf[16384 + ca] * u0[ca] + bfc[ca];
            const float B = wf[cb] * (u2 ? u2[cb] : 0.f) + wf[8192 + cb] * (u1 ? u1[cb] : 0.f) + wf[16384 + cb] * u0[cb] + bfc[cb];
            y[e] = A * pg8::sigmoidf_(A) * B; }
        v4u o; o.x = pk2(y[0], y[1]); o.y = pk2(y[2], y[3]); o.z = pk2(y[4], y[5]); o.w = pk2(y[6], y[7]);
        *(GAS v4u*)(Gb + (size_t)row * 4096 + ch) = o;
    }
}
template <int CH>
__device__ __forceinline__ void block_cumsum(const float* src, int stride, int n, float* dst, float* wtot, float scale, bool subT, int tid) {
    asm volatile("" : "+v"(tid));
    const int lane = tid & 63, wid = tid >> 6, i0 = tid * CH;
    float v[CH]; float run = 0.f;
#pragma unroll
    for (int j = 0; j < CH; ++j) { const int i = i0 + j; const float x = i < n ? src[(size_t)i * stride] : 0.f; run += x; v[j] = run; }
    const float inc = xl::wave_incl_scan(run, lane);
    if (lane == 63) wtot[wid] = inc;
    __syncthreads();
    float off = inc - run, tot = 0.f;
#pragma unroll
    for (int w = 0; w < 8; ++w) { const float x = wtot[w]; if (w < wid) off += x; tot += x; }
    const float sub = subT ? tot : 0.f;
#pragma unroll
    for (int j = 0; j < CH; ++j) if (i0 + j < n) dst[i0 + j] = scale * (off + v[j] - sub);
    __syncthreads();
}

__device__ __forceinline__ void unpack8(float (&d)[8], const v4u w) {
#pragma unroll
    for (int e = 0; e < 4; ++e) { d[2 * e] = __uint_as_float(w[e] << 16); d[2 * e + 1] = __uint_as_float(w[e] & 0xffff0000u); } }
__device__ __forceinline__ void skinny_merged(Frame& F, const bf16* YCA, const bf16* WCA, const bf16* RG, const unsigned char* SGA, bf16* MG, unsigned char* lds) {
    if (F.bx >= 160) return;
    const int rg = F.bx >> 5, n0 = (F.bx & 31) * 64, tid = phase_tid(F), row = sk::ROW0 + 64 * rg + (tid >> 3), col = n0 + (tid & 7) * 8;
    f32x4 a0, a1, b0, b1;
    sk::job(YCA, WCA, 1024, 2048, rg, n0, (char*)lds, F.wv, a0, a1);
    sk::job(YCA + 1024, WCA + 1024, 1024, 2048, rg, n0, (char*)lds, F.wv, b0, b1);
    if (row >= MREAL) return;
    float r[8], ga[8]; unpack8(r, *(const GAS v4u*)(RG + (size_t)row * 2048 + col));
    { const pg8::u32x2 gq = *(const GAS pg8::u32x2*)(SGA + (size_t)row * 2048 + col);
#pragma unroll
      for (int e = 0; e < 4; ++e) { ga[e] = (float)((gq.x >> (8 * e)) & 255u) * (1.0f / 255.0f); ga[4 + e] = (float)((gq.y >> (8 * e)) & 255u) * (1.0f / 255.0f); } }
    v4u o; o.x = pk2(ga[0] * (r[0] * a0[0] + b0[0]), ga[1] * (r[1] * a0[1] + b0[1])); o.y = pk2(ga[2] * (r[2] * a0[2] + b0[2]), ga[3] * (r[3] * a0[3] + b0[3]));
    o.z = pk2(ga[4] * (r[4] * a1[0] + b1[0]), ga[5] * (r[5] * a1[1] + b1[1])); o.w = pk2(ga[6] * (r[6] * a1[2] + b1[2]), ga[7] * (r[7] * a1[3] + b1[3]));
    *(GAS v4u*)(MG + (size_t)row * 2048 + col) = o;
}
__device__ __forceinline__ void skinny_res(Frame& F, const bf16* A, const bf16* Bt, int K, bf16* XB, float* ssq_next, unsigned char* lds) {
    if (F.bx >= 160) return;
    const int rg = F.bx >> 5, n0 = (F.bx & 31) * 64, tid = phase_tid(F), row = sk::ROW0 + 64 * rg + (tid >> 3), col = n0 + (tid & 7) * 8;
    f32x4 a0, a1;
    sk::job(A, Bt, K, K, rg, n0, (char*)lds, F.wv, a0, a1);
    if (row >= MREAL) return;
    float xo[8]; unpack8(xo, *(const GAS v4u*)(XB + (size_t)row * 2048 + col));
    const f32x4 x0 = (f32x4){xo[0], xo[1], xo[2], xo[3]} + a0, x1 = (f32x4){xo[4], xo[5], xo[6], xo[7]} + a1;
    v4u o; o.x = pk2(x0[0], x0[1]); o.y = pk2(x0[2], x0[3]); o.z = pk2(x1[0], x1[1]); o.w = pk2(x1[2], x1[3]);
    *(GAS v4u*)(XB + (size_t)row * 2048 + col) = o;
    float s = ((x0[0] * x0[0] + x0[1] * x0[1]) + (x0[2] * x0[2] + x0[3] * x0[3])) + ((x1[0] * x1[0] + x1[1] * x1[1]) + (x1[2] * x1[2] + x1[3] * x1[3]));
    s += xl::xor1(s); s += __int_as_float(__builtin_amdgcn_update_dpp(0, __float_as_int(s), 0x4E, 0xf, 0xf, true)); s += xl::row_shr<4>(s);
    if ((tid & 7) == 7) ssq_next[(size_t)row * 32 + (n0 >> 6)] = s;
}
__device__ __forceinline__ void part_arrive2(Frame& F, gu32* cnt_a, unsigned na, gu32* cnt_b, unsigned nb, bool& last_a, bool& last_b) {
    asm volatile("s_waitcnt vmcnt(0)" ::: "memory");
    __syncthreads();
    const int t = phase_tid(F);
    if (t < 2) F.MISC[12 + t] = __hip_atomic_fetch_add((unsigned*)(t == 0 ? cnt_a : cnt_b), 1u, __ATOMIC_RELAXED, __HIP_MEMORY_SCOPE_AGENT);
    __syncthreads();
    const unsigned oa = F.MISC[12], ob = F.MISC[13];
    __syncthreads();
    last_a = oa + 1u == na; last_b = ob + 1u == nb;
}
#define GRID_BAR() do { XcdBarrier b_ = bar; asm volatile("" : "+s"(b_.bar), "+s"(b_.x)); xcd_barrier(b_); } while (0)
#ifndef REP_PR
#define REP_PR 1
#endif
#ifndef REP_CH
#define REP_CH 1
#endif
#ifndef REP_CHS
#define REP_CHS 1
#endif
#ifndef REP_CHT
#define REP_CHT 1
#endif
#ifndef REP_P0
#define REP_P0 1
#endif
#ifndef REP_G1
#define REP_G1 1
#endif
#ifndef REP_ATT
#define REP_ATT 1
#endif
#ifndef REP_G4
#define REP_G4 1
#endif
#ifndef REP_E4
#define REP_E4 1
#endif
#ifndef REP_G2
#define REP_G2 1
#endif
#ifndef STOP_AFTER
#define STOP_AFTER 0
#endif
__device__ __forceinline__ void diag_dump(int k, int t0, int NT, float* out, unsigned char* ws) {
    const bf16* a = nullptr; const bf16* b = nullptr; const float* x = nullptr; int lda = 1024;
    if (k == 1) { a = (const bf16*)(ws + WS_Q); b = (const bf16*)(ws + WS_P); }
    else if (k == 2) { a = (const bf16*)(ws + WS_YA); b = (const bf16*)(ws + WS_YC); }
#if defined(DIAG_SEL) && DIAG_SEL == 1
    else if (k == 3) { const bf16* w = (const bf16*)(ws + WS_WPCT); const bf16* s = (const bf16*)(ws + WS_SGC);
        for (int i = t0; i < 4 * 1024 * 1024; i += NT) out[i] = __uint_as_float((unsigned)w[i] << 16);
        for (int i = t0; i < 6000 * 2048; i += NT) out[4 * 1024 * 1024 + i] = __uint_as_float((unsigned)s[i] << 16);
        return; }
#elif defined(DIAG_SEL) && DIAG_SEL == 2
    else if (k == 3) { const bf16* w = (const bf16*)(ws + WS_WPCT);
        for (int i = t0; i < 16 * 1024 * 1024; i += NT) out[i] = __uint_as_float((unsigned)w[i] << 16);
        return; }
#else
    else if (k == 3) { x = (const float*)(ws + WS_T1); }
#endif
    else if (k == 4) { a = (const bf16*)(ws + WS_MG); lda = 2048; }
    else if (k == 5 || k == 8) { x = (const float*)(ws + WS_X); }
    else if (k == 6) { a = (const bf16*)(ws + WS_U); lda = 8192; }
    else if (k == 7) { a = (const bf16*)(ws + WS_G); lda = 4096; }
    if (x) { for (int i = t0; i < 8192 * 2048; i += NT) out[i] = x[i]; return; }
    if (b) { for (int i = t0; i < 8192 * 1024; i += NT) { out[i] = __uint_as_float((unsigned)a[i] << 16); out[8192 * 1024 + i] = __uint_as_float((unsigned)b[i] << 16); } return; }
    for (int i = t0; i < 8192 * 2048; i += NT) { const int r = i / 2048, c = i % 2048; out[i] = __uint_as_float((unsigned)a[(size_t)r * lda + c] << 16); }
}
#define STOP_AT(k) do { if (STOP_AFTER != 0 && STOP_AFTER == 10 * l + (k)) { diag_dump(k, F.bx * NWAVES * 64 + phase_tid(F), F.G * NWAVES * 64, KOUT(), KWS()); return; } } while (0)
#define KARG_U64(off) (*(const __attribute__((address_space(4))) unsigned long long*)(kargs() + (off)))
#define KIN(i)  ((const float*)(const GAS float*)KARG_U64(8 * (i)))
#define KOUT()  ((float*)(GAS float*)KARG_U64(168))
#define KWS()   ((unsigned char*)(GAS unsigned char*)KARG_U64(176))
#define WSP(T, off) ((T*)(KWS() + (off)))
__global__ void __launch_bounds__(NWAVES * 64, 2) fwd_kernel(Args args) {
    extern __shared__ __attribute__((aligned(16))) unsigned char lds[];
    Frame F;
    F.lds = (LAS unsigned char*)lds; F.MISC = (volatile LAS unsigned*)(F.lds + LDSCTL_OFF);
    F.wv = __builtin_amdgcn_readfirstlane((int)threadIdx.x >> 6); F.G = gridDim.x; F.bx = blockIdx.x;
    F.ctl = (gu32*)(KWS() + WS_CTL);
    for (int u = threadIdx.x; u < (LDS_BYTES - LDSCTL_OFF) / 4; u += NWAVES * 64) ((LAS unsigned*)(F.lds + LDSCTL_OFF))[u] = 0u;
    __syncthreads();
    XcdBarrier bar = xcd_barrier_post((unsigned*)(F.ctl + CW_BAR), F.MISC + 8);

#ifndef SKIP_P0
    for (int rep_ = 0; rep_ < REP_P0; ++rep_) {
    transpose_matrix(F, F.bx, F.G, KIN(9), 2048, 10248, 10496, KIN(8), WSP(bf16, WS_W1T), MapIn());
    { const int NT = F.G * NWAVES * 64; MapIn mp; const float* b_in = KIN(10); float* BIAS1 = WSP(float, WS_BIAS1);
      for (int i = F.bx * NWAVES * 64 + phase_tid(F); i < 2 * 10496; i += NT) { const int l = i / 10496, n = i % 10496, s = mp(n); BIAS1[i] = s >= 0 ? b_in[l * 10248 + s] : 0.f; } }
    {   const int NGW = F.G * NWAVES, gw = NGW - 1 - (F.bx * NWAVES + F.wv), lane = phase_tid(F) & 63;
        const float* xs = KIN(1); const float* xm = KIN(7); const float* xp = KIN(0); bf16* XB = WSP(bf16, WS_XB); float* SSQ = WSP(float, SSQ_OFF);
        for (int m0 = gw; m0 < MP; m0 += 2 * NGW) {
            f32x4 v[2][8];
#pragma unroll
            for (int r = 0; r < 2; ++r) { const int m = m0 + r * NGW; const float* src = nullptr;
                if (m < 16) src = xm + (size_t)m * 2048; else if (m < LPR) src = xp + (size_t)(m - 16) * 2048; else if (m < MREAL) src = xs + (size_t)(m - SROW0) * 2048;
#pragma unroll
                for (int j = 0; j < 8; ++j) v[r][j] = src ? *(const GAS f32x4*)(src + 256 * j + 4 * lane) : (f32x4){0.f, 0.f, 0.f, 0.f}; }
#pragma unroll
            for (int r = 0; r < 2; ++r) { const int m = m0 + r * NGW; if (m >= MP) break; float s = 0.f;
#pragma unroll
                for (int j = 0; j < 8; ++j) { const f32x4 w = v[r][j];
                    *(GAS unsigned long long*)(XB + (size_t)m * 2048 + 256 * j + 4 * lane) = (unsigned long long)pk2(w[0], w[1]) | ((unsigned long long)pk2(w[2], w[3]) << 32);
                    s += (w[0] * w[0] + w[1] * w[1]) + (w[2] * w[2] + w[3] * w[3]); }
                s = xl::wave_sum(s); if (lane < 32) SSQ[(size_t)m * 32 + lane] = lane == 0 ? s : 0.f; }
        }
    }
    }
#endif
    GRID_BAR();

#pragma unroll 1
    for (int l = 0; l < 2; ++l) {
#ifndef SKIP_G1
        for (int rep_ = 0; rep_ < REP_G1; ++rep_) {
        {   pg8::Gemm g{WSP(bf16, WS_XB), WSP(bf16, WS_W1T) + (size_t)l * 10496 * 2048, MP, 10496, 2048}; pg8::StaticOrder S; S.init(MP, 10496, opaque_s(F.G), opaque_s(F.bx));
            pg8::EpiIn E{WSP(float, SSQ_OFF) + (size_t)(2 * l) * MP * 32, WSP(float, WS_BIAS1) + l * 10496, WSP(bf16, WS_YC), WSP(float, WS_PH), KIN(11) + l * 3072, WSP(bf16, WS_Q), WSP(bf16, WS_K), WSP(bf16, WS_V), WSP(bf16, WS_SGC), WSP(unsigned char, WS_SGA), WSP(float, WS_LOGF), KOUT(), l, (LAS float*)(F.lds + RST_OFF)};
            pg8::gemm_phase<pg8::EpiIn, pg8::StaticOrder, true, true>(F.lds + RING_OFF, g, S, E, F.wv); }
        if (F.bx >= IDLE1) {
            const int vb = F.bx - IDLE1, vg = F.G - IDLE1;
            if (l == 0) {
                transpose_matrix(F, vb, vg, KIN(12), 1024, 2048, 2048, nullptr, WSP(bf16, WS_WPCT), MapIdent(), 2048);
                transpose_matrix(F, vb, vg, KIN(13), 1024, 2048, 2048, nullptr, WSP(bf16, WS_WPCT) + 1024, MapIdent(), 2048);
                transpose_matrix(F, vb, vg, KIN(14), 2048, 2048, 2048, nullptr, WSP(bf16, WS_WOT), MapIdent()); }
            transpose_matrix(F, vb, vg, KIN(16) + (size_t)l * 2048 * 8192, 2048, 8192, 8192, KIN(15) + l * 2048, WSP(bf16, WS_WUPT) + (size_t)l * 8192 * 2048, MapUp());
            transpose_matrix(F, vb, vg, KIN(19) + (size_t)l * 4096 * 2048, 4096, 2048, 2048, nullptr, WSP(bf16, WS_WDNT) + (size_t)l * 2048 * 4096, MapIdent()); }
        if (rep_ + 1 < REP_G1) GRID_BAR();
        }
#endif
        GRID_BAR();
        STOP_AT(1);
        for (int rep_ = 0; rep_ < REP_ATT; ++rep_) {
#ifndef SKIP_CONV
        phase_yc_fixup(F, WSP(float, WS_PH), WSP(bf16, WS_YC), KIN(11) + l * 3072, KIN(5) + (size_t)l * 16 * 2048);
#endif
        {
            const int c_ = F.bx & 255;
#pragma unroll 1
            for (int step = 0; step < 2; ++step) {
                const bool do_chunk = (((c_ >> 3) & 1) != 0) == (step == 0);
                if (!do_chunk) {
#ifndef SKIP_PA
        for (int rpr_ = 0; rpr_ < REP_PR; ++rpr_)
        {
            float* bias = (float*)(lds + ATT_BIAS_OFF); float* wtot = (float*)(lds + SCAN_SCR_OFF);
            const bf16* Qb = WSP(bf16, WS_Q); bf16* YA = WSP(bf16, WS_YC) + 1024; const float* LOGF = WSP(float, WS_LOGF);
            const int c = F.bx & 255, h = c & 7, j = (c >> 3) >> 1, s = (c >> 3) & 1, cj = 62 - 4 * j, qbB = 31 - j;
            const bf16* Kp = WSP(bf16, WS_K) + h * 128; const bf16* Vp = WSP(bf16, WS_V) + h * 128;
            float* part = WSP(float, WS_PART) + (size_t)(h * 16 + j) * pa::PART_FLOATS; unsigned* flag = (unsigned*)(F.ctl + CW_FLAG) + (l * 128 + h * 16 + j) * 64;
            if (F.bx < 256) {
                const int nmax = 64 * (s ? (128 - 4 * j) : (4 * j + 4 > cj ? 4 * j + 4 : cj));
                block_cumsum<16>(LOGF + (size_t)h * MP, 1, nmax, bias, wtot, -1.0f / pa::SCALE, false, phase_tid(F));
                const pa::BlockRef bA{Qb + (size_t)(256 * j) * 1024 + h * 128, Kp, Vp, YA + (size_t)(256 * j) * 2048 + h * 128, 256 * j, 0, 4 * j + 4, 0, nullptr, nullptr};
                const pa::BlockRef bB{Qb + (size_t)(256 * qbB) * 1024 + h * 128, Kp, Vp, YA + (size_t)(256 * qbB) * 2048 + h * 128, 256 * qbB, s ? cj : 0, s ? 128 - 4 * j : cj, s ? 2 : 1, part, flag};
                pa::Seam S;
                if (s == 0) { pa::prime(bA, (char*)lds, S, F.wv); pa::block(bA, bB, (char*)lds, bias, S, F.wv); pa::block(bB, bB, (char*)lds, bias, S, F.wv); }
                else { pa::prime(bB, (char*)lds, S, F.wv); pa::block(bB, bB, (char*)lds, bias, S, F.wv); }
            }
            asm volatile("s_waitcnt vmcnt(0)" ::: "memory"); __syncthreads();
        }
#endif
                } else {
#ifndef SKIP_SA
        for (int rch_ = 0; rch_ < REP_CH; ++rch_)
        {
            float* bias = (float*)lds; float* wtot = (float*)(lds + SCAN_SCR_OFF);
            const float* LOGF = WSP(float, WS_LOGF); float* out = KOUT(); float* slots = WSP(float, WS_CPART);
            if (F.bx < 256) {
                for (int rs_ = 0; rs_ < REP_CHS; ++rs_)
                {   const int item = c_ >> 1, part = c_ & 1, b = item >> 3, h = item & 7; sa::Item it;
                    block_cumsum<8>(KIN(4) + ((size_t)(l * 16 + b) * 4096) * 8 + h, 8, 4096, bias, wtot, -LOG2E, true, phase_tid(F));
                    { const int t_ = phase_tid(F); if (t_ < 64) { const float x = t_ < 16 ? LOGF[(size_t)h * MP + SROW0 + b * 16 + t_] : 0.f; const float inc = xl::wave_incl_scan(x, t_); if (t_ < 16) bias[4096 + t_] = -LOG2E * inc; } }
                    __syncthreads();
                    const size_t cb = ((size_t)(l * 16 + b) * 4096) * 1024 + h * 128;
                    it.Kc = KIN(2) + cb; it.Vc = KIN(3) + cb; it.nk = 4096;
                    it.Kn = out + pg8::OFF_KS + ((size_t)l * 256 + b * 16) * 1024 + h * 128; it.Vn = out + pg8::OFF_VS + ((size_t)l * 256 + b * 16) * 1024 + h * 128;
                    it.Q = WSP(bf16, WS_Q) + (size_t)(SROW0 + b * 16) * 1024 + h * 128; it.O = nullptr;
                    sa::run_part(it, part * 128, part * 128 + 128, part == 1, slots + (size_t)(256 + 2 * item + part) * sa::PART_SLOT, (char*)lds, F.wv); }
                for (int rt_ = 0; rt_ < REP_CHT; ++rt_)
                {   const int h = c_ >> 5, part = c_ & 31; sa::Item it;
                    block_cumsum<17>(LOGF + (size_t)h * MP, 1, LPR, bias, wtot, -LOG2E, false, phase_tid(F));
                    const size_t kb = ((size_t)l * LPR) * 1024 + h * 128;
                    it.Kc = out + pg8::OFF_KP + kb; it.Vc = out + pg8::OFF_VP + kb; it.nk = 8192; it.Kn = it.Kc + (size_t)8192 * 1024; it.Vn = it.Vc + (size_t)8192 * 1024;
                    it.Q = WSP(bf16, WS_Q) + (size_t)8192 * 1024 + h * 128; it.O = nullptr;
                    sa::run_part(it, part * 16, part * 16 + 16, part == 31, slots + (size_t)(h * 32 + part) * sa::PART_SLOT, (char*)lds, F.wv); }
                {   const int item = c_ >> 1, b = item >> 3, hs = item & 7, ht = c_ >> 5, lane = phase_tid(F) & 63; bool last_s, last_t;
                    part_arrive2(F, F.ctl + CW_CNT + l * 136 + item, 2u, F.ctl + CW_CNT + l * 136 + 128 + ht, 32u, last_s, last_t);
                    if (last_s)
                        for (int q = 2 * F.wv; q < 2 * F.wv + 2; ++q) sa::combine_row<2>(slots + (size_t)(256 + 2 * item) * sa::PART_SLOT, q, WSP(bf16, WS_YC) + (size_t)(SROW0 + b * 16 + q) * 2048 + 1024 + hs * 128, lane);
                    if (last_t)
                        for (int q = 2 * F.wv; q < 2 * F.wv + 2; ++q) sa::combine_row<32>(slots + (size_t)(ht * 32) * sa::PART_SLOT, q, WSP(bf16, WS_YC) + (size_t)(8192 + q) * 2048 + 1024 + ht * 128, lane); }
            }
        }
#endif
                }
            }
        }
        if (rep_ + 1 < REP_ATT) GRID_BAR();
        }
        GRID_BAR();
        STOP_AT(2);
#ifndef SKIP_G2
        {   pg8::Gemm g{WSP(bf16, WS_YC), WSP(bf16, WS_WPCT) + (size_t)l * 2048 * 2048, 8192, 2048, 2048}; pg8::StaticOrder S; S.init(8192, 2048, opaque_s(F.G), opaque_s(F.bx));
            pg8::EpiGateK E{WSP(bf16, WS_SGC), WSP(unsigned char, WS_SGA), WSP(bf16, WS_MG)}; pg8::gemm_phase<pg8::EpiGateK, pg8::StaticOrder, true, true, true>(F.lds + RING_OFF, g, S, E, F.wv); }
        skinny_merged(F, WSP(bf16, WS_YC), WSP(bf16, WS_WPCT) + (size_t)l * 2048 * 2048, WSP(bf16, WS_SGC), WSP(unsigned char, WS_SGA), WSP(bf16, WS_MG), lds);
        GRID_BAR();
        STOP_AT(4);
#endif
#ifndef SKIP_G3
        {   pg8::Gemm g{WSP(bf16, WS_MG), WSP(bf16, WS_WOT) + (size_t)l * 2048 * 2048, 8192, 2048, 2048}; pg8::StaticOrder S; S.init(8192, 2048, opaque_s(F.G), opaque_s(F.bx));
            pg8::EpiRes E{WSP(bf16, WS_XB), WSP(float, SSQ_OFF) + (size_t)(2 * l + 1) * MP * 32}; pg8::gemm_phase<pg8::EpiRes, pg8::StaticOrder, true, true>(F.lds + RING_OFF, g, S, E, F.wv); }
        skinny_res(F, WSP(bf16, WS_MG), WSP(bf16, WS_WOT) + (size_t)l * 2048 * 2048, 2048, WSP(bf16, WS_XB), WSP(float, SSQ_OFF) + (size_t)(2 * l + 1) * MP * 32, lds);
        GRID_BAR();
        STOP_AT(5);
#endif
#ifndef SKIP_G4
        for (int rep_ = 0; rep_ < REP_G4; ++rep_) {
        {   pg8::Gemm g{WSP(bf16, WS_XB), WSP(bf16, WS_WUPT) + (size_t)l * 8192 * 2048, MP, 8192, 2048}; pg8::StaticOrder S; S.init(MP, 8192, opaque_s(F.G), opaque_s(F.bx));
            pg8::EpiUpConv E{WSP(float, SSQ_OFF) + (size_t)(2 * l + 1) * MP * 32, WSP(bf16, WS_G), WSP(float, WS_HALO), KIN(17) + (size_t)l * 3 * 8192, KIN(18) + l * 8192, KOUT(), l, (LAS float*)(F.lds + RST_OFF)}; pg8::gemm_phase<pg8::EpiUpConv, pg8::StaticOrder, true, true>(F.lds + RING_OFF, g, S, E, F.wv); }
        if (l == 0 && F.bx >= IDLE5) {
            const int vb = F.bx - IDLE5, vg = F.G - IDLE5;
            transpose_matrix(F, vb, vg, KIN(9) + (size_t)2048 * 10248, 2048, 10248, 10496, KIN(8) + 2048, WSP(bf16, WS_W1T) + (size_t)10496 * 2048, MapIn());
            transpose_matrix(F, vb, vg, KIN(12) + (size_t)1024 * 2048, 1024, 2048, 2048, nullptr, WSP(bf16, WS_WPCT) + (size_t)2048 * 2048, MapIdent(), 2048);
            transpose_matrix(F, vb, vg, KIN(13) + (size_t)1024 * 2048, 1024, 2048, 2048, nullptr, WSP(bf16, WS_WPCT) + (size_t)2048 * 2048 + 1024, MapIdent(), 2048);
            transpose_matrix(F, vb, vg, KIN(14) + (size_t)2048 * 2048, 2048, 2048, 2048, nullptr, WSP(bf16, WS_WOT) + (size_t)2048 * 2048, MapIdent()); }
        GRID_BAR();
        STOP_AT(6);
        if (rep_ + 1 < REP_G4) GRID_BAR();
        }
#endif
#ifndef SKIP_E4
        for (int rep_ = 0; rep_ < REP_E4; ++rep_) {
        phase_ffn_fixup(F, WSP(float, WS_HALO), WSP(bf16, WS_G), KIN(17) + (size_t)l * 3 * 8192, KIN(18) + l * 8192, KIN(6) + (size_t)l * 16 * 2 * 8192);
        GRID_BAR();
        STOP_AT(7);
        if (rep_ + 1 < REP_E4) GRID_BAR();
        }
#endif
#ifndef SKIP_G5
        {   pg8::Gemm g{WSP(bf16, WS_G), WSP(bf16, WS_WDNT) + (size_t)l * 2048 * 4096, 8192, 2048, 4096}; pg8::StaticOrder S; S.init(8192, 2048, opaque_s(F.G), opaque_s(F.bx));
            pg8::EpiRes E{WSP(bf16, WS_XB), WSP(float, SSQ_OFF) + (size_t)(2 * l + 2) * MP * 32}; pg8::gemm_phase<pg8::EpiRes, pg8::StaticOrder, true, true>(F.lds + RING_OFF, g, S, E, F.wv); }
        skinny_res(F, WSP(bf16, WS_G), WSP(bf16, WS_WDNT) + (size_t)l * 2048 * 4096, 4096, WSP(bf16, WS_XB), WSP(float, SSQ_OFF) + (size_t)(2 * l + 2) * MP * 32, lds);
        GRID_BAR();
        STOP_AT(8);
#endif
    }
    {   const int gw = F.bx * NWAVES + F.wv, NGW = F.G * NWAVES, lane = phase_tid(F) & 63; float* out = KOUT(); const bf16* XB = WSP(bf16, WS_XB); const float* SSQ = WSP(float, SSQ_OFF); const float* gf = KIN(20);
        for (int m0 = gw; m0 < MREAL; m0 += 2 * NGW) {
            pg8::u32x2 xv[2][8]; float part[2];
#pragma unroll
            for (int r = 0; r < 2; ++r) { const int m = (m0 + r * NGW < MREAL) ? m0 + r * NGW : m0;
                part[r] = lane < 32 ? SSQ[(size_t)4 * MP * 32 + (size_t)m * 32 + lane] : 0.f;
#pragma unroll
                for (int j = 0; j < 8; ++j) xv[r][j] = *(const GAS pg8::u32x2*)(XB + (size_t)m * 2048 + 256 * j + 4 * lane); }
#pragma unroll
            for (int r = 0; r < 2; ++r) { const int m = m0 + r * NGW; if (m >= MREAL) break;
                float* o; if (m >= SROW0) o = out + pg8::OFF_YS + (size_t)(m - SROW0) * 2048; else if (m >= 16) o = out + pg8::OFF_YP + (size_t)(m - 16) * 2048; else continue;
                const float rs = 1.0f / sqrtf(xl::wave_sum(part[r]) * (1.0f / 2048.0f) + pg8::RMS_EPS);
#pragma unroll
                for (int j = 0; j < 8; ++j) { const f32x4 v = pg8::unpk4(xv[r][j]), gg = *(const GAS f32x4*)(gf + 256 * j + 4 * lane);
                    *(GAS f32x4*)(o + 256 * j + 4 * lane) = v * rs * gg; } }
        }
    }
}

extern "C" void kernel_launch(void* const* d_in, const int* in_sizes, int n_in, void* d_out, int out_size, void* d_ws, size_t ws_size, hipStream_t stream) {
    static int grid = 0;
    if (grid == 0) {
        if (n_in != 21 || out_size != (int)pg8::OUT_TOTAL || ws_size < WS_END) { fprintf(stderr, "kernel_launch: unexpected shapes: n_in %d out %d ws %zu\n", n_in, out_size, ws_size); grid = -1; return; }
        int dev = 0, cus = 0, per_cu = 0;
        if (hipGetDevice(&dev) != hipSuccess || hipDeviceGetAttribute(&cus, hipDeviceAttributeMultiprocessorCount, dev) != hipSuccess) { grid = -1; return; }
        if (hipFuncSetAttribute((const void*)fwd_kernel, hipFuncAttributeMaxDynamicSharedMemorySize, LDS_BYTES) != hipSuccess) { fprintf(stderr, "kernel_launch: hipFuncSetAttribute failed\n"); grid = -1; return; }
        if (hipOccupancyMaxActiveBlocksPerMultiprocessor(&per_cu, (const void*)fwd_kernel, NWAVES * 64, LDS_BYTES) != hipSuccess || per_cu < 1) fprintf(stderr, "kernel_launch: occupancy query reports %d\n", per_cu);
        (void)hipGetLastError();
        grid = cus;
    }
    if (grid < 0) return;
    (void)hipMemsetAsync((char*)d_ws + WS_CTL, 0, CTL_ZERO_BYTES, stream);
    Args a{};
    for (int i = 0; i < 21; ++i) a.in[i] = (const float*)d_in[i];
    a.out = (float*)d_out; a.ws = (unsigned char*)d_ws;
    hipLaunchKernelGGL(fwd_kernel, dim3(grid), dim3(NWAVES * 64), LDS_BYTES, stream, a);
    const hipError_t le = hipPeekAtLastError();
    if (le != hipSuccess) fprintf(stderr, "kernel_launch: launch failed: %s\n", hipGetErrorName(le));
}
```
